# Optimizing an MI355X kernel written in HIP

```python
import math
import jax, jax.numpy as jnp
from jax import lax
import numpy as np

D_MODEL = 2048
BATCH = 8
SEQ = 4096
DEPTH = 2
DEC_BATCH = 16
DEC_SEQ = 32
PAST_LEN = 2048

CHUNK = 64
N_HEADS = 8
HEAD_DIM = 128
N_SUB = 2 * N_HEADS
D_ATT = N_HEADS * 2 * HEAD_DIM
Q_BLOCK = 128
D_SSM = D_MODEL
GROUP_CH = 16
N_GROUPS = D_SSM // GROUP_CH
STATE_P = 64
SCAN_BLOCK = CHUNK
D_FF = 5632
CONV_W = 3
LN_EPS = 1e-5
ALPHA = (2 * DEPTH) ** 0.25
BETA = (8 * DEPTH) ** -0.25
N_SSM_LAYERS = (DEPTH + 1) // 2
N_ATTN_LAYERS = DEPTH // 2

kernel_name = "hybrid_s5_diffattn_convffn_stream_step"


def layer_norm(x, g, b):
    xf = x.astype(jnp.float32)
    mu = jnp.mean(xf, axis=-1, keepdims=True)
    var = jnp.mean(jnp.square(xf - mu), axis=-1, keepdims=True)
    return ((xf - mu) * lax.rsqrt(var + LN_EPS) * g.astype(jnp.float32) + b.astype(jnp.float32)).astype(x.dtype)


def ada_mod(c, w, b):
    m = (jax.nn.silu(c) @ w + b)[:, None, :]
    return jnp.split(m, 6, axis=-1)


def conv_ffn(h, buf, w_up, w_conv, b_conv, w_down):
    g, v = jnp.split(h @ w_up, 2, axis=-1)
    gp = jnp.concatenate([buf.astype(g.dtype), g], axis=1)
    L = g.shape[1]
    conv = b_conv
    for kk in range(CONV_W):
        conv = conv + gp[:, kk:kk + L] * w_conv[kk]
    out = (jax.nn.gelu(conv, approximate=False) * v) @ w_down
    return out, gp[:, -(CONV_W - 1):]


def ssm_discretise(lam_re, lam_im, log_step, b_re, b_im):
    lr = jnp.minimum(lam_re.astype(jnp.float32), -1e-4)
    li = lam_im.astype(jnp.float32)
    dt = jnp.exp(log_step.astype(jnp.float32))[:, None]
    mag = jnp.exp(lr * dt)
    abar_re = mag * jnp.cos(li * dt)
    abar_im = mag * jnp.sin(li * dt)
    nr = abar_re - 1.0
    ni = abar_im
    den = lr * lr + li * li
    kr = (nr * lr + ni * li) / den
    ki = (ni * lr - nr * li) / den
    br = b_re.astype(jnp.float32)
    bi = b_im.astype(jnp.float32)
    bbar_re = kr[..., None] * br - ki[..., None] * bi
    bbar_im = kr[..., None] * bi + ki[..., None] * br
    return abar_re, abar_im, bbar_re, bbar_im


def _cmul_combine(e1, e2):
    a1r, a1i, b1r, b1i = e1
    a2r, a2i, b2r, b2i = e2
    return (a2r * a1r - a2i * a1i,
            a2r * a1i + a2i * a1r,
            a2r * b1r - a2i * b1i + b2r,
            a2r * b1i + a2i * b1r + b2i)


def ssm_scan(u, s_re, s_im, abar_re, abar_im, bbar_re, bbar_im, c_re, c_im):
    bsz, L = u.shape[0], u.shape[1]
    blk = L if L <= SCAN_BLOCK else SCAN_BLOCK
    nblk = L // blk
    ub = u.reshape(bsz, nblk, blk, N_GROUPS, GROUP_CH).swapaxes(0, 1)
    cr = c_re.astype(jnp.float32)
    ci = c_im.astype(jnp.float32)

    def step(carry, ublk):
        sr, si = carry
        br = jnp.einsum('btgc,gpc->btgp', ublk, bbar_re)
        bi = jnp.einsum('btgc,gpc->btgp', ublk, bbar_im)
        br = br.at[:, 0].add(abar_re * sr - abar_im * si)
        bi = bi.at[:, 0].add(abar_re * si + abar_im * sr)
        ar = jnp.broadcast_to(abar_re, br.shape)
        ai = jnp.broadcast_to(abar_im, bi.shape)
        _, _, hr, hi = lax.associative_scan(_cmul_combine, (ar, ai, br, bi), axis=1)
        y = jnp.einsum('btgp,gcp->btgc', hr, cr) - jnp.einsum('btgp,gcp->btgc', hi, ci)
        return (hr[:, -1], hi[:, -1]), y

    (sr, si), yb = lax.scan(step, (s_re.astype(jnp.float32), s_im.astype(jnp.float32)), ub)
    y = yb.swapaxes(0, 1).reshape(bsz, L, N_GROUPS, GROUP_CH)
    return y, sr, si


def ssm_mixer(h, s_re, s_im, w_in, disc, c_re, c_im, d_skip, w_glu):
    bsz, L, _ = h.shape
    u = (h @ w_in).astype(jnp.float32).reshape(bsz, L, N_GROUPS, GROUP_CH)
    y, sr, si = ssm_scan(u, s_re, s_im, *disc, c_re, c_im)
    y = y + d_skip.astype(jnp.float32).reshape(N_GROUPS, GROUP_CH) * u
    z = jax.nn.gelu(y.reshape(bsz, L, D_SSM), approximate=False).astype(h.dtype)
    a, g = jnp.split(z @ w_glu, 2, axis=-1)
    return a * jax.nn.sigmoid(g), sr, si


def diff_lambda(lq1, lk1, lq2, lk2, lam_init):
    f = jnp.float32
    return (jnp.exp(jnp.sum(lq1.astype(f) * lk1.astype(f)))
            - jnp.exp(jnp.sum(lq2.astype(f) * lk2.astype(f))) + lam_init)


def qkv_proj(h, w_qkv):
    bsz, L, _ = h.shape
    q, k, v = jnp.split(h @ w_qkv, 3, axis=-1)
    return (q.reshape(bsz, L, N_SUB, HEAD_DIM), k.reshape(bsz, L, N_SUB, HEAD_DIM),
            v.reshape(bsz, L, N_HEADS, 2 * HEAD_DIM))


def diff_attend(q, k, v, qpos, kpos, lam):
    s = jnp.einsum('bqhd,bkhd->bhqk', q, k, preferred_element_type=jnp.float32) * (HEAD_DIM ** -0.5)
    mask = (kpos[None, :] // CHUNK) <= (qpos[:, None] // CHUNK)
    s = jnp.where(mask, s, -1e30)
    p = jax.nn.softmax(s, axis=-1)
    bsz, _, tq, tk = p.shape
    p = p.reshape(bsz, N_HEADS, 2, tq, tk)
    a = p[:, :, 0] - lam * p[:, :, 1]
    return jnp.einsum('bhqk,bkhe->bqhe', a.astype(v.dtype), v)


def diff_out(o, subln_g, lam_init, w_o):
    of = o.astype(jnp.float32)
    of = of * lax.rsqrt(jnp.mean(jnp.square(of), axis=-1, keepdims=True) + LN_EPS)
    of = of * subln_g.astype(jnp.float32) * (1.0 - lam_init)
    bsz, L = o.shape[0], o.shape[1]
    return of.reshape(bsz, L, D_ATT).astype(o.dtype) @ w_o


def diff_attn_prompt(h, w_qkv, lam, lam_init, subln_g, w_o):
    bsz, L, _ = h.shape
    q, k, v = qkv_proj(h, w_qkv)
    nq = L // Q_BLOCK
    qb = q.reshape(bsz, nq, Q_BLOCK, N_SUB, HEAD_DIM).swapaxes(0, 1)
    kpos = jnp.arange(L)

    def blk(args):
        qblk, bi = args
        qpos = bi * Q_BLOCK + jnp.arange(Q_BLOCK)
        return diff_attend(qblk, k, v, qpos, kpos, lam)

    o = lax.map(blk, (qb, jnp.arange(nq)))
    o = o.swapaxes(0, 1).reshape(bsz, L, N_HEADS, 2 * HEAD_DIM)
    return diff_out(o, subln_g, lam_init, w_o), k, v


def diff_attn_sample(h, ck, cv, w_qkv, lam, lam_init, subln_g, w_o):
    T = h.shape[1]
    P = ck.shape[1]
    q, k, v = qkv_proj(h, w_qkv)
    kk = jnp.concatenate([ck.astype(k.dtype), k], axis=1)
    vv = jnp.concatenate([cv.astype(v.dtype), v], axis=1)
    qpos = P + jnp.arange(T)
    kpos = jnp.arange(P + T)
    o = diff_attend(q, kk, vv, qpos, kpos, lam)
    return diff_out(o, subln_g, lam_init, w_o), k, v


def setup_inputs(seed: int = 0) -> dict:
    key = jax.random.key(seed)
    ks = iter(jax.random.split(key, 48))
    f = jnp.float32

    def nrm(shape, scale):
        return jax.random.normal(next(ks), shape, f) * scale

    NS, NA = N_SSM_LAYERS, N_ATTN_LAYERS
    d = {}
    d['x_prompt'] = nrm((BATCH, SEQ, D_MODEL), 1.0)
    d['x_sample'] = nrm((DEC_BATCH, DEC_SEQ, D_MODEL), 1.0)
    d['c_prompt'] = nrm((BATCH, D_MODEL), 1.0)
    d['c_sample'] = nrm((DEC_BATCH, D_MODEL), 1.0)
    d['cache_k'] = nrm((NA, DEC_BATCH, PAST_LEN, N_SUB, HEAD_DIM), 1.0)
    d['cache_v'] = nrm((NA, DEC_BATCH, PAST_LEN, N_HEADS, 2 * HEAD_DIM), BETA)
    d['state_ssm_re'] = nrm((NS, DEC_BATCH, N_GROUPS, STATE_P), 0.5)
    d['state_ssm_im'] = nrm((NS, DEC_BATCH, N_GROUPS, STATE_P), 0.5)
    d['state_conv'] = nrm((DEPTH, DEC_BATCH, CONV_W - 1, D_FF), BETA)
    d['w_ada'] = nrm((DEPTH, D_MODEL, 6 * D_MODEL), 0.1 * D_MODEL ** -0.5)
    d['b_ada'] = nrm((DEPTH, 6 * D_MODEL), 0.01)
    d['ln_g'] = 1.0 + nrm((DEPTH, 2, D_MODEL), 0.02)
    d['ln_b'] = nrm((DEPTH, 2, D_MODEL), 0.02)
    d['w_up'] = nrm((DEPTH, D_MODEL, 2 * D_FF), BETA * D_MODEL ** -0.5)
    d['w_dconv'] = nrm((DEPTH, CONV_W, D_FF), CONV_W ** -0.5)
    d['b_dconv'] = nrm((DEPTH, D_FF), 0.02)
    d['w_down'] = nrm((DEPTH, D_FF, D_MODEL), BETA * D_FF ** -0.5)
    d['w_ssm_in'] = nrm((NS, D_MODEL, D_SSM), BETA * D_MODEL ** -0.5)
    d['ssm_lam_re'] = -0.5 + nrm((NS, N_GROUPS, STATE_P), 0.01)
    d['ssm_lam_im'] = math.pi * jnp.arange(STATE_P, dtype=f)[None, None, :] + nrm((NS, N_GROUPS, STATE_P), 0.01)
    d['ssm_log_step'] = jax.random.uniform(next(ks), (NS, N_GROUPS), f, math.log(1e-3), math.log(1e-1))
    d['ssm_b_re'] = nrm((NS, N_GROUPS, STATE_P, GROUP_CH), (2 * GROUP_CH) ** -0.5)
    d['ssm_b_im'] = nrm((NS, N_GROUPS, STATE_P, GROUP_CH), (2 * GROUP_CH) ** -0.5)
    d['ssm_c_re'] = nrm((NS, N_GROUPS, GROUP_CH, STATE_P), (2 * STATE_P) ** -0.5)
    d['ssm_c_im'] = nrm((NS, N_GROUPS, GROUP_CH, STATE_P), (2 * STATE_P) ** -0.5)
    d['ssm_d'] = nrm((NS, D_SSM), 1.0)
    d['w_glu'] = nrm((NS, D_SSM, 2 * D_MODEL), BETA * D_SSM ** -0.5)
    wq = nrm((NA, D_MODEL, D_ATT), D_MODEL ** -0.5)
    wk = nrm((NA, D_MODEL, D_ATT), D_MODEL ** -0.5)
    wv = nrm((NA, D_MODEL, D_ATT), BETA * D_MODEL ** -0.5)
    d['w_qkv'] = jnp.concatenate([wq, wk, wv], axis=-1)
    d['lam_q1'] = nrm((NA, HEAD_DIM), 0.1)
    d['lam_k1'] = nrm((NA, HEAD_DIM), 0.1)
    d['lam_q2'] = nrm((NA, HEAD_DIM), 0.1)
    d['lam_k2'] = nrm((NA, HEAD_DIM), 0.1)
    d['subln_g'] = 1.0 + nrm((NA, 2 * HEAD_DIM), 0.02)
    d['w_o'] = nrm((NA, D_ATT, D_MODEL), BETA * D_ATT ** -0.5)
    return d


def reference(x_prompt, x_sample, c_prompt, c_sample, cache_k, cache_v, state_ssm_re, state_ssm_im,
              state_conv, w_ada, b_ada, ln_g, ln_b, w_up, w_dconv, b_dconv, w_down, w_ssm_in,
              ssm_lam_re, ssm_lam_im, ssm_log_step, ssm_b_re, ssm_b_im, ssm_c_re, ssm_c_im, ssm_d,
              w_glu, w_qkv, lam_q1, lam_k1, lam_q2, lam_k2, subln_g, w_o):
    xp, xs = x_prompt, x_sample
    bp, bs = xp.shape[0], xs.shape[0]
    kp_l, vp_l, ks_l, vs_l = [], [], [], []
    srp_l, sip_l, srs_l, sis_l = [], [], [], []
    cvp_l, cvs_l = [], []
    for i in range(DEPTH):
        shp1, scp1, gtp1, shp2, scp2, gtp2 = ada_mod(c_prompt, w_ada[i], b_ada[i])
        shs1, scs1, gts1, shs2, scs2, gts2 = ada_mod(c_sample, w_ada[i], b_ada[i])
        hp = xp * (1.0 + scp1) + shp1
        hs = xs * (1.0 + scs1) + shs1
        j = i // 2
        if i % 2 == 0:
            disc = ssm_discretise(ssm_lam_re[j], ssm_lam_im[j], ssm_log_step[j], ssm_b_re[j], ssm_b_im[j])
            zp = jnp.zeros((bp, N_GROUPS, STATE_P), jnp.float32)
            mp, srp, sip = ssm_mixer(hp, zp, zp, w_ssm_in[j], disc, ssm_c_re[j], ssm_c_im[j], ssm_d[j], w_glu[j])
            ms, srs, sis = ssm_mixer(hs, state_ssm_re[j], state_ssm_im[j], w_ssm_in[j], disc,
                                     ssm_c_re[j], ssm_c_im[j], ssm_d[j], w_glu[j])
            srp_l.append(srp); sip_l.append(sip); srs_l.append(srs); sis_l.append(sis)
        else:
            lam_init = 0.8 - 0.6 * math.exp(-0.3 * i)
            lam = diff_lambda(lam_q1[j], lam_k1[j], lam_q2[j], lam_k2[j], lam_init)
            mp, kp, vp = diff_attn_prompt(hp, w_qkv[j], lam, lam_init, subln_g[j], w_o[j])
            ms, kn, vn = diff_attn_sample(hs, cache_k[j], cache_v[j], w_qkv[j], lam, lam_init, subln_g[j], w_o[j])
            kp_l.append(kp); vp_l.append(vp); ks_l.append(kn); vs_l.append(vn)
        xp = layer_norm(ALPHA * xp + (1.0 + gtp1) * mp, ln_g[i, 0], ln_b[i, 0])
        xs = layer_norm(ALPHA * xs + (1.0 + gts1) * ms, ln_g[i, 0], ln_b[i, 0])
        hp = xp * (1.0 + scp2) + shp2
        hs = xs * (1.0 + scs2) + shs2
        fp, cvp = conv_ffn(hp, jnp.zeros((bp, CONV_W - 1, D_FF), xp.dtype), w_up[i], w_dconv[i], b_dconv[i], w_down[i])
        fs, cvs = conv_ffn(hs, state_conv[i], w_up[i], w_dconv[i], b_dconv[i], w_down[i])
        cvp_l.append(cvp); cvs_l.append(cvs)
        xp = layer_norm(ALPHA * xp + (1.0 + gtp2) * fp, ln_g[i, 1], ln_b[i, 1])
        xs = layer_norm(ALPHA * xs + (1.0 + gts2) * fs, ln_g[i, 1], ln_b[i, 1])
    new_k_prompt = jnp.stack(kp_l)
    new_v_prompt = jnp.stack(vp_l)
    new_ssm_re_prompt = jnp.stack(srp_l)
    new_ssm_im_prompt = jnp.stack(sip_l)
    new_conv_prompt = jnp.stack(cvp_l)
    new_k_sample = jnp.stack(ks_l)
    new_v_sample = jnp.stack(vs_l)
    new_ssm_re_sample = jnp.stack(srs_l)
    new_ssm_im_sample = jnp.stack(sis_l)
    new_conv_sample = jnp.stack(cvs_l)
    return (xp, xs, new_k_prompt, new_v_prompt, new_ssm_re_prompt, new_ssm_im_prompt, new_conv_prompt,
            new_k_sample, new_v_sample, new_ssm_re_sample, new_ssm_im_sample, new_conv_sample)
```

```cpp
#include <hip/hip_runtime.h>
#include <cstdio>
#include <cstdint>
#ifndef MK_SSM_SIMPLE
#define MK_SSM_SIMPLE 0
#endif
#ifndef MK_ONE_LAUNCH
#define MK_ONE_LAUNCH 0
#endif
namespace pg8 {
#define PG8_LAS __attribute__((address_space(3)))
typedef unsigned short bf16_t;
typedef short bf16x8 __attribute__((ext_vector_type(8)));
typedef float f32x4 __attribute__((ext_vector_type(4)));
typedef unsigned u32x4 __attribute__((ext_vector_type(4)));
constexpr int BM = 256, BK = 64, HALF = 128, HTB = HALF * BK * 2  , STAGE_BYTES = 8 * HTB, NXCD = 8, WGM = 8;

__host__ __device__ __forceinline__ int lds_byte(int r, int c) { const int st = (r >> 4) * 2 + (c >> 5), rr = r & 15, cc = c & 31, ob = rr * 64 + cc * 2; return st * 1024 + (ob ^ (((ob >> 9) & 1) << 5)); }
__host__ __device__ __forceinline__ void stage_rc(int b, int& R, int& C) { const int st = b / 1024, sb = b % 1024, swz = sb ^ (((sb >> 9) & 1) << 5); R = (st >> 1) * 16 + swz / 64; C = (st & 1) * 32 + (swz % 64) / 2; }
__host__ __device__ __forceinline__ int perm32(int rho) { const int n = rho >> 4, i = rho & 15; return 8 * (i >> 2) + 4 * n + (i & 3); }

struct Unit { int pm, pn; };
struct Gemm { const bf16_t* A; const bf16_t* Bt; int M, N, K; };

struct StaticOrder {
    int nM, nN, nwg, G, c;
    __host__ __device__ void init(int M, int N, int G_, int c_) { nM = M / BM; nN = N / BM; nwg = nM * nN; G = G_; c = c_; }
    __host__ __device__ bool next(int i, Unit& u) const {
        const long L = (long)i * G + c; if (L >= nwg) return false;
        int wgid = (int)L; { const int q = nwg / NXCD, r = nwg % NXCD, xcd = wgid % NXCD, off = wgid / NXCD; wgid = (xcd < r ? xcd * (q + 1) : r * (q + 1) + (xcd - r) * q) + off; }
        const int nig = WGM * nN, gid = wgid / nig, fm = gid * WGM, gsz = (nM - fm) < WGM ? (nM - fm) : WGM;
        u.pm = fm + ((wgid % nig) % gsz); u.pn = (wgid % nig) / gsz; return true;
    }
    __device__ __forceinline__ void a_ready(const Unit&) const {}
    __device__ __forceinline__ void done(const Unit&) const {}
};

__device__ __forceinline__ unsigned cvt_pk_bf16(float lo, float hi) { unsigned r; asm volatile("v_cvt_pk_bf16_f32 %0, %1, %2" : "=v"(r) : "v"(lo), "v"(hi)); return r; }
typedef float f32x2 __attribute__((ext_vector_type(2)));
__device__ __forceinline__ f32x2 gelu_pk(f32x2 v) {
    const f32x2 av = __builtin_elementwise_abs(v), d = av * 0.2316418882f + 1.0f;
    f32x2 t; t.x = __builtin_amdgcn_rcpf(d.x); t.y = __builtin_amdgcn_rcpf(d.y);
    f32x2 q = t * 0.5307027145f + (-0.7265760135f); q = q * t + 0.7107068705f; q = q * t + (-0.142248368f); q = q * t + 0.127414796f; q = q * t;
    const f32x2 s = (v * v) * (-0.72134752044f);
    f32x2 e; e.x = __builtin_amdgcn_exp2f(s.x); e.y = __builtin_amdgcn_exp2f(s.y);
    const f32x2 m = v * (q * e), r = v - m;
    f32x2 o; o.x = v.x < 0.f ? m.x : r.x; o.y = v.y < 0.f ? m.y : r.y; return o;
}

template <int ACT  > struct EpiBf16 {
    static constexpr bool PERM = true, AFTER_DRAIN = false; static_assert(ACT == 0 || ACT == 1, "EpiBf16: ACT is 0 (none) or 1 (gelu_pk)");
    bf16_t* O; int ldc; const float* bias; int split_cols; size_t split_stride; float scale0;
    __device__ __forceinline__ void operator()(const f32x4 (&acc)[2][2][4][2], const Unit& u, int wr, int wc, int fr, int fq) const {
        const int row0 = u.pm * BM + wr * 64 + fr; int colt = u.pn * BM; bf16_t* base = O;
        float sc = 1.f; if (split_cols) { const int t = colt / split_cols; base += (size_t)t * split_stride; colt -= t * split_cols; if (t == 0) sc = scale0; }
        const int col0 = colt + wc * 32 + 8 * fq, bcol0 = u.pn * BM + wc * 32 + 8 * fq;
        f32x4 bv[2][2];
#pragma unroll
        for (int bj = 0; bj < 2; ++bj)
#pragma unroll
            for (int n = 0; n < 2; ++n) bv[bj][n] = bias ? *(const f32x4*)(bias + bcol0 + bj * HALF + 4 * n) : (f32x4){0.f, 0.f, 0.f, 0.f};
#pragma unroll
        for (int ai = 0; ai < 2; ++ai)
#pragma unroll
            for (int m = 0; m < 4; ++m) { bf16_t* rowp = base + (size_t)(row0 + ai * HALF + m * 16) * ldc + col0;
#pragma unroll
                for (int bj = 0; bj < 2; ++bj) { f32x4 v0 = acc[ai][bj][m][0] + bv[bj][0], v1 = acc[ai][bj][m][1] + bv[bj][1];
                    if (ACT == 1) { f32x2 a = gelu_pk((f32x2){v0[0], v0[1]}), b = gelu_pk((f32x2){v0[2], v0[3]}), c = gelu_pk((f32x2){v1[0], v1[1]}), d = gelu_pk((f32x2){v1[2], v1[3]});
                        v0 = (f32x4){a.x, a.y, b.x, b.y}; v1 = (f32x4){c.x, c.y, d.x, d.y}; }
                    v0 = v0 * sc; v1 = v1 * sc; u32x4 w; w.x = cvt_pk_bf16(v0[0], v0[1]); w.y = cvt_pk_bf16(v0[2], v0[3]); w.z = cvt_pk_bf16(v1[0], v1[1]); w.w = cvt_pk_bf16(v1[2], v1[3]);
                    *(u32x4*)(rowp + bj * HALF) = w; } }
    }
};

constexpr int EP_MP = 32768;
constexpr int EP_D = 2048, EP_MODLD = 12288;
constexpr float EP_ALPHA = 1.4142135623730951f;
template <bool GLU> struct EpiRes {
    static constexpr bool PERM = false, AFTER_DRAIN = false;
    const float* xin_p; const float* xin_s; float* xout; const float* gate;
    __device__ __forceinline__ void operator()(const f32x4 (&acc)[2][2][4][2], const Unit& u, int wr, int wc, int fr, int fq) const {
#pragma unroll
        for (int ai = 0; ai < 2; ++ai)
#pragma unroll
            for (int m = 0; m < 4; ++m) {
                const int r = u.pm * BM + ai * HALF + wr * 64 + m * 16 + fr;
                const int stream = r < EP_MP ? (r >> 12) : 8 + ((r - EP_MP) >> 5);
                const float* xr = r < EP_MP ? xin_p + (size_t)r * EP_D : xin_s + (size_t)(r - EP_MP) * EP_D;
                float* orow = xout + (size_t)r * EP_D; const float* gr = gate + (size_t)stream * EP_MODLD;
                if (GLU) {
#pragma unroll
                    for (int n = 0; n < 2; ++n) { const int col = u.pn * HALF + wc * 32 + n * 16 + 4 * fq;
                        const f32x4 a = acc[ai][0][m][n], g = acc[ai][1][m][n], xv = *(const f32x4*)(xr + col), gt = *(const f32x4*)(gr + col); f32x4 o;
#pragma unroll
                        for (int e = 0; e < 4; ++e) { const float sg = __builtin_amdgcn_rcpf(1.0f + __builtin_amdgcn_exp2f(-1.4426950408889634f * g[e])); o[e] = EP_ALPHA * xv[e] + (1.0f + gt[e]) * (a[e] * sg); }
                        *(f32x4*)(orow + col) = o; }
                } else {
#pragma unroll
                    for (int bj = 0; bj < 2; ++bj)
#pragma unroll
                        for (int n = 0; n < 2; ++n) { const int col = u.pn * BM + bj * HALF + wc * 32 + n * 16 + 4 * fq;
                            const f32x4 a = acc[ai][bj][m][n], xv = *(const f32x4*)(xr + col), gt = *(const f32x4*)(gr + col); f32x4 o;
#pragma unroll
                            for (int e = 0; e < 4; ++e) o[e] = EP_ALPHA * xv[e] + (1.0f + gt[e]) * a[e];
                            *(f32x4*)(orow + col) = o; }
                }
            }
    }
};
struct EpiUp {
    static constexpr bool PERM = true, AFTER_DRAIN = false;
    bf16_t* G; bf16_t* V; float* cv_p; float* cv_s;
    __device__ __forceinline__ void operator()(const f32x4 (&acc)[2][2][4][2], const Unit& u, int wr, int wc, int fr, int fq) const {
        const int col = u.pn * HALF + wc * 32 + 8 * fq;
#pragma unroll
        for (int ai = 0; ai < 2; ++ai)
#pragma unroll
            for (int m = 0; m < 4; ++m) {
                const int r = u.pm * BM + ai * HALF + wr * 64 + m * 16 + fr;
                const f32x4 g0 = acc[ai][0][m][0], g1 = acc[ai][0][m][1], v0 = acc[ai][1][m][0], v1 = acc[ai][1][m][1];
                u32x4 w; w.x = cvt_pk_bf16(g0[0], g0[1]); w.y = cvt_pk_bf16(g0[2], g0[3]); w.z = cvt_pk_bf16(g1[0], g1[1]); w.w = cvt_pk_bf16(g1[2], g1[3]);
                *(u32x4*)(G + (size_t)r * 5632 + col) = w;
                w.x = cvt_pk_bf16(v0[0], v0[1]); w.y = cvt_pk_bf16(v0[2], v0[3]); w.z = cvt_pk_bf16(v1[0], v1[1]); w.w = cvt_pk_bf16(v1[2], v1[3]);
                *(u32x4*)(V + (size_t)r * 5632 + col) = w;
                float* cv = nullptr;
                if (r < EP_MP) { const int t = r & 4095; if (t >= 4094) cv = cv_p + (size_t)((r >> 12) * 2 + (t - 4094)) * 5632; }
                else { const int rs = r - EP_MP, t = rs & 31; if (t >= 30) cv = cv_s + (size_t)((rs >> 5) * 2 + (t - 30)) * 5632; }
                if (cv) { *(f32x4*)(cv + col) = g0; *(f32x4*)(cv + col + 4) = g1; }
            }
    }
};
#ifndef MK_DIAG_KS
#define MK_DIAG_KS 0.0f
#endif
struct EpiQkv {
    static constexpr bool PERM = true, AFTER_DRAIN = false;
    bf16_t* QB; size_t qkv_stride; float* ok_p; float* ok_s;
    __device__ __forceinline__ void operator()(const f32x4 (&acc)[2][2][4][2], const Unit& u, int wr, int wc, int fr, int fq) const {
        const int which = u.pn >> 3; const int colt = (u.pn & 7) * BM + wc * 32 + 8 * fq;
        bf16_t* ob = QB + (size_t)which * qkv_stride;
        const bool samp = u.pm >= (EP_MP / BM);
        const size_t fo = (samp ? (size_t)(ok_s - ok_p) : (size_t)0) + (size_t)(which == 2 ? (samp ? 512 * EP_D : EP_MP * EP_D) : 0);
        float* fbase = ok_p + fo;
        const int rsub = samp ? EP_MP : 0;
#pragma unroll
        for (int ai = 0; ai < 2; ++ai)
#pragma unroll
            for (int m = 0; m < 4; ++m) {
                const int r = u.pm * BM + ai * HALF + wr * 64 + m * 16 + fr;
#pragma unroll
                for (int bj = 0; bj < 2; ++bj) { const f32x4 v0 = acc[ai][bj][m][0], v1 = acc[ai][bj][m][1]; const int col = colt + bj * HALF;
                    u32x4 w; w.x = cvt_pk_bf16(v0[0], v0[1]); w.y = cvt_pk_bf16(v0[2], v0[3]); w.z = cvt_pk_bf16(v1[0], v1[1]); w.w = cvt_pk_bf16(v1[2], v1[3]);
                    *(u32x4*)(ob + (size_t)r * EP_D + col) = w;
                    if (which) { float* of = fbase + (size_t)(r - rsub) * EP_D + col; float ds = 1.0f; if (!samp && which == 1) { unsigned hsh = (unsigned)(r * 2048 + col) * 2654435761u; hsh ^= hsh >> 15; ds = (hsh & 1u) ? 1.0f + MK_DIAG_KS : 1.0f - MK_DIAG_KS; } *(f32x4*)of = v0 * ds; *(f32x4*)(of + 4) = v1 * ds; } }
            }
    }
};
template <class Epi, class Sched, bool ALIGN_EPI = false, bool SP2 = false>
__device__ __forceinline__ void gemm_phase(PG8_LAS unsigned char* lds, const Gemm g, const Sched& S, const Epi& E) {
    const int tid = threadIdx.x, wid = __builtin_amdgcn_readfirstlane(tid >> 6), lane = tid & 63, wr = wid >> 2, wc = wid & 3, fr = lane & 15, fq = lane >> 4;
    const int K = g.K, nt = K / BK;
    unsigned voffA[2], voffB[2];
#pragma unroll
    for (int i = 0; i < 2; ++i) { int R, C; stage_rc(tid * 16 + i * 8192, R, C); const int Rb = Epi::PERM ? ((R & ~31) + perm32(R & 31)) : R;
        voffA[i] = (unsigned)(R * K + C) * 2u; voffB[i] = (unsigned)(Rb * K + C) * 2u; }
    const size_t kstep = (size_t)(BK * 2);
    const size_t hstep = (size_t)HALF * K * 2;
    const size_t tstep = 2 * hstep;
    const unsigned ldsw = (unsigned)wid * 1024u;
    const int aoff = lds_byte(wr * 64 + fr, fq * 8), boff = lds_byte(wc * 32 + fr, fq * 8);
#define PG8_SA(b, h) (((b) * 2 + (h)) * HTB)
#define PG8_SB(b, h) ((4 + (b) * 2 + (h)) * HTB)
#define PG8_STAGE(bufoff, gbase, voff) do { _Pragma("unroll") for (int _i = 0; _i < 2; ++_i) \
        __builtin_amdgcn_global_load_lds((const unsigned*)((const char*)(gbase) + (voff)[_i]), (PG8_LAS unsigned*)(lds + (bufoff) + ldsw + _i * 8192), 16, 0, 0); } while (0)
#define PG8_LDA(dst, b, h) do { _Pragma("unroll") for (int m = 0; m < 4; ++m) _Pragma("unroll") for (int k = 0; k < 2; ++k) dst[m][k] = *(const PG8_LAS bf16x8*)(lds + PG8_SA(b, h) + aoff + m * 2048 + k * 1024); } while (0)
#define PG8_LDB(dst, b, h) do { _Pragma("unroll") for (int n = 0; n < 2; ++n) _Pragma("unroll") for (int k = 0; k < 2; ++k) dst[n][k] = *(const PG8_LAS bf16x8*)(lds + PG8_SB(b, h) + boff + n * 2048 + k * 1024); } while (0)
#define PG8_MMA(ai, bj, At, Bt) do { __builtin_amdgcn_s_setprio(1); _Pragma("unroll") for (int m = 0; m < 4; ++m) _Pragma("unroll") for (int n = 0; n < 2; ++n) _Pragma("unroll") for (int k = 0; k < 2; ++k) \
        acc[ai][bj][m][n] = __builtin_amdgcn_mfma_f32_16x16x32_bf16(Bt[n][k], At[m][k], acc[ai][bj][m][n], 0, 0, 0); __builtin_amdgcn_s_setprio(0); } while (0)
#define PG8_WAIT_V(n) asm volatile("s_waitcnt vmcnt(" #n ")" ::: "memory")
#define PG8_WAIT_L(n) asm volatile("s_waitcnt lgkmcnt(" #n ")" ::: "memory")
#define PG8_BAR __builtin_amdgcn_s_barrier()
#define PG8_SCHED __builtin_amdgcn_sched_barrier(0)
    Unit cur, nxt; int ui = 0;
    if (!S.next(0, cur)) return;
    f32x4 acc[2][2][4][2];
#pragma unroll
    for (int a = 0; a < 2; ++a)
#pragma unroll
        for (int b = 0; b < 2; ++b)
#pragma unroll
            for (int m = 0; m < 4; ++m)
#pragma unroll
                for (int n = 0; n < 2; ++n) acc[a][b][m][n] = (f32x4){0.f, 0.f, 0.f, 0.f};
    bf16x8 At[4][2], B0[2][2], B1[2][2];
    const char* cA = (const char*)g.A + (size_t)cur.pm * tstep; const char* cB = (const char*)g.Bt + (size_t)cur.pn * tstep;
    S.a_ready(cur);
    if constexpr (SP2) {
        PG8_STAGE(PG8_SB(0, 0), cB, voffB); PG8_STAGE(PG8_SB(0, 1), cB + hstep, voffB); PG8_STAGE(PG8_SA(0, 0), cA, voffA); PG8_STAGE(PG8_SA(0, 1), cA + hstep, voffA);
        if (wr == 1) PG8_BAR;
        PG8_WAIT_V(2); PG8_BAR;
        PG8_STAGE(PG8_SB(1, 0), cB + kstep, voffB); PG8_STAGE(PG8_SA(1, 0), cA + kstep, voffA); PG8_STAGE(PG8_SB(1, 1), cB + hstep + kstep, voffB);
        PG8_WAIT_V(6); PG8_BAR;
    } else {
        PG8_STAGE(PG8_SB(0, 0), cB, voffB); PG8_STAGE(PG8_SA(0, 0), cA, voffA); PG8_STAGE(PG8_SB(0, 1), cB + hstep, voffB); PG8_STAGE(PG8_SA(0, 1), cA + hstep, voffA);
        if (wr == 1) PG8_BAR;
        PG8_WAIT_V(4); PG8_BAR;
        PG8_STAGE(PG8_SB(1, 0), cB + kstep, voffB); PG8_STAGE(PG8_SA(1, 0), cA + kstep, voffA); PG8_STAGE(PG8_SB(1, 1), cB + hstep + kstep, voffB);
        PG8_WAIT_V(6); PG8_BAR;
    }
    for (;;) {
        const bool has_next = S.next(ui + 1, nxt);
        const char* nA = has_next ? (const char*)g.A + (size_t)nxt.pm * tstep : cA; const char* nB = has_next ? (const char*)g.Bt + (size_t)nxt.pn * tstep : cB;
        for (int t = 0; t < nt; t += 2) {
            const bool last = (t == nt - 2);
            const char* a1 = cA + (size_t)(t + 1) * kstep;
            const char* a2 = last ? nA : cA + (size_t)(t + 2) * kstep; const char* b2 = last ? nB : cB + (size_t)(t + 2) * kstep;
            const char* a3 = a2 + kstep; const char* b3 = b2 + kstep;
            if (last && has_next) S.a_ready(nxt);
            if constexpr (SP2) {
            PG8_LDB(B0, 0, 0); PG8_LDB(B1, 0, 1); PG8_SCHED; PG8_LDA(At, 0, 0); PG8_STAGE(PG8_SA(1, 1), a1 + hstep, voffA);
            PG8_WAIT_V(8); PG8_WAIT_L(0); PG8_BAR; PG8_MMA(0, 0, At, B0); PG8_MMA(0, 1, At, B1); PG8_BAR; PG8_SCHED;
            PG8_LDA(At, 0, 1); PG8_STAGE(PG8_SB(0, 0), b2, voffB); PG8_STAGE(PG8_SB(0, 1), b2 + hstep, voffB); PG8_STAGE(PG8_SA(0, 0), a2, voffA);
            PG8_WAIT_V(8); PG8_WAIT_L(0); PG8_BAR; PG8_MMA(1, 0, At, B0); PG8_MMA(1, 1, At, B1); PG8_BAR; PG8_SCHED;
            PG8_LDB(B0, 1, 0); PG8_LDB(B1, 1, 1); PG8_SCHED; PG8_LDA(At, 1, 0); PG8_STAGE(PG8_SA(0, 1), a2 + hstep, voffA);
            PG8_WAIT_V(8); PG8_WAIT_L(0); PG8_BAR; PG8_MMA(0, 0, At, B0); PG8_MMA(0, 1, At, B1); PG8_BAR; PG8_SCHED;
            PG8_LDA(At, 1, 1); PG8_STAGE(PG8_SB(1, 0), b3, voffB); PG8_STAGE(PG8_SB(1, 1), b3 + hstep, voffB); PG8_STAGE(PG8_SA(1, 0), a3, voffA);
            PG8_WAIT_V(8); PG8_WAIT_L(0); PG8_BAR; PG8_MMA(1, 0, At, B0); PG8_MMA(1, 1, At, B1); PG8_BAR; PG8_SCHED;
            } else {
            PG8_LDB(B0, 0, 0); PG8_SCHED; PG8_LDA(At, 0, 0); PG8_STAGE(PG8_SA(1, 1), a1 + hstep, voffA);
            PG8_WAIT_L(8); PG8_BAR; PG8_WAIT_L(0); PG8_MMA(0, 0, At, B0); PG8_BAR; PG8_SCHED;
            PG8_LDB(B1, 0, 1); PG8_STAGE(PG8_SB(0, 0), b2, voffB);
            PG8_BAR; PG8_WAIT_L(0); PG8_MMA(0, 1, At, B1); PG8_BAR;
            PG8_LDA(At, 0, 1); PG8_STAGE(PG8_SA(0, 0), a2, voffA);
            PG8_BAR; PG8_WAIT_L(0); PG8_MMA(1, 0, At, B0); PG8_BAR; PG8_SCHED;
            PG8_STAGE(PG8_SB(0, 1), b2 + hstep, voffB);
            PG8_WAIT_V(6); PG8_BAR; PG8_MMA(1, 1, At, B1); PG8_BAR;
            PG8_LDB(B0, 1, 0); PG8_SCHED; PG8_LDA(At, 1, 0); PG8_STAGE(PG8_SA(0, 1), a2 + hstep, voffA);
            PG8_WAIT_L(8); PG8_BAR; PG8_WAIT_L(0); PG8_MMA(0, 0, At, B0); PG8_BAR; PG8_SCHED;
            PG8_LDB(B1, 1, 1); PG8_STAGE(PG8_SB(1, 0), b3, voffB);
            PG8_BAR; PG8_WAIT_L(0); PG8_MMA(0, 1, At, B1); PG8_BAR;
            PG8_LDA(At, 1, 1); PG8_STAGE(PG8_SA(1, 0), a3, voffA);
            PG8_BAR; PG8_WAIT_L(0); PG8_MMA(1, 0, At, B0); PG8_BAR; PG8_SCHED;
            PG8_STAGE(PG8_SB(1, 1), b3 + hstep, voffB);
            PG8_WAIT_V(6); PG8_BAR; PG8_MMA(1, 1, At, B1); PG8_BAR;
            }
        }
        if constexpr (ALIGN_EPI) { if (wr == 0) PG8_BAR; }
        if constexpr (!Epi::AFTER_DRAIN) { E(acc, cur, wr, wc, fr, fq); S.done(cur); }
        if (!has_next) break;
#pragma unroll
        for (int a = 0; a < 2; ++a)
#pragma unroll
            for (int b = 0; b < 2; ++b)
#pragma unroll
                for (int m = 0; m < 4; ++m)
#pragma unroll
                    for (int n = 0; n < 2; ++n) acc[a][b][m][n] = (f32x4){0.f, 0.f, 0.f, 0.f};
        cur = nxt; cA = nA; cB = nB; ++ui;
        if constexpr (ALIGN_EPI) { if (wr == 1) PG8_BAR; }
    }
    PG8_WAIT_V(0);
    if constexpr (!ALIGN_EPI) { if (wr == 0) PG8_BAR; }
    PG8_BAR;
    if constexpr (Epi::AFTER_DRAIN) { E.fused(acc, cur, wr, wc, fr, fq, lds, wid, lane); S.done(cur); }
#undef PG8_SA
#undef PG8_SB
#undef PG8_STAGE
#undef PG8_LDA
#undef PG8_LDB
#undef PG8_MMA
#undef PG8_WAIT_V
#undef PG8_WAIT_L
#undef PG8_BAR
#undef PG8_SCHED
}
}

namespace att {
typedef unsigned short bf16;
using bf16x8 = __attribute__((ext_vector_type(8))) short;
using s16x4  = __attribute__((ext_vector_type(4))) short;
using f32x16 = __attribute__((ext_vector_type(16))) float;
using f32x8  = __attribute__((ext_vector_type(8))) float;
using f32x4  = __attribute__((ext_vector_type(4))) float;
using u32x4  = __attribute__((ext_vector_type(4))) unsigned;
constexpr int   D = 128, NW = 8, QBLK = 32, KVBLK = 64;
constexpr float SCALE = 0.088388347648318440f;
constexpr float THR = 8.f;
constexpr int LDQ = 2048, LDK = 2048, LDO = 4096;
constexpr size_t SHM_V = KVBLK * D * 2, SHM_K = KVBLK * D * 2, SHM_ATTN = 2 * SHM_V + 2 * SHM_K + NW * 64 * 4;
#define KSWZ(row, colB) ((row) * 256 + ((colB) ^ (((row) & 7) << 4)))
#define SBAR() __builtin_amdgcn_sched_barrier(0)
__device__ __forceinline__ int crow(int r, int hi) { return (r & 3) + 8 * (r >> 2) + 4 * hi; }
__device__ __forceinline__ unsigned cvtpk(float lo, float hi) { unsigned r; asm volatile("v_cvt_pk_bf16_f32 %0, %1, %2" : "=v"(r) : "v"(lo), "v"(hi)); return r; }
__device__ __forceinline__ bf16x8 tobf(f32x8 x) { u32x4 w = {cvtpk(x[0], x[1]), cvtpk(x[2], x[3]), cvtpk(x[4], x[5]), cvtpk(x[6], x[7])}; return *reinterpret_cast<bf16x8*>(&w); }

__device__ __forceinline__ void partialSM(f32x16& p0, f32x16& p1, float& m_reg, float& mn, float& alpha) {
  constexpr float C = SCALE * 1.4426950408889634f;
  float pmax = p0[0];
#pragma unroll
  for (int r = 1; r < 16; ++r) pmax = fmaxf(pmax, p0[r]);
#pragma unroll
  for (int r = 0; r < 16; ++r) pmax = fmaxf(pmax, p1[r]);
  { auto rr = __builtin_amdgcn_permlane32_swap(__float_as_uint(pmax), __float_as_uint(pmax), false, false);
    pmax = fmaxf(__uint_as_float(rr[0]), __uint_as_float(rr[1])); }
  if (__builtin_expect(__all(pmax - m_reg <= THR / SCALE), 1)) { mn = m_reg; alpha = 1.f; }
  else { mn = fmaxf(m_reg, pmax); alpha = __builtin_amdgcn_exp2f((m_reg - mn) * C); m_reg = mn; }
  float mnC = -mn * C;
#pragma unroll
  for (int r = 0; r < 16; ++r) p0[r] = fmaf(p0[r], C, mnC);
#pragma unroll
  for (int r = 0; r < 16; ++r) p1[r] = fmaf(p1[r], C, mnC);
#pragma unroll
  for (int r = 0; r < 16; ++r) p0[r] = __builtin_amdgcn_exp2f(p0[r]);
}
__device__ __forceinline__ void finishSM(f32x16& p0, f32x16& p1, float alpha, float& l_reg, bf16x8& pa0, bf16x8& pa1, bf16x8& pa2, bf16x8& pa3) {
#pragma unroll
  for (int r = 0; r < 16; ++r) p1[r] = __builtin_amdgcn_exp2f(p1[r]);
  float ps = 0;
#pragma unroll
  for (int r = 0; r < 16; ++r) ps += p0[r];
#pragma unroll
  for (int r = 0; r < 16; ++r) ps += p1[r];
  { auto rr = __builtin_amdgcn_permlane32_swap(__float_as_uint(ps), __float_as_uint(ps), false, false);
    ps = __uint_as_float(rr[0]) + __uint_as_float(rr[1]); }
  l_reg = l_reg * alpha + ps;
#define PK4(P, BASE, OUT) do { unsigned a0 = cvtpk(P[BASE + 0], P[BASE + 1]), a1 = cvtpk(P[BASE + 2], P[BASE + 3]);   \
    unsigned b0 = cvtpk(P[BASE + 4], P[BASE + 5]), b1 = cvtpk(P[BASE + 6], P[BASE + 7]);                              \
    auto r0 = __builtin_amdgcn_permlane32_swap(a0, b0, false, false); auto r1 = __builtin_amdgcn_permlane32_swap(a1, b1, false, false); \
    u32x4 w = {r0[0], r1[0], r0[1], r1[1]}; OUT = *reinterpret_cast<bf16x8*>(&w); } while (0)
  PK4(p0, 0, pa0); PK4(p0, 8, pa1); PK4(p1, 0, pa2); PK4(p1, 8, pa3);
#undef PK4
}
__device__ __forceinline__ void qkt(f32x16& p0, f32x16& p1, const bf16* Ks, const bf16x8* qr, int r32, int hi) {
  p0 = f32x16{}; p1 = f32x16{};
#pragma unroll
  for (int d0 = 0; d0 < 8; ++d0) { int cb = (d0 * 16 + hi * 8) * 2;
    bf16x8 b0 = *reinterpret_cast<const bf16x8*>((const char*)Ks + KSWZ(r32, cb));
    bf16x8 b1 = *reinterpret_cast<const bf16x8*>((const char*)Ks + KSWZ(32 + r32, cb));
    p0 = __builtin_amdgcn_mfma_f32_32x32x16_bf16(b0, qr[d0], p0, 0, 0, 0);
    p1 = __builtin_amdgcn_mfma_f32_32x32x16_bf16(b1, qr[d0], p1, 0, 0, 0); }
}
__device__ __forceinline__ int v_st(int k, int c) { const int kk = (k & ~0xC) | ((k & 4) << 1) | ((k & 8) >> 1); return ((kk >> 3) * 4 + (c >> 5)) * 512 + ((kk & 7) * 32 + (c & 31)) * 2; }
__device__ __forceinline__ int v_rd_base(int lane) { return ((lane & 3) << 3) | (((lane >> 2) & 3) << 6) | (((lane >> 4) & 1) << 5) | (((lane >> 5) & 1) << 8); }
constexpr int v_rd_off(int d0, int ks, int half) { return d0 * 512 + ks * 4096 + half * 2048; }
template <int OFF> __device__ __forceinline__ s16x4 tr_read(int vb) {
  s16x4 r; asm volatile("ds_read_b64_tr_b16 %0, %1 offset:%2" : "=&v"(r) : "v"(vb), "i"(OFF) : "memory"); return r;
}
template <int D0> __device__ __forceinline__ void pv_one(f32x16& od, int vb, bf16x8 pa0, bf16x8 pa1, bf16x8 pa2, bf16x8 pa3) {
  const s16x4 l0 = tr_read<v_rd_off(D0, 0, 0)>(vb), h0 = tr_read<v_rd_off(D0, 0, 1)>(vb), l1 = tr_read<v_rd_off(D0, 1, 0)>(vb), h1 = tr_read<v_rd_off(D0, 1, 1)>(vb);
  const s16x4 l2 = tr_read<v_rd_off(D0, 2, 0)>(vb), h2 = tr_read<v_rd_off(D0, 2, 1)>(vb), l3 = tr_read<v_rd_off(D0, 3, 0)>(vb), h3 = tr_read<v_rd_off(D0, 3, 1)>(vb);
  asm volatile("s_waitcnt lgkmcnt(0)" ::: "memory"); SBAR();
#define PK(L, H) (bf16x8){L[0], L[1], L[2], L[3], H[0], H[1], H[2], H[3]}
  od = __builtin_amdgcn_mfma_f32_32x32x16_bf16(pa0, PK(l0, h0), od, 0, 0, 0);
  od = __builtin_amdgcn_mfma_f32_32x32x16_bf16(pa1, PK(l1, h1), od, 0, 0, 0);
  od = __builtin_amdgcn_mfma_f32_32x32x16_bf16(pa2, PK(l2, h2), od, 0, 0, 0);
  od = __builtin_amdgcn_mfma_f32_32x32x16_bf16(pa3, PK(l3, h3), od, 0, 0, 0);
#undef PK
}
__device__ __forceinline__ void pv_d0(f32x16* o, int vb, bf16x8 pa0, bf16x8 pa1, bf16x8 pa2, bf16x8 pa3) {
  pv_one<0>(o[0], vb, pa0, pa1, pa2, pa3); pv_one<1>(o[1], vb, pa0, pa1, pa2, pa3); pv_one<2>(o[2], vb, pa0, pa1, pa2, pa3); pv_one<3>(o[3], vb, pa0, pa1, pa2, pa3);
}

__device__ __forceinline__ void attn_prompt_unit(const bf16* __restrict__ Qb, const bf16* __restrict__ Kh, const bf16* __restrict__ Vh, bf16* __restrict__ Ob, int qb, char* lds) {
  asm volatile("" : "+s"(Qb), "+s"(Kh), "+s"(Vh), "+s"(Ob), "+s"(qb));
  const int tid = threadIdx.x, wid = tid >> 6, lane = tid & 63, r32 = lane & 31, hi = lane >> 5;
  bf16* V_lds = (bf16*)lds; bf16* K_lds = (bf16*)(lds + 2 * SHM_V);
  float* ws = (float*)(lds + 2 * SHM_V + 2 * SHM_K) + wid * 64; float* li_l = ws; float* al_l = ws + 32;
  float m_reg = -1e30f, l_reg = 0; f32x16 o[4] = {}; bf16x8 qr[8];
  const bf16* Qw = Qb + (long)(wid * QBLK + r32) * LDQ + hi * 8;
#pragma unroll
  for (int d0 = 0; d0 < 8; ++d0) qr[d0] = *reinterpret_cast<const bf16x8*>(Qw + d0 * 16);
  const int sr = tid >> 4, sc = (tid & 15) * 8, vst0 = v_st(sr, sc), vst1 = v_st(32 + sr, sc);
  const int vb0 = (int)(uintptr_t)V_lds + v_rd_base(lane);
  struct { bf16x8 vs0, vs1, ks0, ks1; } sr_[2];
  const int NT = 4 * (qb + 1), lastvis = 4 * qb + (wid >> 1);
#define SLOAD(i, k0) do { sr_[i].vs0 = *reinterpret_cast<const bf16x8*>(&Vh[(long)((k0) + sr) * LDK + sc]); sr_[i].vs1 = *reinterpret_cast<const bf16x8*>(&Vh[(long)((k0) + 32 + sr) * LDK + sc]); \
    sr_[i].ks0 = *reinterpret_cast<const bf16x8*>(&Kh[(long)((k0) + sr) * LDK + sc]); sr_[i].ks1 = *reinterpret_cast<const bf16x8*>(&Kh[(long)((k0) + 32 + sr) * LDK + sc]); } while (0)
#define SWRITE(b, i) do { *(bf16x8*)((char*)V_lds + (b) * SHM_V + vst0) = sr_[i].vs0;          \
    *(bf16x8*)((char*)V_lds + (b) * SHM_V + vst1) = sr_[i].vs1; int kc = sc * 2;               \
    *(bf16x8*)((char*)K_lds + (b) * SHM_K + KSWZ(sr, kc)) = sr_[i].ks0;                       \
    *(bf16x8*)((char*)K_lds + (b) * SHM_K + KSWZ(32 + sr, kc)) = sr_[i].ks1; } while (0)
#define SWAIT() asm volatile("s_waitcnt vmcnt(4)" ::: "memory")
#define RESC(a) do { if (__any((a) < 1.f)) { if (hi == 0) al_l[r32] = (a); asm volatile("s_waitcnt lgkmcnt(0)" ::: "memory"); \
    _Pragma("unroll") for (int d = 0; d < 4; ++d) _Pragma("unroll") for (int r = 0; r < 16; ++r) o[d][r] *= al_l[crow(r, hi)]; } } while (0)
#define TMASK(P0, P1, jt) do { if ((jt) > lastvis) { _Pragma("unroll") for (int r = 0; r < 16; ++r) { P0[r] = -1e30f; P1[r] = -1e30f; } } } while (0)
  f32x16 pA0, pA1, pB0, pB1; float mnA, mnB, alA, alB; bf16x8 pa0, pa1, pa2, pa3;
  constexpr int SE = 0, SO = 1;
  SLOAD(SE, 0); asm volatile("s_waitcnt vmcnt(0)" ::: "memory"); SWRITE(0, SE); __syncthreads();
  qkt(pA0, pA1, K_lds, qr, r32, hi); partialSM(pA0, pA1, m_reg, mnA, alA);
  SLOAD(SO, KVBLK); if (2 < NT) SLOAD(SE, 2 * KVBLK);
  SWAIT(); SWRITE(1, SO); __syncthreads();
  for (int j = 1; j + 1 < NT; j += 2) {
    SBAR(); qkt(pB0, pB1, (bf16*)((char*)K_lds + SHM_K), qr, r32, hi); TMASK(pB0, pB1, j);
    finishSM(pA0, pA1, alA, l_reg, pa0, pa1, pa2, pa3); SBAR();
    SLOAD(SO, (j + 2) * KVBLK); SBAR();
    pv_d0(o, vb0, pa0, pa1, pa2, pa3); partialSM(pB0, pB1, m_reg, mnB, alB);
    __syncthreads(); SWAIT(); SWRITE(0, SE);
    RESC(alB); __syncthreads();
    SBAR(); qkt(pA0, pA1, K_lds, qr, r32, hi); TMASK(pA0, pA1, j + 1);
    finishSM(pB0, pB1, alB, l_reg, pa0, pa1, pa2, pa3); SBAR();
    if (j + 3 < NT) SLOAD(SE, (j + 3) * KVBLK); SBAR();
    pv_d0(o, vb0 + (int)SHM_V, pa0, pa1, pa2, pa3); partialSM(pA0, pA1, m_reg, mnA, alA);
    __syncthreads(); SWAIT(); SWRITE(1, SO);
    RESC(alA); __syncthreads();
  }
  SBAR(); qkt(pB0, pB1, (bf16*)((char*)K_lds + SHM_K), qr, r32, hi); TMASK(pB0, pB1, NT - 1);
  finishSM(pA0, pA1, alA, l_reg, pa0, pa1, pa2, pa3); SBAR();
  pv_d0(o, vb0, pa0, pa1, pa2, pa3); partialSM(pB0, pB1, m_reg, mnB, alB);
  __syncthreads(); RESC(alB);
  finishSM(pB0, pB1, alB, l_reg, pa0, pa1, pa2, pa3); SBAR();
  pv_d0(o, vb0 + (int)SHM_V, pa0, pa1, pa2, pa3);
  if (hi == 0) li_l[r32] = l_reg; asm volatile("s_waitcnt lgkmcnt(0)" ::: "memory");
  float rli[16];
#pragma unroll
  for (int r = 0; r < 16; ++r) rli[r] = __builtin_amdgcn_rcpf(li_l[crow(r, hi)]);
  bf16* Ow = Ob + (long)(wid * QBLK) * LDO;
#pragma unroll
  for (int r = 0; r < 16; ++r) { int orow = crow(r, hi);
#pragma unroll
    for (int d0 = 0; d0 < 4; ++d0) Ow[(long)orow * LDO + d0 * 32 + r32] = (bf16)(cvtpk(o[d0][r] * rli[r], 0.f) & 0xffffu); }
  __syncthreads();
#undef SLOAD
#undef SWRITE
#undef SWAIT
#undef TMASK
}

__device__ __forceinline__ void attn_sample_unit(const bf16* __restrict__ QB, const bf16* __restrict__ KB, const bf16* __restrict__ VB, const float* __restrict__ ck, const float* __restrict__ cv,
                                                 float* __restrict__ OPS, float* __restrict__ MLS, int b, int h, int split, char* lds) {
  const int tid = threadIdx.x, wid = tid >> 6, lane = tid & 63, r32 = lane & 31, hi = lane >> 5, j = wid >> 2, c = wid & 3;
  bf16* K_lds = (bf16*)(lds + j * 16384);
  char* V_base = lds + 32768;
  float* ws = (float*)(lds + 65536) + wid * 64; float* al_l = ws + 32;
  float m_reg = -1e30f, l_reg = 0; f32x16 o[2] = {}; bf16x8 qr[8];
  const long qrow0 = 32768 + 32 * b;
  const bf16* Qw = QB + (qrow0 + r32) * LDQ + (2 * h + j) * 128 + hi * 8;
#pragma unroll
  for (int d0 = 0; d0 < 8; ++d0) qr[d0] = *reinterpret_cast<const bf16x8*>(Qw + d0 * 16);
  const int vb = (int)(uintptr_t)(V_base + (c >> 1) * 16384) + v_rd_base(lane);
  const int skey = tid >> 3, sg = tid & 7;
  const float* ckb = ck + ((long)(b * 2048 + split * 1024 + skey) * 16 + 2 * h) * 128 + sg * 8;
  const float* cvb = cv + ((long)(b * 2048 + split * 1024 + skey) * 8 + h) * 256 + sg * 8;
  f32x8 kreg[4], vreg[4];
#define S_LOAD(t) do { _Pragma("unroll") for (int i = 0; i < 4; ++i) { kreg[i] = *reinterpret_cast<const f32x8*>(ckb + (long)(t) * 64 * 2048 + i * 64); vreg[i] = *reinterpret_cast<const f32x8*>(cvb + (long)(t) * 64 * 2048 + i * 64); } } while (0)
#define S_WRITE() do { _Pragma("unroll") for (int i = 0; i < 4; ++i) { const int col = (sg + 8 * i) * 8, jj = col >> 7, cc = col & 127; \
    *(bf16x8*)(lds + jj * 16384 + KSWZ(skey, cc * 2)) = tobf(kreg[i]); *(bf16x8*)(V_base + jj * 16384 + v_st(skey, cc)) = tobf(vreg[i]); } } while (0)
#define S_TILE(MASKP1) do { f32x16 p0, p1; float mn, al; bf16x8 pa0, pa1, pa2, pa3; \
    qkt(p0, p1, K_lds, qr, r32, hi); if (MASKP1) { _Pragma("unroll") for (int r = 0; r < 16; ++r) p1[r] = -1e30f; } \
    partialSM(p0, p1, m_reg, mn, al); \
    if (__any(al < 1.f)) { if (hi == 0) al_l[r32] = al; asm volatile("s_waitcnt lgkmcnt(0)" ::: "memory"); \
      _Pragma("unroll") for (int d = 0; d < 2; ++d) _Pragma("unroll") for (int r = 0; r < 16; ++r) o[d][r] *= al_l[crow(r, hi)]; } \
    finishSM(p0, p1, al, l_reg, pa0, pa1, pa2, pa3); SBAR(); \
    if (c & 1) { pv_one<2>(o[0], vb, pa0, pa1, pa2, pa3); pv_one<3>(o[1], vb, pa0, pa1, pa2, pa3); } \
    else { pv_one<0>(o[0], vb, pa0, pa1, pa2, pa3); pv_one<1>(o[1], vb, pa0, pa1, pa2, pa3); } } while (0)
  S_LOAD(0);
  for (int t = 0; t < 16; ++t) {
    asm volatile("s_waitcnt vmcnt(0)" ::: "memory"); __syncthreads(); S_WRITE(); __syncthreads();
    if (t + 1 < 16) S_LOAD(t + 1);
    S_TILE(false);
  }
  if (split == 1) {
    __syncthreads();
    { const int key = tid >> 4, g16 = tid & 15;
#pragma unroll
      for (int i = 0; i < 2; ++i) { const int col = g16 * 16 + i * 8, jj = col >> 7, cc = col & 127;
        const bf16x8 kv = *reinterpret_cast<const bf16x8*>(KB + (qrow0 + key) * LDK + h * 256 + col);
        const bf16x8 vv = *reinterpret_cast<const bf16x8*>(VB + (qrow0 + key) * LDK + h * 256 + col);
        *(bf16x8*)(lds + jj * 16384 + KSWZ(key, cc * 2)) = kv; *(bf16x8*)(V_base + jj * 16384 + v_st(key, cc)) = vv;
        *(bf16x8*)(lds + jj * 16384 + KSWZ(32 + key, cc * 2)) = bf16x8{}; *(bf16x8*)(V_base + jj * 16384 + v_st(32 + key, cc)) = bf16x8{}; } }
    __syncthreads();
    S_TILE(true);
  }
  const long pbase = ((((long)b * 8 + h) * 2 + split) * 2 + j) * 32;
#pragma unroll
  for (int r = 0; r < 16; ++r) { const int orow = crow(r, hi);
#pragma unroll
    for (int d = 0; d < 2; ++d) OPS[(pbase + orow) * 256 + c * 64 + d * 32 + r32] = o[d][r]; }
  if (c == 0 && hi == 0) { MLS[(pbase + r32) * 2] = m_reg; MLS[(pbase + r32) * 2 + 1] = l_reg; }
  __syncthreads();
#undef S_LOAD
#undef S_WRITE
#undef S_TILE
}
#undef RESC
#undef KSWZ
}

constexpr int NWAVES = 8;
constexpr int DM = 2048, MP = 32768, MS = 512, M = MP + MS, SEQ = 4096, TS = 32, NSTREAM = 24, DFF = 5632, NGRP = 128, SP = 64;
constexpr float LN_EPS = 1e-5f;
constexpr float LAM_INIT = 0.35550906759f;
constexpr size_t OUT_Y = 0, OUT_KP = (size_t)M * DM, OUT_VP = OUT_KP + (size_t)MP * DM, OUT_SRP = OUT_VP + (size_t)MP * DM, OUT_SIP = OUT_SRP + 8 * 128 * 64, OUT_CVP = OUT_SIP + 8 * 128 * 64,
                 OUT_KS = OUT_CVP + 2 * 8 * 2 * DFF, OUT_VS = OUT_KS + (size_t)MS * DM, OUT_SRS = OUT_VS + (size_t)MS * DM, OUT_SIS = OUT_SRS + 16 * 128 * 64, OUT_CVS = OUT_SIS + 16 * 128 * 64,
                 OUT_END = OUT_CVS + 2 * 16 * 2 * DFF;
static_assert(OUT_END == 205406208 && OUT_VP - OUT_KP == (size_t)MP * DM && OUT_VS - OUT_KS == (size_t)MS * DM, "output size");
constexpr size_t MiB = 1u << 20;
constexpr size_t WS_CTL = 0, CTL_ZERO_BYTES = 1 * MiB;
constexpr size_t WS_MOD = 1 * MiB;
constexpr size_t WS_ABAR = 4 * MiB;
constexpr size_t WS_BBT = 5 * MiB;
constexpr size_t WS_CMT = 6 * MiB;
constexpr size_t WS_WIN = 8 * MiB, WS_WGLU = 16 * MiB, WS_WUP = 32 * MiB  , WS_WDOWN = 120 * MiB  , WS_WQKV = 164 * MiB, WS_WO = 188 * MiB;
constexpr size_t WS_HB = 196 * MiB;
constexpr size_t WS_BIG = 326 * MiB;
constexpr size_t WS_U = WS_BIG, WS_Z = WS_BIG + 130 * MiB;
constexpr size_t WS_G = WS_BIG, WS_V = WS_BIG + 358 * MiB;
constexpr size_t WS_Q = WS_BIG, WS_K = WS_BIG + 130 * MiB, WS_VA = WS_BIG + 260 * MiB, WS_OP = WS_BIG + 390 * MiB  , WS_OPS = WS_BIG + 650 * MiB  , WS_MLS = WS_BIG + 666 * MiB;
constexpr size_t WS_END = WS_V + 358 * MiB;
static_assert(WS_VA - WS_K == WS_K - WS_Q && (size_t)M * DFF * 2 <= 358 * MiB && (size_t)M * DM * 2 <= 130 * MiB && (size_t)M * 4096 * 2 <= 260 * MiB, "ws map");
constexpr int CW_BAR = 4096;
constexpr int RING_BYTES = 131072, LDSCTL_OFF = RING_BYTES, MISC_OFF = LDSCTL_OFF + 320, LDS_BYTES = 147456;

#define GAS __attribute__((address_space(1)))
#define LAS __attribute__((address_space(3)))
typedef unsigned short bf16;
typedef unsigned v4u __attribute__((ext_vector_type(4)));
typedef float f32x4 __attribute__((ext_vector_type(4)));
typedef short bf16x8 __attribute__((ext_vector_type(8)));
typedef GAS unsigned gu32;
typedef GAS unsigned long long gu64;
#define RLX_AGENT __ATOMIC_RELAXED, __HIP_MEMORY_SCOPE_AGENT
#define LDS_WAIT() asm volatile("s_waitcnt lgkmcnt(0)" ::: "memory")
#define VM_WAIT() asm volatile("s_waitcnt vmcnt(0)" ::: "memory")
__device__ __forceinline__ unsigned long long rt() { return __builtin_amdgcn_s_memrealtime(); }
__device__ __forceinline__ unsigned f2bf(float f) { unsigned u = __builtin_bit_cast(unsigned, f); return (u + 0x7fffu + ((u >> 16) & 1u)) >> 16; }
__device__ __forceinline__ unsigned pk2(float lo, float hi) { return f2bf(lo) | (f2bf(hi) << 16); }

#define XB_TMO      128
#define XB_XCNT(j)  (256  + 64 * (j))
#define XB_XSUB(j)  (1280 + 64 * (j))
#define XB_XGEN(j)  (2304 + 64 * (j))
#define XB_TOP      3328
#define XB_TOPGEN   3392
#define XCD_BAR_WORDS 3456
#define XB_SPIN_CAP (1u << 18)

__device__ __forceinline__ unsigned xb_ld(unsigned* p)              { return __hip_atomic_load(p, __ATOMIC_RELAXED, __HIP_MEMORY_SCOPE_AGENT); }
__device__ __forceinline__ unsigned xb_add(unsigned* p, unsigned v) { return __hip_atomic_fetch_add(p, v, __ATOMIC_RELAXED, __HIP_MEMORY_SCOPE_AGENT); }
__device__ __forceinline__ unsigned xb_xcc_id() { return (unsigned)__builtin_amdgcn_s_getreg((3 << 11) | 20) & 0xFu; }
#define XB_SPIN(cond, bar) do { unsigned _sp = 0; while (cond) { __builtin_amdgcn_s_sleep(1); \
    if ((++_sp & 255u) == 0u) { if (xb_ld(&(bar)[XB_TMO])) break; if (_sp > XB_SPIN_CAP) { atomicAdd(&(bar)[XB_TMO], 1u); break; } } } } while (0)

struct XcdBarrier {
    unsigned* bar; unsigned x;
    volatile LAS unsigned* st;
};

__device__ __forceinline__ XcdBarrier xcd_barrier_post(unsigned* bar, volatile LAS unsigned* st) {
    XcdBarrier b; b.bar = bar; b.x = xb_xcc_id(); b.st = st;
    if (threadIdx.x == 0) (void)xb_add(&bar[XB_XCNT(b.x)], 1u);
    return b;
}
__device__ __forceinline__ void xcd_barrier_complete(unsigned* bar, unsigned x, unsigned& nloc, unsigned& nx) {
    const unsigned G = gridDim.x * gridDim.y * gridDim.z;
    unsigned sum, cnt, mine, sp = 0u;
    for (;;) {
        sum = 0u; cnt = 0u; mine = 0u;
#pragma unroll
        for (unsigned j = 0; j < 16; ++j) { const unsigned c = xb_ld(&bar[XB_XCNT(j)]); sum += c; cnt += (c > 0u) ? 1u : 0u; mine = (j == x) ? c : mine; }
        if (sum == G) break;
        __builtin_amdgcn_s_sleep(1);
        if ((++sp & 255u) == 0u) { if (xb_ld(&bar[XB_TMO])) break; if (sp > XB_SPIN_CAP) { atomicAdd(&bar[XB_TMO], 1u); break; } }
    }
    nloc = mine > 0u ? mine : 1u; nx = cnt > 0u ? cnt : 1u;
}

__device__ __forceinline__ void xcd_barrier(const XcdBarrier& b) {
    asm volatile("s_waitcnt vmcnt(0)" ::: "memory");
    __syncthreads();
    if (threadIdx.x == 0) {
        unsigned* bar = b.bar;
        __builtin_amdgcn_s_waitcnt(0);
        unsigned nloc = b.st[0], nx = b.st[1];
        if (nloc == 0u) { xcd_barrier_complete(bar, b.x, nloc, nx); b.st[0] = nloc; b.st[1] = nx; }
        const unsigned old = xb_add(&bar[XB_XSUB(b.x)], 1u);
        const unsigned gen = old / nloc;
        if (old + 1u == (gen + 1u) * nloc) {
            __builtin_amdgcn_fence(__ATOMIC_RELEASE, "agent");
            asm volatile("s_waitcnt vmcnt(0)" ::: "memory");
            const unsigned og = xb_add(&bar[XB_TOP], 1u);
            const unsigned tg = og / nx;
            if (og + 1u == (tg + 1u) * nx) xb_add(&bar[XB_TOPGEN], 1u);
            else XB_SPIN(xb_ld(&bar[XB_TOPGEN]) == tg, bar);
            __builtin_amdgcn_fence(__ATOMIC_ACQUIRE, "agent");
            xb_add(&bar[XB_XGEN(b.x)], 1u);
            asm volatile("s_waitcnt vmcnt(0)" ::: "memory");
        } else {
            XB_SPIN(xb_ld(&bar[XB_XGEN(b.x)]) == gen, bar);
            __builtin_amdgcn_fence(__ATOMIC_ACQUIRE, "agent");
            asm volatile("s_waitcnt vmcnt(0)" ::: "memory");
        }
    }
    __syncthreads();
}

struct Args { const float* in[34]; float* out; unsigned char* ws; int ph_lo, ph_hi; };
enum { I_XP = 0, I_XS, I_CP, I_CS, I_CK, I_CV, I_SRE, I_SIM, I_SCONV, I_WADA, I_BADA, I_LNG, I_LNB, I_WUP, I_WDC, I_BDC, I_WDOWN, I_WIN, I_LRE, I_LIM, I_LSTEP, I_BRE, I_BIM, I_CRE, I_CIM, I_SSMD, I_WGLU, I_WQKV, I_LQ1, I_LK1, I_LQ2, I_LK2, I_SUBG, I_WO };

__device__ __forceinline__ float wave_sum(float v) {
#pragma unroll
    for (int o = 1; o < 64; o <<= 1) v += __shfl_xor(v, o);
    return v;
}
__device__ __forceinline__ unsigned cvtpk2(float lo, float hi) { unsigned r; asm volatile("v_cvt_pk_bf16_f32 %0, %1, %2" : "=v"(r) : "v"(lo), "v"(hi)); return r; }
__device__ __forceinline__ int row_stream(int r) { return r < MP ? (r >> 12) : 8 + ((r - MP) >> 5); }

__device__ __forceinline__ void p0_transpose_item(const float* W, int K, int N, bf16* WT, int kind, LAS float* scr, int item, int lane) {
    const int nblk = N / 32, kb = item / nblk, nb = item % nblk, k0 = 64 * kb, n0 = 32 * nb;
    int d0 = n0;
    if (kind == 1) { const int hn = N / 2, half = n0 / hn, rem = n0 % hn; d0 = 256 * (rem >> 7) + 128 * half + (rem & 127); }
#pragma unroll 8
    for (int i = 0; i < 32; ++i) { const int kk = 2 * i + (lane >> 5); scr[kk * 33 + (lane & 31)] = W[(size_t)(k0 + kk) * N + n0 + (lane & 31)]; }
    LDS_WAIT(); asm volatile("" ::: "memory");
    const int c = lane & 7;
#pragma unroll
    for (int j = 0; j < 4; ++j) { const int n = (lane >> 3) + 8 * j; const LAS float* s = scr + (8 * c) * 33 + n;
        v4u o; o.x = pk2(s[0 * 33], s[1 * 33]); o.y = pk2(s[2 * 33], s[3 * 33]); o.z = pk2(s[4 * 33], s[5 * 33]); o.w = pk2(s[6 * 33], s[7 * 33]);
        *(GAS v4u*)(WT + (size_t)(d0 + n) * K + k0 + 8 * c) = o; }
    LDS_WAIT(); asm volatile("" ::: "memory");
}
__device__ __forceinline__ void sincos_cw(float x, float& s, float& c) {
    const float k = rintf(x * 0.63661977236758134f);
    float r = fmaf(k, -1.5703125f, x); r = fmaf(k, -4.837512969970703125e-4f, r); r = fmaf(k, -7.54978995489188216e-8f, r);
    const float r2 = r * r;
    const float sp = r + r * r2 * (-1.6666654611e-1f + r2 * (8.3321608736e-3f + r2 * -1.9515295891e-4f));
    const float cp = 1.0f - 0.5f * r2 + r2 * r2 * (4.166664568298827e-2f + r2 * (-1.388731625493765e-3f + r2 * 2.443315711809948e-5f));
    const int q = (int)k & 3;
    const float ss = (q & 1) ? cp : sp, cc = (q & 1) ? sp : cp;
    s = (q & 2) ? -ss : ss; c = ((q + 1) & 2) ? -cc : cc;
}
__device__ __forceinline__ void p0_ssm_tables(const Args& A, int g, int lane) {
    const int p = lane;
    const float lr = fminf(A.in[I_LRE][g * 64 + p], -1e-4f), li = A.in[I_LIM][g * 64 + p], dt = expf(A.in[I_LSTEP][g]);
    const float mag = expf(lr * dt); float sn, cs; sincos_cw(li * dt, sn, cs);
    const float ar = mag * cs, ai = mag * sn, nr = ar - 1.0f, ni = ai, den = lr * lr + li * li;
    const float kr = (nr * lr + ni * li) / den, ki = (ni * lr - nr * li) / den;
    float2* ab = (float2*)(A.ws + WS_ABAR); ab[g * 64 + p] = make_float2(ar, ai);
    bf16* bbt = (bf16*)(A.ws + WS_BBT) + (size_t)g * 128 * 16;
    const float* bre = A.in[I_BRE] + ((size_t)g * 64 + p) * 16; const float* bim = A.in[I_BIM] + ((size_t)g * 64 + p) * 16;
#pragma unroll
    for (int c = 0; c < 16; ++c) { const float br = bre[c], bi = bim[c];
        bbt[p * 16 + c] = (bf16)f2bf(kr * br - ki * bi); bbt[(64 + p) * 16 + c] = (bf16)f2bf(kr * bi + ki * br); }
    bf16* cmt = (bf16*)(A.ws + WS_CMT) + (size_t)g * 16 * 128;
#pragma unroll
    for (int c = 0; c < 16; ++c) { const float cr = A.in[I_CRE][((size_t)g * 16 + c) * 64 + p], ci = A.in[I_CIM][((size_t)g * 16 + c) * 64 + p];
        *(unsigned*)(cmt + c * 128 + 2 * p) = f2bf(cr) | (f2bf(-ci) << 16); }
}
__device__ __forceinline__ void p0_ada_item(const Args& A, LAS unsigned char* lds, int item, int tid, int wave, int lane) {
    const int l = item / 192, cb = item % 192;
    LAS float* SC = (LAS float*)lds;
    LAS float* RED = (LAS float*)(lds + 98304);
    float acc[24];
#pragma unroll
    for (int s = 0; s < 24; ++s) acc[s] = 0.f;
    const float* W = A.in[I_WADA] + (size_t)l * DM * 12288 + cb * 64 + lane;
    for (int half = 0; half < 2; ++half) {
        for (int i = tid; i < 24 * 1024; i += 512) { const int s = i >> 10, k = (i & 1023) + half * 1024;
            const float c = s < 8 ? A.in[I_CP][s * DM + k] : A.in[I_CS][(s - 8) * DM + k]; SC[i] = c / (1.0f + __expf(-c)); }
        __syncthreads();
        const int k0 = wave * 128;
#pragma unroll 4
        for (int kk = 0; kk < 128; ++kk) { const float w = W[(size_t)(half * 1024 + k0 + kk) * 12288];
#pragma unroll
            for (int s = 0; s < 24; ++s) acc[s] = fmaf(SC[s * 1024 + k0 + kk], w, acc[s]); }
        __syncthreads();
    }
    for (int w8 = 0; w8 < 8; ++w8) {
        if (wave == w8) {
#pragma unroll
            for (int s = 0; s < 24; ++s) { float v = acc[s]; if (w8) v += RED[s * 64 + lane]; RED[s * 64 + lane] = v; } }
        __syncthreads();
    }
    float* mod = (float*)(A.ws + WS_MOD);
    for (int i = tid; i < 24 * 64; i += 512) { const int s = i >> 6, c = i & 63; mod[((size_t)l * 24 + s) * 12288 + cb * 64 + c] = RED[i] + A.in[I_BADA][l * 12288 + cb * 64 + c]; }
    __syncthreads();
}
__device__ __forceinline__ void mod_row(const float* xr, const float* sc, const float* sh, bf16* hr, int lane) {
#pragma unroll
    for (int j = 0; j < 4; ++j) { const int col = j * 512 + lane * 8;
        const f32x4 a0 = *(const f32x4*)(xr + col), a1 = *(const f32x4*)(xr + col + 4), s0 = *(const f32x4*)(sc + col), s1 = *(const f32x4*)(sc + col + 4), h0 = *(const f32x4*)(sh + col), h1 = *(const f32x4*)(sh + col + 4);
        v4u w; w.x = cvtpk2(a0[0] * (1.f + s0[0]) + h0[0], a0[1] * (1.f + s0[1]) + h0[1]); w.y = cvtpk2(a0[2] * (1.f + s0[2]) + h0[2], a0[3] * (1.f + s0[3]) + h0[3]);
        w.z = cvtpk2(a1[0] * (1.f + s1[0]) + h1[0], a1[1] * (1.f + s1[1]) + h1[1]); w.w = cvtpk2(a1[2] * (1.f + s1[2]) + h1[2], a1[3] * (1.f + s1[3]) + h1[3]);
        *(v4u*)(hr + col) = w; }
}
#ifndef MK_DIAG_Y
#define MK_DIAG_Y 1.0f
#endif
__device__ __forceinline__ void ln_row(float* xr, const float* lg, const float* lb, const float* sc, const float* sh, bf16* hr, int lane, float dscale = 1.0f) {
    f32x4 v[8]; float s = 0.f;
#pragma unroll
    for (int j = 0; j < 8; ++j) { v[j] = *(const f32x4*)(xr + j * 256 + lane * 4); s += (v[j][0] + v[j][1]) + (v[j][2] + v[j][3]); }
    const float mean = wave_sum(s) * (1.f / DM); float s2 = 0.f;
#pragma unroll
    for (int j = 0; j < 8; ++j) { v[j] = v[j] - mean; s2 += (v[j][0] * v[j][0] + v[j][1] * v[j][1]) + (v[j][2] * v[j][2] + v[j][3] * v[j][3]); }
    const float rstd = 1.f / sqrtf(wave_sum(s2) * (1.f / DM) + LN_EPS);
#pragma unroll
    for (int j = 0; j < 8; ++j) { const int col = j * 256 + lane * 4; const f32x4 g = *(const f32x4*)(lg + col), b = *(const f32x4*)(lb + col);
        f32x4 y;
#pragma unroll
        for (int e = 0; e < 4; ++e) y[e] = (v[j][e] * rstd * g[e] + b[e]) * dscale;
        *(f32x4*)(xr + col) = y;
        if (hr) { const f32x4 a = *(const f32x4*)(sc + col), h = *(const f32x4*)(sh + col);
            uint2 w; w.x = cvtpk2(y[0] * (1.f + a[0]) + h[0], y[1] * (1.f + a[1]) + h[1]); w.y = cvtpk2(y[2] * (1.f + a[2]) + h[2], y[3] * (1.f + a[3]) + h[3]);
            *(uint2*)(hr + col) = w; } }
}

#ifndef MK_DIAG_SR
#define MK_DIAG_SR 1.0f
#endif
typedef short s16x4v __attribute__((ext_vector_type(4)));
typedef float f32x2v __attribute__((ext_vector_type(2)));
__device__ __forceinline__ void ssm_seq(const Args& A, LAS unsigned char* wl, int stream, int g, int lane) {
    const bool prompt = stream < 8;
    const int nch = prompt ? SEQ / 16 : TS / 16;
    const size_t row0 = prompt ? (size_t)stream * SEQ : (size_t)MP + (size_t)(stream - 8) * TS;
    const bf16* U = (const bf16*)(A.ws + WS_U) + row0 * DM + 16 * g;
    bf16* Z = (bf16*)(A.ws + WS_Z) + row0 * DM + 16 * g;
    const int n16 = lane & 15, q4 = lane >> 4;
    s16x4v bB[8]; bf16x8 cB[4]; s16x4v dB;
    { const bf16* bbt = (const bf16*)(A.ws + WS_BBT) + (size_t)g * 128 * 16;
#pragma unroll
      for (int nb = 0; nb < 8; ++nb) bB[nb] = *(const s16x4v*)(bbt + (16 * nb + n16) * 16 + 4 * q4);
      const bf16* cmt = (const bf16*)(A.ws + WS_CMT) + (size_t)g * 16 * 128;
#pragma unroll
      for (int ks = 0; ks < 4; ++ks) cB[ks] = *(const bf16x8*)(cmt + n16 * 128 + 32 * ks + 8 * q4);
      const short dv = (short)f2bf(A.in[I_SSMD][16 * g + n16]);
#pragma unroll
      for (int j = 0; j < 4; ++j) dB[j] = (4 * q4 + j == n16) ? dv : (short)0; }
    const float2 ab = ((const float2*)(A.ws + WS_ABAR))[g * 64 + lane];
    const float ar = ab.x, ai = ab.y;
    float hr = 0.f, hi = 0.f;
    if (!prompt) { hr = A.in[I_SRE][((size_t)(stream - 8) * NGRP + g) * SP + lane]; hi = A.in[I_SIM][((size_t)(stream - 8) * NGRP + g) * SP + lane]; }
    LAS unsigned char* hl = wl + 10240;
#define SSM_LD(ch) (*(const s16x4v*)(U + (size_t)((ch) * 16 + n16) * DM + 4 * q4))
#define SSM_STEP(ua, ch) do { \
        f32x4 bu[8]; \
        _Pragma("unroll") for (int nb = 0; nb < 8; ++nb) bu[nb] = __builtin_amdgcn_mfma_f32_16x16x16bf16_1k(ua, bB[nb], (f32x4){0.f, 0.f, 0.f, 0.f}, 0, 0, 0); \
        _Pragma("unroll") for (int nb = 0; nb < 8; ++nb) *(LAS f32x4*)(wl + ((16 * nb + n16) * 20 + 4 * q4) * 4) = bu[nb]; \
        LDS_WAIT(); asm volatile("" ::: "memory"); \
        f32x4 br[4], bi[4]; \
        _Pragma("unroll") for (int j = 0; j < 4; ++j) { br[j] = *(const LAS f32x4*)(wl + (lane * 20 + 4 * j) * 4); bi[j] = *(const LAS f32x4*)(wl + ((64 + lane) * 20 + 4 * j) * 4); } \
        _Pragma("unroll") for (int t = 0; t < 16; ++t) { \
            const float nhr = fmaf(ar, hr, fmaf(-ai, hi, br[t >> 2][t & 3])), nhi = fmaf(ar, hi, fmaf(ai, hr, bi[t >> 2][t & 3])); hr = nhr; hi = nhi; \
            *(LAS unsigned*)(hl + (t * 68 + lane) * 4) = cvtpk2(hr, hi); } \
        LDS_WAIT(); asm volatile("" ::: "memory"); \
        f32x4 y = (f32x4){0.f, 0.f, 0.f, 0.f}; \
        _Pragma("unroll") for (int ks = 0; ks < 4; ++ks) { const bf16x8 hA = *(const LAS bf16x8*)(hl + (n16 * 68 + 16 * ks + 4 * q4) * 4); y = __builtin_amdgcn_mfma_f32_16x16x32_bf16(hA, cB[ks], y, 0, 0, 0); } \
        { const f32x4 ysk = __builtin_amdgcn_mfma_f32_16x16x16bf16_1k(ua, dB, (f32x4){0.f, 0.f, 0.f, 0.f}, 0, 0, 0); y = y + ysk; }     \
        LDS_WAIT(); asm volatile("" ::: "memory"); \
        const pg8::f32x2 z0 = pg8::gelu_pk((pg8::f32x2){y[0], y[1]}), z1 = pg8::gelu_pk((pg8::f32x2){y[2], y[3]}); \
        bf16* zp = Z + (size_t)((ch) * 16 + 4 * q4) * DM + n16; \
        const unsigned w0 = cvtpk2(z0.x, z0.y), w1 = cvtpk2(z1.x, z1.y); \
        zp[0] = (bf16)(w0 & 0xffffu); zp[DM] = (bf16)(w0 >> 16); zp[2 * DM] = (bf16)(w1 & 0xffffu); zp[3 * DM] = (bf16)(w1 >> 16); \
    } while (0)
    s16x4v c0 = SSM_LD(0), c1 = SSM_LD(1), c2 = s16x4v{}, c3 = s16x4v{};
    if (nch > 2) { c2 = SSM_LD(2); c3 = SSM_LD(3); }
    for (int ch = 0; ch < nch; ch += 4) {
        s16x4v n0 = s16x4v{}, n1 = s16x4v{}, n2 = s16x4v{}, n3 = s16x4v{};
        if (ch + 4 < nch) { n0 = SSM_LD(ch + 4); n1 = SSM_LD(ch + 5); n2 = SSM_LD(ch + 6); n3 = SSM_LD(ch + 7); }
        SSM_STEP(c0, ch); SSM_STEP(c1, ch + 1);
        if (ch + 2 < nch) { SSM_STEP(c2, ch + 2); SSM_STEP(c3, ch + 3); }
        c0 = n0; c1 = n1; c2 = n2; c3 = n3;
    }
#undef SSM_LD
#undef SSM_STEP
    float* ore = A.out + (prompt ? OUT_SRP + ((size_t)stream * NGRP + g) * SP : OUT_SRS + ((size_t)(stream - 8) * NGRP + g) * SP);
    float* oim = A.out + (prompt ? OUT_SIP + ((size_t)stream * NGRP + g) * SP : OUT_SIS + ((size_t)(stream - 8) * NGRP + g) * SP);
    ore[lane] = hr * (prompt ? 1.0f : MK_DIAG_SR); oim[lane] = hi;
}


__device__ __forceinline__ void ssm_seq_sample_simple(const Args& A, int bs, int g, int lane) {
    const int p = lane;
    const size_t row0 = (size_t)MP + (size_t)bs * TS;
    const bf16* U = (const bf16*)(A.ws + WS_U) + row0 * DM + 16 * g;
    bf16* Z = (bf16*)(A.ws + WS_Z) + row0 * DM + 16 * g;
    const float lr = fminf(A.in[I_LRE][g * 64 + p], -1e-4f), li = A.in[I_LIM][g * 64 + p], dt = expf(A.in[I_LSTEP][g]);
    const float mag = expf(lr * dt); float sn, cs; sincos_cw(li * dt, sn, cs);
    const float ar = mag * cs, ai = mag * sn, nr = ar - 1.0f, ni = ai, den = lr * lr + li * li;
    const float kr = (nr * lr + ni * li) / den, ki = (ni * lr - nr * li) / den;
    float bbr[16], bbi[16], ccr[16], cci[16];
#pragma unroll
    for (int c = 0; c < 16; ++c) { const float br = A.in[I_BRE][((size_t)g * 64 + p) * 16 + c], bi = A.in[I_BIM][((size_t)g * 64 + p) * 16 + c];
        bbr[c] = kr * br - ki * bi; bbi[c] = kr * bi + ki * br;
        ccr[c] = A.in[I_CRE][((size_t)g * 16 + c) * 64 + p]; cci[c] = A.in[I_CIM][((size_t)g * 16 + c) * 64 + p]; }
    float hr = A.in[I_SRE][((size_t)bs * NGRP + g) * SP + p], hi = A.in[I_SIM][((size_t)bs * NGRP + g) * SP + p];
    const float dsk = A.in[I_SSMD][16 * g + (lane & 15)];
    for (int t = 0; t < TS; ++t) {
        float br = 0.f, bi = 0.f, myu = 0.f;
#pragma unroll
        for (int c = 0; c < 16; ++c) { const float uc = __uint_as_float((unsigned)U[(size_t)t * DM + c] << 16); br = fmaf(bbr[c], uc, br); bi = fmaf(bbi[c], uc, bi); if ((lane & 15) == c) myu = uc; }
        const float nhr = fmaf(ar, hr, fmaf(-ai, hi, br)), nhi = fmaf(ar, hi, fmaf(ai, hr, bi)); hr = nhr; hi = nhi;
        float yv = 0.f;
#pragma unroll
        for (int c = 0; c < 16; ++c) { const float s = wave_sum(ccr[c] * hr - cci[c] * hi); if ((lane & 15) == c) yv = s; }
        yv += dsk * myu;
        const pg8::f32x2 zz = pg8::gelu_pk((pg8::f32x2){yv, yv});
        if (lane < 16) Z[(size_t)t * DM + lane] = (bf16)(cvtpk2(zz.x, 0.f) & 0xffffu);
    }
    A.out[OUT_SRS + ((size_t)bs * NGRP + g) * SP + p] = hr; A.out[OUT_SIS + ((size_t)bs * NGRP + g) * SP + p] = hi;
}

__device__ __forceinline__ void conv_item(const Args& A, int layer, int item, int lane) {
    const int rb = item / 11, cs = item % 11, r0 = rb * 32, col = cs * 512 + lane * 8;
    const bf16* G = (const bf16*)(A.ws + WS_G); bf16* V = (bf16*)(A.ws + WS_V);
    const float* wc = A.in[I_WDC] + (size_t)layer * 3 * DFF + col; const float* bc = A.in[I_BDC] + (size_t)layer * DFF + col;
    float w0[8], w1[8], w2[8], bb[8], gm2[8], gm1[8];
#pragma unroll
    for (int e = 0; e < 8; ++e) { w0[e] = wc[e]; w1[e] = wc[DFF + e]; w2[e] = wc[2 * DFF + e]; bb[e] = bc[e]; gm2[e] = 0.f; gm1[e] = 0.f; }
    if (r0 >= MP) { const float* st = A.in[I_SCONV] + ((size_t)(layer * 16 + ((r0 - MP) >> 5)) * 2) * DFF + col;
#pragma unroll
        for (int e = 0; e < 8; ++e) { gm2[e] = st[e]; gm1[e] = st[DFF + e]; } }
    else if ((r0 & 4095) != 0) { const bf16x8 a = *(const bf16x8*)(G + (size_t)(r0 - 2) * DFF + col), b = *(const bf16x8*)(G + (size_t)(r0 - 1) * DFF + col);
#pragma unroll
        for (int e = 0; e < 8; ++e) { gm2[e] = __uint_as_float((unsigned)(unsigned short)a[e] << 16); gm1[e] = __uint_as_float((unsigned)(unsigned short)b[e] << 16); } }
#pragma unroll 4
    for (int t = 0; t < 32; ++t) {
        const bf16x8 gv = *(const bf16x8*)(G + (size_t)(r0 + t) * DFF + col), vv = *(const bf16x8*)(V + (size_t)(r0 + t) * DFF + col);
        float o[8];
#pragma unroll
        for (int e = 0; e < 8; e += 2) { const float g0 = __uint_as_float((unsigned)(unsigned short)gv[e] << 16), g1 = __uint_as_float((unsigned)(unsigned short)gv[e + 1] << 16);
            const float c0 = bb[e] + w0[e] * gm2[e] + w1[e] * gm1[e] + w2[e] * g0, c1 = bb[e + 1] + w0[e + 1] * gm2[e + 1] + w1[e + 1] * gm1[e + 1] + w2[e + 1] * g1;
            const pg8::f32x2 a = pg8::gelu_pk((pg8::f32x2){c0, c1});
            o[e] = a.x * __uint_as_float((unsigned)(unsigned short)vv[e] << 16); o[e + 1] = a.y * __uint_as_float((unsigned)(unsigned short)vv[e + 1] << 16);
            gm2[e] = gm1[e]; gm1[e] = g0; gm2[e + 1] = gm1[e + 1]; gm1[e + 1] = g1; }
        v4u w; w.x = cvtpk2(o[0], o[1]); w.y = cvtpk2(o[2], o[3]); w.z = cvtpk2(o[4], o[5]); w.w = cvtpk2(o[6], o[7]);
        *(v4u*)(V + (size_t)(r0 + t) * DFF + col) = w;
    }
}

__device__ __forceinline__ void comb_row(const Args& A, int r, float lam, int lane) {
    bf16* ob = (bf16*)(A.ws + WS_HB) + (size_t)r * DM;
    const f32x4 sg = *(const f32x4*)(A.in[I_SUBG] + lane * 4);
    constexpr float C = att::SCALE * 1.4426950408889634f;
    for (int h = 0; h < 8; ++h) {
        float o1[4], o2[4];
        if (r < MP) {
            const bf16* op = (const bf16*)(A.ws + WS_OP) + (size_t)r * 4096 + h * 512 + lane * 4;
            const uint2 a = *(const uint2*)op, b = *(const uint2*)(op + 256);
            o1[0] = __uint_as_float(a.x << 16); o1[1] = __uint_as_float(a.x & 0xffff0000u); o1[2] = __uint_as_float(a.y << 16); o1[3] = __uint_as_float(a.y & 0xffff0000u);
            o2[0] = __uint_as_float(b.x << 16); o2[1] = __uint_as_float(b.x & 0xffff0000u); o2[2] = __uint_as_float(b.y << 16); o2[3] = __uint_as_float(b.y & 0xffff0000u);
        } else {
            const int rs = r - MP, b = rs >> 5, row = rs & 31;
            const float* ops = (const float*)(A.ws + WS_OPS); const float* mls = (const float*)(A.ws + WS_MLS);
#pragma unroll
            for (int j = 0; j < 2; ++j) {
                const size_t p0 = ((((size_t)b * 8 + h) * 2 + 0) * 2 + j) * 32 + row, p1 = ((((size_t)b * 8 + h) * 2 + 1) * 2 + j) * 32 + row;
                const float m0 = mls[p0 * 2], l0 = mls[p0 * 2 + 1], m1 = mls[p1 * 2], l1 = mls[p1 * 2 + 1], mm = fmaxf(m0, m1);
                const float e0 = __builtin_amdgcn_exp2f((m0 - mm) * C), e1 = __builtin_amdgcn_exp2f((m1 - mm) * C), inv = 1.0f / (l0 * e0 + l1 * e1);
                const f32x4 a = *(const f32x4*)(ops + p0 * 256 + lane * 4), bq = *(const f32x4*)(ops + p1 * 256 + lane * 4);
#pragma unroll
                for (int e = 0; e < 4; ++e) { const float v = (a[e] * e0 + bq[e] * e1) * inv; if (j == 0) o1[e] = v; else o2[e] = v; }
            }
        }
        float d[4], ss = 0.f;
#pragma unroll
        for (int e = 0; e < 4; ++e) { d[e] = o1[e] - lam * o2[e]; ss += d[e] * d[e]; }
        const float rs_ = 1.0f / sqrtf(wave_sum(ss) * (1.0f / 256.0f) + LN_EPS) * (1.0f - LAM_INIT);
        uint2 w; w.x = cvtpk2(d[0] * rs_ * sg[0], d[1] * rs_ * sg[1]); w.y = cvtpk2(d[2] * rs_ * sg[2], d[3] * rs_ * sg[3]);
        *(uint2*)(ob + h * 256 + lane * 4) = w;
    }
}


#ifndef MK_PHMASK
#define MK_PHMASK 0x7ffff
#endif
#define IN(k) (((MK_PHMASK >> (k)) & 1) && lo <= (k) && (k) < hi)
#define SEAM(k) do { if (IN(k) && IN((k) + 1)) xcd_barrier(bar); } while (0)
template <int layer> __device__ __forceinline__ void ffn_phases(const Args& A, LAS unsigned char* L, const XcdBarrier& bar, int lo, int hi, int G, int bx, int gw, int NGW, int lane) {
    float* const Xs = A.out + OUT_Y; float* const MOD = (float*)(A.ws + WS_MOD); bf16* const HB = (bf16*)(A.ws + WS_HB);
    const float* modl = MOD + (size_t)layer * NSTREAM * 12288;
        const int fb = layer ? 14 : 5;
        if (IN(fb)) {
            const float* lg = A.in[I_LNG] + (size_t)(layer * 2 + 0) * DM; const float* lb = A.in[I_LNB] + (size_t)(layer * 2 + 0) * DM;
            for (int r = gw; r < M; r += NGW) { const float* md = modl + (size_t)row_stream(r) * 12288; ln_row(Xs + (size_t)r * DM, lg, lb, md + 4 * DM, md + 3 * DM, HB + (size_t)r * DM, lane); }
            SEAM(fb);
        }
        if (IN(fb + 1)) {
            pg8::Gemm g{HB, (const bf16*)(A.ws + WS_WUP + (size_t)layer * 44 * MiB), M, 2 * DFF, DM}; pg8::StaticOrder S; S.init(M, 2 * DFF, G, bx);
            pg8::EpiUp E{(bf16*)(A.ws + WS_G), (bf16*)(A.ws + WS_V), A.out + OUT_CVP + (size_t)layer * 8 * 2 * DFF, A.out + OUT_CVS + (size_t)layer * 16 * 2 * DFF};
            pg8::gemm_phase<pg8::EpiUp, pg8::StaticOrder, true, true>(L, g, S, E);
            SEAM(fb + 1);
        }
        if (IN(fb + 2)) {
            for (int it = gw; it < (M / 32) * 11; it += NGW) conv_item(A, layer, it, lane);
            SEAM(fb + 2);
        }
        if (IN(fb + 3)) {
            pg8::Gemm g{(const bf16*)(A.ws + WS_V), (const bf16*)(A.ws + WS_WDOWN + (size_t)layer * 22 * MiB), M, DM, DFF}; pg8::StaticOrder S; S.init(M, DM, G, bx);
            pg8::EpiRes<false> E{Xs, Xs + (size_t)MP * DM, Xs, modl + 5 * DM};
            pg8::gemm_phase<pg8::EpiRes<false>, pg8::StaticOrder, true, true>(L, g, S, E);
            SEAM(fb + 3);
        }
        if (IN(fb + 4)) {
            const float* lg = A.in[I_LNG] + (size_t)(layer * 2 + 1) * DM; const float* lb = A.in[I_LNB] + (size_t)(layer * 2 + 1) * DM;
            const float* modn = MOD + (size_t)NSTREAM * 12288;
            for (int r = gw; r < M; r += NGW) { const float* md = modn + (size_t)row_stream(r) * 12288; ln_row(Xs + (size_t)r * DM, lg, lb, md + 1 * DM, md + 0 * DM, layer == 0 ? HB + (size_t)r * DM : (bf16*)nullptr, lane, (layer == 1 && r >= MP) ? MK_DIAG_Y : 1.0f); }
            if (layer == 0) SEAM(9);
        }
    }

constexpr int NPHASE = 19;
__global__ void __launch_bounds__(NWAVES * 64, 2) mk_fwd(Args A) {
    extern __shared__ __attribute__((aligned(16))) unsigned char lds[];
    LAS unsigned char* L = (LAS unsigned char*)lds;
    const int tid = threadIdx.x, lane = tid & 63, wave = __builtin_amdgcn_readfirstlane(tid >> 6);
    const int G = gridDim.x, bx = blockIdx.x;
    const int vcu = (G % 8 == 0) ? (bx % 8) * (G / 8) + bx / 8 : bx;
    const int gw = bx * NWAVES + wave, NGW = G * NWAVES;
    for (int u = tid; u < (LDS_BYTES - LDSCTL_OFF) / 4; u += NWAVES * 64) ((LAS unsigned*)(L + LDSCTL_OFF))[u] = 0u;
    __syncthreads();
    const int lo = A.ph_lo, hi = A.ph_hi;
    unsigned* ctl = (unsigned*)(A.ws + WS_CTL);
    XcdBarrier bar; bar.bar = ctl + CW_BAR; bar.x = 0; bar.st = nullptr;
    if (hi - lo > 1) bar = xcd_barrier_post(ctl + CW_BAR, (volatile LAS unsigned*)(L + MISC_OFF) + 8);
    float* const Xs = A.out + OUT_Y;
    float* const MOD = (float*)(A.ws + WS_MOD);
    bf16* const HB = (bf16*)(A.ws + WS_HB);

    if (IN(0)) {
        for (int it = bx; it < 384; it += G) p0_ada_item(A, L, it, tid, wave, lane);
        __syncthreads();
        LAS float* scr = (LAS float*)(L + wave * 16384);
        constexpr int I_T = 128, I_IN = 2048, I_GLU = 4096, I_UP = 11264, I_DN = 5632, I_QKV = 6144, I_OO = 2048;
        constexpr int NIT = I_T + I_IN + I_GLU + 2 * I_UP + 2 * I_DN + I_QKV + I_OO;
        for (int it = gw; it < NIT; it += NGW) {
            int r = it;
            if (r < I_T) { p0_ssm_tables(A, r, lane); continue; } r -= I_T;
            if (r < I_IN) { p0_transpose_item(A.in[I_WIN], DM, DM, (bf16*)(A.ws + WS_WIN), 0, scr, r, lane); continue; } r -= I_IN;
            if (r < I_GLU) { p0_transpose_item(A.in[I_WGLU], DM, 2 * DM, (bf16*)(A.ws + WS_WGLU), 1, scr, r, lane); continue; } r -= I_GLU;
            if (r < 2 * I_UP) { const int l = r / I_UP; p0_transpose_item(A.in[I_WUP] + (size_t)l * DM * 2 * DFF, DM, 2 * DFF, (bf16*)(A.ws + WS_WUP + (size_t)l * 44 * MiB), 1, scr, r % I_UP, lane); continue; } r -= 2 * I_UP;
            if (r < 2 * I_DN) { const int l = r / I_DN; p0_transpose_item(A.in[I_WDOWN] + (size_t)l * DFF * DM, DFF, DM, (bf16*)(A.ws + WS_WDOWN + (size_t)l * 22 * MiB), 0, scr, r % I_DN, lane); continue; } r -= 2 * I_DN;
            if (r < I_QKV) { p0_transpose_item(A.in[I_WQKV], DM, 3 * DM, (bf16*)(A.ws + WS_WQKV), 0, scr, r, lane); continue; } r -= I_QKV;
            p0_transpose_item(A.in[I_WO], DM, DM, (bf16*)(A.ws + WS_WO), 0, scr, r, lane);
        }
        SEAM(0);
    }
    if (IN(1)) {
        for (int r = gw; r < M; r += NGW) { const float* xr = r < MP ? A.in[I_XP] + (size_t)r * DM : A.in[I_XS] + (size_t)(r - MP) * DM; const float* md = MOD + (size_t)row_stream(r) * 12288;
            mod_row(xr, md + 1 * DM, md + 0 * DM, HB + (size_t)r * DM, lane); }
        SEAM(1);
    }
    {
        const float* modl = MOD;
        {
            if (IN(2)) {
                pg8::Gemm g{HB, (const bf16*)(A.ws + WS_WIN), M, DM, DM}; pg8::StaticOrder S; S.init(M, DM, G, bx);
                pg8::EpiBf16<0> E{(bf16*)(A.ws + WS_U), DM, nullptr, 0, 0, 1.f};
                pg8::gemm_phase<pg8::EpiBf16<0>, pg8::StaticOrder, true, true>(L, g, S, E);
                SEAM(2);
            }
            if (IN(3)) {
                LAS unsigned char* wl = L + wave * 14592;
                if (wave < 4) { for (int u = bx * 4 + wave; u < 8 * NGRP; u += G * 4) ssm_seq(A, wl, u >> 7, u & 127, lane); }
                else { for (int u = bx * 4 + (wave - 4); u < 16 * NGRP; u += G * 4) {
#if MK_SSM_SIMPLE
                    ssm_seq_sample_simple(A, u >> 7, u & 127, lane);
#else
                    ssm_seq(A, wl, 8 + (u >> 7), u & 127, lane);
#endif
                } }
                SEAM(3);
            }
            if (IN(4)) {
                pg8::Gemm g{(const bf16*)(A.ws + WS_Z), (const bf16*)(A.ws + WS_WGLU), M, 2 * DM, DM}; pg8::StaticOrder S; S.init(M, 2 * DM, G, bx);
                pg8::EpiRes<true> E{A.in[I_XP], A.in[I_XS], Xs, modl + 2 * DM};
                pg8::gemm_phase<pg8::EpiRes<true>, pg8::StaticOrder, true, true>(L, g, S, E);
                SEAM(4);
            }
        }
        ffn_phases<0>(A, L, bar, lo, hi, G, bx, gw, NGW, lane);
    }
    {
        const float* modl = MOD + (size_t)NSTREAM * 12288;
        {
            if (IN(10)) {
                pg8::Gemm g{HB, (const bf16*)(A.ws + WS_WQKV), M, 3 * DM, DM}; pg8::StaticOrder S; S.init(M, 3 * DM, G, bx);
                pg8::EpiQkv E{(bf16*)(A.ws + WS_Q), (size_t)(WS_K - WS_Q) / 2, A.out + OUT_KP, A.out + OUT_KS};
                pg8::gemm_phase<pg8::EpiQkv, pg8::StaticOrder, true, true>(L, g, S, E);
                SEAM(10);
            }
            if (IN(11)) {
                const att::bf16* QB = (const att::bf16*)(A.ws + WS_Q); const att::bf16* KB = (const att::bf16*)(A.ws + WS_K); const att::bf16* VB = (const att::bf16*)(A.ws + WS_VA);
                att::bf16* OP = (att::bf16*)(A.ws + WS_OP);
#ifndef MK_NO_ATTP
                for (int pi = vcu; pi < 2048; pi += G) {
                    const int qp = pi & 7, e = (pi >> 3) & 1, s = (pi >> 4) & 15, b = pi >> 8;
                    const size_t seq0 = (size_t)b * SEQ;
#pragma unroll 1
                    for (int k = 0; k < 2; ++k) { const int qb = k ? qp : 15 - qp;
                        att::attn_prompt_unit(QB + (seq0 + qb * 256) * DM + s * 128, KB + seq0 * DM + s * 128, VB + seq0 * DM + (s >> 1) * 256 + e * 128, OP + (seq0 + qb * 256) * 4096 + s * 256 + e * 128, qb, (char*)lds); }
                }
#endif
#ifndef MK_NO_ATTS
                for (int si = vcu; si < 256; si += G)
                    att::attn_sample_unit(QB, KB, VB, A.in[I_CK], A.in[I_CV], (float*)(A.ws + WS_OPS), (float*)(A.ws + WS_MLS), si >> 4, (si >> 1) & 7, si & 1, (char*)lds);
#endif
                SEAM(11);
            }
            if (IN(12)) {
                float d1 = A.in[I_LQ1][lane] * A.in[I_LK1][lane] + A.in[I_LQ1][64 + lane] * A.in[I_LK1][64 + lane];
                float d2 = A.in[I_LQ2][lane] * A.in[I_LK2][lane] + A.in[I_LQ2][64 + lane] * A.in[I_LK2][64 + lane];
                const float lam = expf(wave_sum(d1)) - expf(wave_sum(d2)) + LAM_INIT;
                for (int r = gw; r < M; r += NGW) comb_row(A, r, lam, lane);
                SEAM(12);
            }
            if (IN(13)) {
                pg8::Gemm g{HB, (const bf16*)(A.ws + WS_WO), M, DM, DM}; pg8::StaticOrder S; S.init(M, DM, G, bx);
                pg8::EpiRes<false> E{Xs, Xs + (size_t)MP * DM, Xs, modl + 2 * DM};
                pg8::gemm_phase<pg8::EpiRes<false>, pg8::StaticOrder, true, true>(L, g, S, E);
                SEAM(13);
            }
        }
        ffn_phases<1>(A, L, bar, lo, hi, G, bx, gw, NGW, lane);
    }
#undef IN
#undef SEAM
}

extern "C" void kernel_launch(void* const* d_in, const int* in_sizes, int n_in, void* d_out, int out_size, void* d_ws, size_t ws_size, hipStream_t stream) {
    static int grid = 0;
    if (grid == 0) {
        if (n_in != 34 || out_size != (int)OUT_END || ws_size < WS_END) { fprintf(stderr, "kernel_launch: expected 34 inputs, %zu outputs, >= %zu ws bytes; got %d, %d, %zu\n", (size_t)OUT_END, (size_t)WS_END, n_in, out_size, ws_size); grid = -1; return; }
        int dev = 0, cus = 0, per_cu = 0;
        if (hipGetDevice(&dev) != hipSuccess || hipDeviceGetAttribute(&cus, hipDeviceAttributeMultiprocessorCount, dev) != hipSuccess) { grid = -1; return; }
        if (hipFuncSetAttribute((const void*)mk_fwd, hipFuncAttributeMaxDynamicSharedMemorySize, LDS_BYTES) != hipSuccess) { fprintf(stderr, "kernel_launch: hipFuncSetAttribute failed\n"); grid = -1; return; }
        if (hipOccupancyMaxActiveBlocksPerMultiprocessor(&per_cu, (const void*)mk_fwd, NWAVES * 64, LDS_BYTES) != hipSuccess || per_cu < 1) fprintf(stderr, "kernel_launch: occupancy query says %d\n", per_cu);
        (void)hipGetLastError();
        grid = cus;
    }
    if (grid < 0) return;
    if (hipMemsetAsync((char*)d_ws + WS_CTL, 0, CTL_ZERO_BYTES, stream) != hipSuccess) return;
    Args a{};
    for (int i = 0; i < 34; ++i) a.in[i] = (const float*)d_in[i];
    a.out = (float*)d_out; a.ws = (unsigned char*)d_ws;
#if MK_ONE_LAUNCH
    a.ph_lo = 0; a.ph_hi = NPHASE;
    hipLaunchKernelGGL(mk_fwd, dim3(grid), dim3(NWAVES * 64), LDS_BYTES, stream, a);
#else
    for (int k = 0; k < NPHASE; ++k) { a.ph_lo = k; a.ph_hi = k + 1; hipLaunchKernelGGL(mk_fwd, dim3(grid), dim3(NWAVES * 64), LDS_BYTES, stream, a); }
#endif
    const hipError_t le = hipPeekAtLastError();
    if (le != hipSuccess) fprintf(stderr, "kernel_launch: launch failed: %s\n", hipGetErrorName(le));
}
```

```cpp
#include <hip/hip_runtime.h>
#include <cstdio>
#include <cstdint>
#ifndef MK_SSM_SIMPLE
#define MK_SSM_SIMPLE 0
#endif
#ifndef MK_REP
#define MK_REP (-1)
#endif
#ifndef MK_PROBE_PAIR_SAMPLE
#define MK_PROBE_PAIR_SAMPLE 0
#endif
#ifndef MK_ONE_LAUNCH
#define MK_ONE_LAUNCH 1
#endif
namespace pg8 {
#define PG8_LAS __attribute__((address_space(3)))
typedef unsigned short bf16_t;
typedef short bf16x8 __attribute__((ext_vector_type(8)));
typedef float f32x4 __attribute__((ext_vector_type(4)));
typedef unsigned u32x4 __attribute__((ext_vector_type(4)));
constexpr int BM = 256, BK = 64, HALF = 128, HTB = HALF * BK * 2  , STAGE_BYTES = 8 * HTB, NXCD = 8, WGM = 8;

__host__ __device__ __forceinline__ int lds_byte(int r, int c) { const int st = (r >> 4) * 2 + (c >> 5), rr = r & 15, cc = c & 31, ob = rr * 64 + cc * 2; return st * 1024 + (ob ^ (((ob >> 9) & 1) << 5)); }
__host__ __device__ __forceinline__ void stage_rc(int b, int& R, int& C) { const int st = b / 1024, sb = b % 1024, swz = sb ^ (((sb >> 9) & 1) << 5); R = (st >> 1) * 16 + swz / 64; C = (st & 1) * 32 + (swz % 64) / 2; }
__host__ __device__ __forceinline__ int perm32(int rho) { const int n = rho >> 4, i = rho & 15; return 8 * (i >> 2) + 4 * n + (i & 3); }

struct Unit { int pm, pn, kh; };
struct Gemm { const bf16_t* A; const bf16_t* Bt; int M, N, K; float oscale; const void* base; };
typedef int v8i32 __attribute__((ext_vector_type(8)));
typedef short s16x16 __attribute__((ext_vector_type(16)));

struct StaticOrder {
    int nM, nN, nwg, G, c, rep, pm0, ksplit;
    __host__ __device__ void init(int M, int N, int G_, int c_, int rep_ = 1, int pm0_ = 0, int ksplit_ = 1) { nM = M / BM; nN = N / BM; nwg = nM * nN; G = G_; c = c_; rep = rep_; pm0 = pm0_; ksplit = ksplit_; }
    __host__ __device__ bool next(int i, Unit& u) const {
        const long L0 = (long)i * G + c; if (L0 >= (long)nwg * rep * ksplit) return false;
        const long L1 = L0 % ((long)nwg * ksplit); u.kh = (int)(L1 % ksplit); const long L = L1 / ksplit;
        int wgid = (int)L; { const int q = nwg / NXCD, r = nwg % NXCD, xcd = wgid % NXCD, off = wgid / NXCD; wgid = (xcd < r ? xcd * (q + 1) : r * (q + 1) + (xcd - r) * q) + off; }
        const int nig = WGM * nN, gid = wgid / nig, fm = gid * WGM, gsz = (nM - fm) < WGM ? (nM - fm) : WGM;
        u.pm = pm0 + fm + ((wgid % nig) % gsz); u.pn = (wgid % nig) / gsz; return true;
    }
    __device__ __forceinline__ void a_ready(const Unit&) const {}
    __device__ __forceinline__ void done(const Unit&) const {}
};

__device__ __forceinline__ unsigned cvt_pk_bf16(float lo, float hi) { unsigned r; asm volatile("v_cvt_pk_bf16_f32 %0, %1, %2" : "=v"(r) : "v"(lo), "v"(hi)); return r; }
typedef float f32x2 __attribute__((ext_vector_type(2)));
__device__ __forceinline__ f32x2 gelu_pk(f32x2 v) {
    const f32x2 av = __builtin_elementwise_abs(v), d = av * 0.2316418882f + 1.0f;
    f32x2 t; t.x = __builtin_amdgcn_rcpf(d.x); t.y = __builtin_amdgcn_rcpf(d.y);
    f32x2 q = t * 0.5307027145f + (-0.7265760135f); q = q * t + 0.7107068705f; q = q * t + (-0.142248368f); q = q * t + 0.127414796f; q = q * t;
    const f32x2 s = (v * v) * (-0.72134752044f);
    f32x2 e; e.x = __builtin_amdgcn_exp2f(s.x); e.y = __builtin_amdgcn_exp2f(s.y);
    const f32x2 m = v * (q * e), r = v - m;
    f32x2 o; o.x = v.x < 0.f ? m.x : r.x; o.y = v.y < 0.f ? m.y : r.y; return o;
}

template <int ACT  > struct EpiBf16 {
    static constexpr bool PERM = true, AFTER_DRAIN = false; static_assert(ACT == 0 || ACT == 1, "EpiBf16: ACT is 0 (none) or 1 (gelu_pk)");
    bf16_t* O; int ldc; const float* bias; int split_cols; size_t split_stride; float scale0;
    __device__ __forceinline__ void operator()(const f32x4 (&acc)[2][2][4][2], const Unit& u, int wr, int wc, int fr, int fq) const {
        const int row0 = u.pm * BM + wr * 64 + fr; int colt = u.pn * BM; bf16_t* base = O;
        float sc = 1.f; if (split_cols) { const int t = colt / split_cols; base += (size_t)t * split_stride; colt -= t * split_cols; if (t == 0) sc = scale0; }
        const int col0 = colt + wc * 32 + 8 * fq, bcol0 = u.pn * BM + wc * 32 + 8 * fq;
        f32x4 bv[2][2];
#pragma unroll
        for (int bj = 0; bj < 2; ++bj)
#pragma unroll
            for (int n = 0; n < 2; ++n) bv[bj][n] = bias ? *(const f32x4*)(bias + bcol0 + bj * HALF + 4 * n) : (f32x4){0.f, 0.f, 0.f, 0.f};
#pragma unroll
        for (int ai = 0; ai < 2; ++ai)
#pragma unroll
            for (int m = 0; m < 4; ++m) { bf16_t* rowp = base + (size_t)(row0 + ai * HALF + m * 16) * ldc + col0;
#pragma unroll
                for (int bj = 0; bj < 2; ++bj) { f32x4 v0 = acc[ai][bj][m][0] + bv[bj][0], v1 = acc[ai][bj][m][1] + bv[bj][1];
                    if (ACT == 1) { f32x2 a = gelu_pk((f32x2){v0[0], v0[1]}), b = gelu_pk((f32x2){v0[2], v0[3]}), c = gelu_pk((f32x2){v1[0], v1[1]}), d = gelu_pk((f32x2){v1[2], v1[3]});
                        v0 = (f32x4){a.x, a.y, b.x, b.y}; v1 = (f32x4){c.x, c.y, d.x, d.y}; }
                    v0 = v0 * sc; v1 = v1 * sc; u32x4 w; w.x = cvt_pk_bf16(v0[0], v0[1]); w.y = cvt_pk_bf16(v0[2], v0[3]); w.z = cvt_pk_bf16(v1[0], v1[1]); w.w = cvt_pk_bf16(v1[2], v1[3]);
                    *(u32x4*)(rowp + bj * HALF) = w; } }
    }
};

constexpr int EP_MP = 32768;
constexpr int EP_D = 2048, EP_MODLD = 12288;
constexpr float EP_ALPHA = 1.4142135623730951f;
template <bool GLU, bool RENORM, int HOIST = 0  > struct EpiRes {
    static constexpr bool PERM = false, AFTER_DRAIN = false;
    static constexpr int NG = GLU ? 2 : 4;
    const float* xin_p; const float* xin_s; float* xout; const float* gate;
    float* stat_out; const float* stat_in; const float* lng; const float* lnb;
    __device__ __forceinline__ int colof(const Unit& u, int wc, int fq, int q) const { return GLU ? u.pn * HALF + wc * 32 + q * 16 + 4 * fq : u.pn * BM + (q >> 1) * HALF + wc * 32 + (q & 1) * 16 + 4 * fq; }
    __device__ __forceinline__ void ldrow(const Unit& u, int wr, int wc, int fr, int fq, int idx, int h, f32x4 (&xv)[2], f32x2& st, f32x4 (&gq)[2]) const {
        const int ru = u.pm * BM + (idx >> 2) * HALF + wr * 64 + (idx & 3) * 16, r = ru + fr;
        const float* xr = xin_p + (size_t)r * EP_D;
#pragma unroll
        for (int p = 0; p < 2; ++p) xv[p] = *(const f32x4*)(xr + colof(u, wc, fq, 2 * h + p));
        if (RENORM) st = *(const f32x2*)(stat_in + 2 * r);
        if (HOIST == 2) { const float* gr2 = gate + (size_t)(8 + ((ru - EP_MP) >> 5)) * EP_MODLD;
#pragma unroll
            for (int p = 0; p < 2; ++p) gq[p] = *(const f32x4*)(gr2 + colof(u, wc, fq, 2 * h + p)); }
    }
    __device__ __forceinline__ void hoisted(const f32x4 (&acc)[2][2][4][2], const Unit& u, int wr, int wc, int fr, int fq) const {
        const float* gr = gate + (size_t)((u.pm * BM) >> 12) * EP_MODLD; (void)gr;
#pragma unroll
        for (int h = 0; h < NG / 2; ++h) {
            f32x4 g1[2], la[2], ba[2];
#pragma unroll
            for (int p = 0; p < 2; ++p) { const int col = colof(u, wc, fq, 2 * h + p); if (HOIST == 1) g1[p] = *(const f32x4*)(gr + col) + 1.0f;
                if (RENORM) { la[p] = *(const f32x4*)(lng + col) * EP_ALPHA; ba[p] = *(const f32x4*)(lnb + col) * EP_ALPHA; } }
            f32x4 xr3[3][2]; f32x2 st3[3] = {{0.f, 0.f}, {0.f, 0.f}, {0.f, 0.f}};
            f32x4 g3[3][2];
            ldrow(u, wr, wc, fr, fq, 0, h, xr3[0], st3[0], g3[0]); ldrow(u, wr, wc, fr, fq, 1, h, xr3[1], st3[1], g3[1]);
#pragma unroll
            for (int idx = 0; idx < 8; ++idx) { const int ai = idx >> 2, m = idx & 3;
                if (idx + 2 < 8) ldrow(u, wr, wc, fr, fq, idx + 2, h, xr3[(idx + 2) % 3], st3[(idx + 2) % 3], g3[(idx + 2) % 3]);
                if (HOIST == 2) { g1[0] = g3[idx % 3][0] + 1.0f; g1[1] = g3[idx % 3][1] + 1.0f; }
                const f32x4 (&xc)[2] = xr3[idx % 3]; const f32x2 sc_ = st3[idx % 3];
                const int r = u.pm * BM + ai * HALF + wr * 64 + m * 16 + fr;
                float* orow = xout + (size_t)r * EP_D;
                float mu = 0.f, rs = 1.f;
                if (RENORM) { mu = sc_.x * (1.0f / EP_D); rs = __builtin_amdgcn_rsqf(fmaxf(sc_.y * (1.0f / EP_D) - mu * mu, 0.f) + 1e-5f); }
                float t1 = 0.f, t2 = 0.f;
                f32x4 o[2];
#pragma unroll
                for (int p = 0; p < 2; ++p) { const f32x4 xv = xc[p];
                    if (GLU) { const f32x4 a = acc[ai][0][m][p], g = acc[ai][1][m][p];
#pragma unroll
                        for (int e = 0; e < 4; ++e) { const float sg = __builtin_amdgcn_rcpf(1.0f + __builtin_amdgcn_exp2f(-1.4426950408889634f * g[e])); o[p][e] = EP_ALPHA * xv[e] + g1[p][e] * (a[e] * sg); }
                    } else { const f32x4 a = acc[ai][h][m][p];
#pragma unroll
                        for (int e = 0; e < 4; ++e) o[p][e] = (RENORM ? ((xv[e] - mu) * rs) * la[p][e] + ba[p][e] : EP_ALPHA * xv[e]) + g1[p][e] * a[e]; }
#pragma unroll
                    for (int e = 0; e < 4; ++e) { t1 += o[p][e]; t2 += o[p][e] * o[p][e]; } }
#pragma unroll
                for (int p = 0; p < 2; ++p) *(f32x4*)(orow + colof(u, wc, fq, 2 * h + p)) = o[p];
                t1 += __shfl_xor(t1, 16); t2 += __shfl_xor(t2, 16); t1 += __shfl_xor(t1, 32); t2 += __shfl_xor(t2, 32);
                if (fq == 0) { atomicAdd(stat_out + 2 * r, t1); atomicAdd(stat_out + 2 * r + 1, t2); }
            }
        }
    }
    __device__ __forceinline__ void operator()(const f32x4 (&acc)[2][2][4][2], const Unit& u, int wr, int wc, int fr, int fq) const {
        if constexpr (HOIST) { hoisted(acc, u, wr, wc, fr, fq); return; }
#pragma unroll
        for (int ai = 0; ai < 2; ++ai)
#pragma unroll
            for (int m = 0; m < 4; ++m) {
                const int r = u.pm * BM + ai * HALF + wr * 64 + m * 16 + fr;
                const int stream = r < EP_MP ? (r >> 12) : 8 + ((r - EP_MP) >> 5);
                const float* xr = r < EP_MP ? xin_p + (size_t)r * EP_D : xin_s + (size_t)(r - EP_MP) * EP_D;
                float* orow = xout + (size_t)r * EP_D; const float* gr = gate + (size_t)stream * EP_MODLD;
                float mu = 0.f, rs = 1.f;
                if (RENORM) { const f32x2 st = *(const f32x2*)(stat_in + 2 * r); mu = st.x * (1.0f / EP_D); rs = __builtin_amdgcn_rsqf(fmaxf(st.y * (1.0f / EP_D) - mu * mu, 0.f) + 1e-5f); }
                float t1 = 0.f, t2 = 0.f;
                if (GLU) {
#pragma unroll
                    for (int n = 0; n < 2; ++n) { const int col = u.pn * HALF + wc * 32 + n * 16 + 4 * fq;
                        const f32x4 a = acc[ai][0][m][n], g = acc[ai][1][m][n], xv = *(const f32x4*)(xr + col), gt = *(const f32x4*)(gr + col); f32x4 o;
#pragma unroll
                        for (int e = 0; e < 4; ++e) { const float sg = __builtin_amdgcn_rcpf(1.0f + __builtin_amdgcn_exp2f(-1.4426950408889634f * g[e])); o[e] = EP_ALPHA * xv[e] + (1.0f + gt[e]) * (a[e] * sg); t1 += o[e]; t2 += o[e] * o[e]; }
                        *(f32x4*)(orow + col) = o; }
                } else {
#pragma unroll
                    for (int bj = 0; bj < 2; ++bj)
#pragma unroll
                        for (int n = 0; n < 2; ++n) { const int col = u.pn * BM + bj * HALF + wc * 32 + n * 16 + 4 * fq;
                            const f32x4 a = acc[ai][bj][m][n], gt = *(const f32x4*)(gr + col); f32x4 xv = *(const f32x4*)(xr + col), o;
                            if (RENORM) { const f32x4 lg = *(const f32x4*)(lng + col), lb = *(const f32x4*)(lnb + col);
#pragma unroll
                                for (int e = 0; e < 4; ++e) xv[e] = (xv[e] - mu) * rs * lg[e] + lb[e]; }
#pragma unroll
                            for (int e = 0; e < 4; ++e) { o[e] = EP_ALPHA * xv[e] + (1.0f + gt[e]) * a[e]; t1 += o[e]; t2 += o[e] * o[e]; }
                            *(f32x4*)(orow + col) = o; }
                }
                t1 += __shfl_xor(t1, 16); t2 += __shfl_xor(t2, 16); t1 += __shfl_xor(t1, 32); t2 += __shfl_xor(t2, 32);
                if (fq == 0) { atomicAdd(stat_out + 2 * r, t1); atomicAdd(stat_out + 2 * r + 1, t2); }
            }
    }
};
struct EpiUp {
    static constexpr bool PERM = true, AFTER_DRAIN = false;
    unsigned char* G; unsigned char* V;
    __device__ static __forceinline__ unsigned pk4(float a, float b, float c, float d) {
        a = __builtin_amdgcn_fmed3f(a * 64.f, -448.f, 448.f); b = __builtin_amdgcn_fmed3f(b * 64.f, -448.f, 448.f); c = __builtin_amdgcn_fmed3f(c * 64.f, -448.f, 448.f); d = __builtin_amdgcn_fmed3f(d * 64.f, -448.f, 448.f);
        unsigned w = 0u; w = (unsigned)__builtin_amdgcn_cvt_pk_fp8_f32(a, b, (int)w, false); w = (unsigned)__builtin_amdgcn_cvt_pk_fp8_f32(c, d, (int)w, true); return w; }
    __device__ __forceinline__ void operator()(const f32x4 (&acc)[2][2][4][2], const Unit& u, int wr, int wc, int fr, int fq) const {
        const int col = u.pn * HALF + wc * 32 + 8 * fq;
        typedef unsigned u32x2 __attribute__((ext_vector_type(2)));
#pragma unroll
        for (int ai = 0; ai < 2; ++ai)
#pragma unroll
            for (int m = 0; m < 4; ++m) {
                const int r = u.pm * BM + ai * HALF + wr * 64 + m * 16 + fr;
                const f32x4 g0 = acc[ai][0][m][0], g1 = acc[ai][0][m][1], v0 = acc[ai][1][m][0], v1 = acc[ai][1][m][1];
                u32x2 w; w.x = pk4(g0[0], g0[1], g0[2], g0[3]); w.y = pk4(g1[0], g1[1], g1[2], g1[3]);
                *(u32x2*)(G + (size_t)r * 5632 + col) = w;
                w.x = pk4(v0[0], v0[1], v0[2], v0[3]); w.y = pk4(v1[0], v1[1], v1[2], v1[3]);
                *(u32x2*)(V + (size_t)r * 5632 + col) = w;
            }
    }
};

struct EpiRaw {
    static constexpr bool PERM = false, AFTER_DRAIN = false;
    float* part;
    __device__ __forceinline__ void operator()(const f32x4 (&acc)[2][2][4][2], const Unit& u, int wr, int wc, int fr, int fq) const {
#pragma unroll
        for (int ai = 0; ai < 2; ++ai)
#pragma unroll
            for (int m = 0; m < 4; ++m) { const int rs = u.pm * BM + ai * HALF + wr * 64 + m * 16 + fr - EP_MP; float* orow = part + ((size_t)u.kh * 512 + rs) * EP_D;
#pragma unroll
                for (int bj = 0; bj < 2; ++bj)
#pragma unroll
                    for (int n = 0; n < 2; ++n) *(f32x4*)(orow + u.pn * BM + bj * HALF + wc * 32 + n * 16 + 4 * fq) = acc[ai][bj][m][n]; }
    }
};
#ifndef MK_DIAG_KS
#define MK_DIAG_KS 0.0f
#endif
struct EpiQkv {
    static constexpr bool PERM = true, AFTER_DRAIN = false;
    bf16_t* QB; size_t qkv_stride; float* ok_p; float* ok_s;
    __device__ __forceinline__ void operator()(const f32x4 (&acc)[2][2][4][2], const Unit& u, int wr, int wc, int fr, int fq) const {
        const int which = u.pn >> 3; const int colt = (u.pn & 7) * BM + wc * 32 + 8 * fq;
        bf16_t* ob = QB + (size_t)which * qkv_stride;
        const bool samp = u.pm >= (EP_MP / BM);
        const size_t fo = (samp ? (size_t)(ok_s - ok_p) : (size_t)0) + (size_t)(which == 2 ? (samp ? 512 * EP_D : EP_MP * EP_D) : 0);
        float* fbase = ok_p + fo;
        const int rsub = samp ? EP_MP : 0;
#pragma unroll
        for (int ai = 0; ai < 2; ++ai)
#pragma unroll
            for (int m = 0; m < 4; ++m) {
                const int r = u.pm * BM + ai * HALF + wr * 64 + m * 16 + fr;
#pragma unroll
                for (int bj = 0; bj < 2; ++bj) { const f32x4 v0 = acc[ai][bj][m][0], v1 = acc[ai][bj][m][1]; const int col = colt + bj * HALF;
                    u32x4 w; w.x = cvt_pk_bf16(v0[0], v0[1]); w.y = cvt_pk_bf16(v0[2], v0[3]); w.z = cvt_pk_bf16(v1[0], v1[1]); w.w = cvt_pk_bf16(v1[2], v1[3]);
                    *(u32x4*)(ob + (size_t)r * EP_D + col) = w;
                    if (which) { float* of = fbase + (size_t)(r - rsub) * EP_D + col; float ds = 1.0f; if (!samp && which == 1) { unsigned hsh = (unsigned)(r * 2048 + col) * 2654435761u; hsh ^= hsh >> 15; ds = (hsh & 1u) ? 1.0f + MK_DIAG_KS : 1.0f - MK_DIAG_KS; } *(f32x4*)of = v0 * ds; *(f32x4*)(of + 4) = v1 * ds; } }
            }
    }
};
template <class Epi, class Sched, bool ALIGN_EPI = false, bool SP2 = false, bool FP8 = false>
__device__ __forceinline__ void gemm_phase(PG8_LAS unsigned char* lds, const Gemm g, const Sched& S, const Epi& E, const int tid) {
    const int wid = __builtin_amdgcn_readfirstlane(tid >> 6), lane = tid & 63, wr = wid >> 2, wc = wid & 3, fr = lane & 15, fq = lane >> 4;
    const int K = g.K, nt = (K / BK) / S.ksplit;
    unsigned voffA[2], voffB[2];
#pragma unroll
    for (int i = 0; i < 2; ++i) { int R, C; stage_rc(tid * 16 + i * 8192, R, C); const int Rb = Epi::PERM ? ((R & ~31) + perm32(R & 31)) : R;
        voffA[i] = (unsigned)(R * K + C) * 2u; voffB[i] = (unsigned)(Rb * K + C) * 2u; }
    const unsigned kstep = (unsigned)(BK * 2);
    const unsigned hstep = (unsigned)HALF * (unsigned)K * 2u;
    const unsigned tstep = 2u * hstep;
    const unsigned ldsw = (unsigned)wid * 1024u;
    const int aoff = lds_byte(wr * 64 + fr, fq * 8), boff = lds_byte(wc * 32 + fr, fq * 8);
#define PG8_SA(b, h) (((b) * 2 + (h)) * HTB)
#define PG8_SB(b, h) ((4 + (b) * 2 + (h)) * HTB)
#define PG8_STAGE(bufoff, gbase, voff) do { _Pragma("unroll") for (int _i = 0; _i < 2; ++_i) \
        __builtin_amdgcn_raw_ptr_buffer_load_lds(rs_##voff, (PG8_LAS void*)(lds + (bufoff) + ldsw + _i * 8192), 16, (int)(voff)[_i], (int)(gbase), 0, 0); } while (0)
#define PG8_LDA(dst, b, h) do { _Pragma("unroll") for (int m = 0; m < 4; ++m) _Pragma("unroll") for (int k = 0; k < 2; ++k) dst[m][k] = *(const PG8_LAS bf16x8*)(lds + PG8_SA(b, h) + aoff + m * 2048 + k * 1024); } while (0)
#define PG8_LDB(dst, b, h) do { _Pragma("unroll") for (int n = 0; n < 2; ++n) _Pragma("unroll") for (int k = 0; k < 2; ++k) dst[n][k] = *(const PG8_LAS bf16x8*)(lds + PG8_SB(b, h) + boff + n * 2048 + k * 1024); } while (0)
#define PG8_MMA(ai, bj, At, Bt) do { __builtin_amdgcn_s_setprio(1); _Pragma("unroll") for (int m = 0; m < 4; ++m) _Pragma("unroll") for (int n = 0; n < 2; ++n) { \
        if constexpr (FP8) { const v8i32 b8 = __builtin_bit_cast(v8i32, __builtin_shufflevector(Bt[n][0], Bt[n][1], 0, 1, 2, 3, 4, 5, 6, 7, 8, 9, 10, 11, 12, 13, 14, 15)), a8 = __builtin_bit_cast(v8i32, __builtin_shufflevector(At[m][0], At[m][1], 0, 1, 2, 3, 4, 5, 6, 7, 8, 9, 10, 11, 12, 13, 14, 15)); \
            acc[ai][bj][m][n] = __builtin_amdgcn_mfma_scale_f32_16x16x128_f8f6f4(b8, a8, acc[ai][bj][m][n], 0, 0, 0, 0, 0, 0); } \
        else { _Pragma("unroll") for (int k = 0; k < 2; ++k) acc[ai][bj][m][n] = __builtin_amdgcn_mfma_f32_16x16x32_bf16(Bt[n][k], At[m][k], acc[ai][bj][m][n], 0, 0, 0); } } __builtin_amdgcn_s_setprio(0); } while (0)
#define PG8_WAIT_V(n) asm volatile("s_waitcnt vmcnt(" #n ")" ::: "memory")
#define PG8_WAIT_L(n) asm volatile("s_waitcnt lgkmcnt(" #n ")" ::: "memory")
#define PG8_BAR __builtin_amdgcn_s_barrier()
#define PG8_SCHED __builtin_amdgcn_sched_barrier(0)
    Unit cur, nxt; int ui = 0;
    if (!S.next(0, cur)) return;
    f32x4 acc[2][2][4][2];
#pragma unroll
    for (int a = 0; a < 2; ++a)
#pragma unroll
        for (int b = 0; b < 2; ++b)
#pragma unroll
            for (int m = 0; m < 4; ++m)
#pragma unroll
                for (int n = 0; n < 2; ++n) acc[a][b][m][n] = (f32x4){0.f, 0.f, 0.f, 0.f};
    bf16x8 At[4][2], B0[2][2], B1[2][2];
    const __amdgpu_buffer_rsrc_t rs_voffA = __builtin_amdgcn_make_buffer_rsrc((void*)g.base, 0, (int)0x7fffffff, 0x00020000);
#define rs_voffB rs_voffA
    const unsigned offA = (unsigned)((const char*)g.A - (const char*)g.base), offB = (unsigned)((const char*)g.Bt - (const char*)g.base);
    const unsigned ksub = (unsigned)nt * kstep;
    unsigned cA = offA + (unsigned)cur.pm * tstep + (unsigned)cur.kh * ksub, cB = offB + (unsigned)cur.pn * tstep + (unsigned)cur.kh * ksub;
    S.a_ready(cur);
    if constexpr (SP2) {
        PG8_STAGE(PG8_SB(0, 0), cB, voffB); PG8_STAGE(PG8_SB(0, 1), cB + hstep, voffB); PG8_STAGE(PG8_SA(0, 0), cA, voffA); PG8_STAGE(PG8_SA(0, 1), cA + hstep, voffA);
        if (wr == 1) PG8_BAR;
        PG8_WAIT_V(2); PG8_BAR;
        PG8_STAGE(PG8_SB(1, 0), cB + kstep, voffB); PG8_STAGE(PG8_SA(1, 0), cA + kstep, voffA); PG8_STAGE(PG8_SB(1, 1), cB + hstep + kstep, voffB);
        PG8_WAIT_V(6); PG8_BAR;
    } else {
        PG8_STAGE(PG8_SB(0, 0), cB, voffB); PG8_STAGE(PG8_SA(0, 0), cA, voffA); PG8_STAGE(PG8_SB(0, 1), cB + hstep, voffB); PG8_STAGE(PG8_SA(0, 1), cA + hstep, voffA);
        if (wr == 1) PG8_BAR;
        PG8_WAIT_V(4); PG8_BAR;
        PG8_STAGE(PG8_SB(1, 0), cB + kstep, voffB); PG8_STAGE(PG8_SA(1, 0), cA + kstep, voffA); PG8_STAGE(PG8_SB(1, 1), cB + hstep + kstep, voffB);
        PG8_WAIT_V(6); PG8_BAR;
    }
    for (;;) {
        const bool has_next = S.next(ui + 1, nxt);
        const unsigned nA = has_next ? offA + (unsigned)nxt.pm * tstep + (unsigned)nxt.kh * ksub : cA, nB = has_next ? offB + (unsigned)nxt.pn * tstep + (unsigned)nxt.kh * ksub : cB;
        for (int t = 0; t < nt; t += 2) {
            const bool last = (t == nt - 2);
            const unsigned a1 = cA + (unsigned)(t + 1) * kstep;
            const unsigned a2 = last ? nA : cA + (unsigned)(t + 2) * kstep, b2 = last ? nB : cB + (unsigned)(t + 2) * kstep;
            const unsigned a3 = a2 + kstep, b3 = b2 + kstep;
            if (last && has_next) S.a_ready(nxt);
            if constexpr (SP2) {
            PG8_LDB(B0, 0, 0); PG8_LDB(B1, 0, 1); PG8_SCHED; PG8_LDA(At, 0, 0); PG8_STAGE(PG8_SA(1, 1), a1 + hstep, voffA);
            PG8_WAIT_V(8); PG8_WAIT_L(0); PG8_BAR; PG8_MMA(0, 0, At, B0); PG8_MMA(0, 1, At, B1); PG8_BAR; PG8_SCHED;
            PG8_LDA(At, 0, 1); PG8_STAGE(PG8_SB(0, 0), b2, voffB); PG8_STAGE(PG8_SB(0, 1), b2 + hstep, voffB); PG8_STAGE(PG8_SA(0, 0), a2, voffA);
            PG8_WAIT_V(8); PG8_WAIT_L(0); PG8_BAR; PG8_MMA(1, 0, At, B0); PG8_MMA(1, 1, At, B1); PG8_BAR; PG8_SCHED;
            PG8_LDB(B0, 1, 0); PG8_LDB(B1, 1, 1); PG8_SCHED; PG8_LDA(At, 1, 0); PG8_STAGE(PG8_SA(0, 1), a2 + hstep, voffA);
            PG8_WAIT_V(8); PG8_WAIT_L(0); PG8_BAR; PG8_MMA(0, 0, At, B0); PG8_MMA(0, 1, At, B1); PG8_BAR; PG8_SCHED;
            PG8_LDA(At, 1, 1); PG8_STAGE(PG8_SB(1, 0), b3, voffB); PG8_STAGE(PG8_SB(1, 1), b3 + hstep, voffB); PG8_STAGE(PG8_SA(1, 0), a3, voffA);
            PG8_WAIT_V(8); PG8_WAIT_L(0); PG8_BAR; PG8_MMA(1, 0, At, B0); PG8_MMA(1, 1, At, B1); PG8_BAR; PG8_SCHED;
            } else {
            PG8_LDB(B0, 0, 0); PG8_SCHED; PG8_LDA(At, 0, 0); PG8_STAGE(PG8_SA(1, 1), a1 + hstep, voffA);
            PG8_WAIT_L(8); PG8_BAR; PG8_WAIT_L(0); PG8_MMA(0, 0, At, B0); PG8_BAR; PG8_SCHED;
            PG8_LDB(B1, 0, 1); PG8_STAGE(PG8_SB(0, 0), b2, voffB);
            PG8_BAR; PG8_WAIT_L(0); PG8_MMA(0, 1, At, B1); PG8_BAR;
            PG8_LDA(At, 0, 1); PG8_STAGE(PG8_SA(0, 0), a2, voffA);
            PG8_BAR; PG8_WAIT_L(0); PG8_MMA(1, 0, At, B0); PG8_BAR; PG8_SCHED;
            PG8_STAGE(PG8_SB(0, 1), b2 + hstep, voffB);
            PG8_WAIT_V(6); PG8_BAR; PG8_MMA(1, 1, At, B1); PG8_BAR;
            PG8_LDB(B0, 1, 0); PG8_SCHED; PG8_LDA(At, 1, 0); PG8_STAGE(PG8_SA(0, 1), a2 + hstep, voffA);
            PG8_WAIT_L(8); PG8_BAR; PG8_WAIT_L(0); PG8_MMA(0, 0, At, B0); PG8_BAR; PG8_SCHED;
            PG8_LDB(B1, 1, 1); PG8_STAGE(PG8_SB(1, 0), b3, voffB);
            PG8_BAR; PG8_WAIT_L(0); PG8_MMA(0, 1, At, B1); PG8_BAR;
            PG8_LDA(At, 1, 1); PG8_STAGE(PG8_SA(1, 0), a3, voffA);
            PG8_BAR; PG8_WAIT_L(0); PG8_MMA(1, 0, At, B0); PG8_BAR; PG8_SCHED;
            PG8_STAGE(PG8_SB(1, 1), b3 + hstep, voffB);
            PG8_WAIT_V(6); PG8_BAR; PG8_MMA(1, 1, At, B1); PG8_BAR;
            }
        }
        if constexpr (ALIGN_EPI) { if (wr == 0) PG8_BAR; }
        if constexpr (FP8) {
#pragma unroll
            for (int a = 0; a < 2; ++a)
#pragma unroll
                for (int b = 0; b < 2; ++b)
#pragma unroll
                    for (int m = 0; m < 4; ++m)
#pragma unroll
                        for (int n = 0; n < 2; ++n) acc[a][b][m][n] = acc[a][b][m][n] * g.oscale; }
        if constexpr (!Epi::AFTER_DRAIN) { E(acc, cur, wr, wc, fr, fq); S.done(cur); }
        if (!has_next) break;
#pragma unroll
        for (int a = 0; a < 2; ++a)
#pragma unroll
            for (int b = 0; b < 2; ++b)
#pragma unroll
                for (int m = 0; m < 4; ++m)
#pragma unroll
                    for (int n = 0; n < 2; ++n) acc[a][b][m][n] = (f32x4){0.f, 0.f, 0.f, 0.f};
        cur = nxt; cA = nA; cB = nB; ++ui;
        if constexpr (ALIGN_EPI) { if (wr == 1) PG8_BAR; }
    }
    PG8_WAIT_V(0);
    if constexpr (!ALIGN_EPI) { if (wr == 0) PG8_BAR; }
    PG8_BAR;
    if constexpr (Epi::AFTER_DRAIN) { E.fused(acc, cur, wr, wc, fr, fq, lds, wid, lane); S.done(cur); }
#undef PG8_SA
#undef PG8_SB
#undef PG8_STAGE
#undef rs_voffB
#undef PG8_LDA
#undef PG8_LDB
#undef PG8_MMA
#undef PG8_WAIT_V
#undef PG8_WAIT_L
#undef PG8_BAR
#undef PG8_SCHED
}
}

namespace att {
typedef unsigned short bf16;
using bf16x8 = __attribute__((ext_vector_type(8))) short;
using s16x4  = __attribute__((ext_vector_type(4))) short;
using f32x16 = __attribute__((ext_vector_type(16))) float;
using f32x8  = __attribute__((ext_vector_type(8))) float;
using f32x4  = __attribute__((ext_vector_type(4))) float;
using u32x4  = __attribute__((ext_vector_type(4))) unsigned;
constexpr int   D = 128, NW = 8, QBLK = 32, KVBLK = 64;
constexpr float SCALE = 0.088388347648318440f;
constexpr float THR = 8.f;
constexpr int LDQ = 2048, LDK = 2048, LDO = 4096;
constexpr size_t SHM_V = KVBLK * D * 2, SHM_K = KVBLK * D * 2, SHM_ATTN = 2 * SHM_V + 2 * SHM_K + NW * 64 * 4;
#define KSWZ(row, colB) ((row) * 256 + ((colB) ^ (((row) & 7) << 4)))
#define SBAR() __builtin_amdgcn_sched_barrier(0)
__device__ __forceinline__ int crow(int r, int hi) { return (r & 3) + 8 * (r >> 2) + 4 * hi; }
__device__ __forceinline__ unsigned cvtpk(float lo, float hi) { unsigned r; asm volatile("v_cvt_pk_bf16_f32 %0, %1, %2" : "=v"(r) : "v"(lo), "v"(hi)); return r; }
__device__ __forceinline__ bf16x8 tobf(f32x8 x) { u32x4 w = {cvtpk(x[0], x[1]), cvtpk(x[2], x[3]), cvtpk(x[4], x[5]), cvtpk(x[6], x[7])}; return *reinterpret_cast<bf16x8*>(&w); }

__device__ __forceinline__ void partialSM(f32x16& p0, f32x16& p1, float& m_reg, float& mn, float& alpha) {
  constexpr float C = SCALE * 1.4426950408889634f;
  float pmax = p0[0];
#pragma unroll
  for (int r = 1; r < 16; ++r) pmax = fmaxf(pmax, p0[r]);
#pragma unroll
  for (int r = 0; r < 16; ++r) pmax = fmaxf(pmax, p1[r]);
  { auto rr = __builtin_amdgcn_permlane32_swap(__float_as_uint(pmax), __float_as_uint(pmax), false, false);
    pmax = fmaxf(__uint_as_float(rr[0]), __uint_as_float(rr[1])); }
  if (__builtin_expect(__all(pmax - m_reg <= THR / SCALE), 1)) { mn = m_reg; alpha = 1.f; }
  else { mn = fmaxf(m_reg, pmax); alpha = __builtin_amdgcn_exp2f((m_reg - mn) * C); m_reg = mn; }
  float mnC = -mn * C;
#pragma unroll
  for (int r = 0; r < 16; ++r) p0[r] = fmaf(p0[r], C, mnC);
#pragma unroll
  for (int r = 0; r < 16; ++r) p1[r] = fmaf(p1[r], C, mnC);
#pragma unroll
  for (int r = 0; r < 16; ++r) p0[r] = __builtin_amdgcn_exp2f(p0[r]);
}
__device__ __forceinline__ void finishSM(f32x16& p0, f32x16& p1, float alpha, float& l_reg, bf16x8& pa0, bf16x8& pa1, bf16x8& pa2, bf16x8& pa3) {
#pragma unroll
  for (int r = 0; r < 16; ++r) p1[r] = __builtin_amdgcn_exp2f(p1[r]);
  float ps = 0;
#pragma unroll
  for (int r = 0; r < 16; ++r) ps += p0[r];
#pragma unroll
  for (int r = 0; r < 16; ++r) ps += p1[r];
  { auto rr = __builtin_amdgcn_permlane32_swap(__float_as_uint(ps), __float_as_uint(ps), false, false);
    ps = __uint_as_float(rr[0]) + __uint_as_float(rr[1]); }
  l_reg = l_reg * alpha + ps;
#define PK4(P, BASE, OUT) do { unsigned a0 = cvtpk(P[BASE + 0], P[BASE + 1]), a1 = cvtpk(P[BASE + 2], P[BASE + 3]);   \
    unsigned b0 = cvtpk(P[BASE + 4], P[BASE + 5]), b1 = cvtpk(P[BASE + 6], P[BASE + 7]);                              \
    auto r0 = __builtin_amdgcn_permlane32_swap(a0, b0, false, false); auto r1 = __builtin_amdgcn_permlane32_swap(a1, b1, false, false); \
    u32x4 w = {r0[0], r1[0], r0[1], r1[1]}; OUT = *reinterpret_cast<bf16x8*>(&w); } while (0)
  PK4(p0, 0, pa0); PK4(p0, 8, pa1); PK4(p1, 0, pa2); PK4(p1, 8, pa3);
#undef PK4
}
__device__ __forceinline__ void qkt(f32x16& p0, f32x16& p1, const bf16* Ks, const bf16x8* qr, int r32, int hi) {
  p0 = f32x16{}; p1 = f32x16{};
#pragma unroll
  for (int d0 = 0; d0 < 8; ++d0) { int cb = (d0 * 16 + hi * 8) * 2;
    bf16x8 b0 = *reinterpret_cast<const bf16x8*>((const char*)Ks + KSWZ(r32, cb));
    bf16x8 b1 = *reinterpret_cast<const bf16x8*>((const char*)Ks + KSWZ(32 + r32, cb));
    p0 = __builtin_amdgcn_mfma_f32_32x32x16_bf16(b0, qr[d0], p0, 0, 0, 0);
    p1 = __builtin_amdgcn_mfma_f32_32x32x16_bf16(b1, qr[d0], p1, 0, 0, 0); }
}
__device__ __forceinline__ int v_st(int k, int c) { const int kk = (k & ~0xC) | ((k & 4) << 1) | ((k & 8) >> 1); return ((kk >> 3) * 4 + (c >> 5)) * 512 + ((kk & 7) * 32 + (c & 31)) * 2; }
__device__ __forceinline__ int v_rd_base(int lane) { return ((lane & 3) << 3) | (((lane >> 2) & 3) << 6) | (((lane >> 4) & 1) << 5) | (((lane >> 5) & 1) << 8); }
constexpr int v_rd_off(int d0, int ks, int half) { return d0 * 512 + ks * 4096 + half * 2048; }
template <int OFF> __device__ __forceinline__ s16x4 tr_read(int vb) {
  s16x4 r; asm volatile("ds_read_b64_tr_b16 %0, %1 offset:%2" : "=&v"(r) : "v"(vb), "i"(OFF) : "memory"); return r;
}
template <int D0> __device__ __forceinline__ void pv_one(f32x16& od, int vb, bf16x8 pa0, bf16x8 pa1, bf16x8 pa2, bf16x8 pa3) {
  const s16x4 l0 = tr_read<v_rd_off(D0, 0, 0)>(vb), h0 = tr_read<v_rd_off(D0, 0, 1)>(vb), l1 = tr_read<v_rd_off(D0, 1, 0)>(vb), h1 = tr_read<v_rd_off(D0, 1, 1)>(vb);
  const s16x4 l2 = tr_read<v_rd_off(D0, 2, 0)>(vb), h2 = tr_read<v_rd_off(D0, 2, 1)>(vb), l3 = tr_read<v_rd_off(D0, 3, 0)>(vb), h3 = tr_read<v_rd_off(D0, 3, 1)>(vb);
  asm volatile("s_waitcnt lgkmcnt(0)" ::: "memory"); SBAR();
#define PK(L, H) (bf16x8){L[0], L[1], L[2], L[3], H[0], H[1], H[2], H[3]}
  od = __builtin_amdgcn_mfma_f32_32x32x16_bf16(pa0, PK(l0, h0), od, 0, 0, 0);
  od = __builtin_amdgcn_mfma_f32_32x32x16_bf16(pa1, PK(l1, h1), od, 0, 0, 0);
  od = __builtin_amdgcn_mfma_f32_32x32x16_bf16(pa2, PK(l2, h2), od, 0, 0, 0);
  od = __builtin_amdgcn_mfma_f32_32x32x16_bf16(pa3, PK(l3, h3), od, 0, 0, 0);
#undef PK
}
__device__ __forceinline__ void pv_d0(f32x16* o, int vb, bf16x8 pa0, bf16x8 pa1, bf16x8 pa2, bf16x8 pa3) {
  pv_one<0>(o[0], vb, pa0, pa1, pa2, pa3); pv_one<1>(o[1], vb, pa0, pa1, pa2, pa3); pv_one<2>(o[2], vb, pa0, pa1, pa2, pa3); pv_one<3>(o[3], vb, pa0, pa1, pa2, pa3);
}

__device__ __forceinline__ void attn_prompt_unit(const bf16* __restrict__ Qb, const bf16* __restrict__ Kh, const bf16* __restrict__ Vh, bf16* __restrict__ Ob, int qb, char* lds, const int tid) {
  asm volatile("" : "+s"(Qb), "+s"(Kh), "+s"(Vh), "+s"(Ob), "+s"(qb));
  const int wid = tid >> 6, lane = tid & 63, r32 = lane & 31, hi = lane >> 5;
  bf16* V_lds = (bf16*)lds; bf16* K_lds = (bf16*)(lds + 2 * SHM_V);
  float* ws = (float*)(lds + 2 * SHM_V + 2 * SHM_K) + wid * 64; float* li_l = ws; float* al_l = ws + 32;
  float m_reg = -1e30f, l_reg = 0; f32x16 o[4] = {}; bf16x8 qr[8];
  const bf16* Qw = Qb + (long)(wid * QBLK + r32) * LDQ + hi * 8;
#pragma unroll
  for (int d0 = 0; d0 < 8; ++d0) qr[d0] = *reinterpret_cast<const bf16x8*>(Qw + d0 * 16);
  const int sr = tid >> 4, sc = (tid & 15) * 8, vst0 = v_st(sr, sc), vst1 = v_st(32 + sr, sc);
  const int vb0 = (int)(uintptr_t)V_lds + v_rd_base(lane);
  struct { bf16x8 vs0, vs1, ks0, ks1; } sr_[2];
  const int NT = 4 * (qb + 1), lastvis = 4 * qb + (wid >> 1);
#define SLOAD(i, k0) do { sr_[i].vs0 = *reinterpret_cast<const bf16x8*>(&Vh[(long)((k0) + sr) * LDK + sc]); sr_[i].vs1 = *reinterpret_cast<const bf16x8*>(&Vh[(long)((k0) + 32 + sr) * LDK + sc]); \
    sr_[i].ks0 = *reinterpret_cast<const bf16x8*>(&Kh[(long)((k0) + sr) * LDK + sc]); sr_[i].ks1 = *reinterpret_cast<const bf16x8*>(&Kh[(long)((k0) + 32 + sr) * LDK + sc]); } while (0)
#define SWRITE(b, i) do { *(bf16x8*)((char*)V_lds + (b) * SHM_V + vst0) = sr_[i].vs0;          \
    *(bf16x8*)((char*)V_lds + (b) * SHM_V + vst1) = sr_[i].vs1; int kc = sc * 2;               \
    *(bf16x8*)((char*)K_lds + (b) * SHM_K + KSWZ(sr, kc)) = sr_[i].ks0;                       \
    *(bf16x8*)((char*)K_lds + (b) * SHM_K + KSWZ(32 + sr, kc)) = sr_[i].ks1; } while (0)
#define SWAIT() asm volatile("s_waitcnt vmcnt(4)" ::: "memory")
#define RESC(a) do { if (__any((a) < 1.f)) { if (hi == 0) al_l[r32] = (a); asm volatile("s_waitcnt lgkmcnt(0)" ::: "memory"); \
    _Pragma("unroll") for (int d = 0; d < 4; ++d) _Pragma("unroll") for (int r = 0; r < 16; ++r) o[d][r] *= al_l[crow(r, hi)]; } } while (0)
#define TMASK(P0, P1, jt) do { if ((jt) > lastvis) { _Pragma("unroll") for (int r = 0; r < 16; ++r) { P0[r] = -1e30f; P1[r] = -1e30f; } } } while (0)
  f32x16 pA0, pA1, pB0, pB1; float mnA, mnB, alA, alB; bf16x8 pa0, pa1, pa2, pa3;
  constexpr int SE = 0, SO = 1;
  SLOAD(SE, 0); asm volatile("s_waitcnt vmcnt(0)" ::: "memory"); SWRITE(0, SE); __syncthreads();
  qkt(pA0, pA1, K_lds, qr, r32, hi); partialSM(pA0, pA1, m_reg, mnA, alA);
  SLOAD(SO, KVBLK); if (2 < NT) SLOAD(SE, 2 * KVBLK);
  SWAIT(); SWRITE(1, SO); __syncthreads();
  for (int j = 1; j + 1 < NT; j += 2) {
    SBAR(); qkt(pB0, pB1, (bf16*)((char*)K_lds + SHM_K), qr, r32, hi); TMASK(pB0, pB1, j);
    finishSM(pA0, pA1, alA, l_reg, pa0, pa1, pa2, pa3); SBAR();
    SLOAD(SO, (j + 2) * KVBLK); SBAR();
    pv_d0(o, vb0, pa0, pa1, pa2, pa3); partialSM(pB0, pB1, m_reg, mnB, alB);
    __syncthreads(); SWAIT(); SWRITE(0, SE);
    RESC(alB); __syncthreads();
    SBAR(); qkt(pA0, pA1, K_lds, qr, r32, hi); TMASK(pA0, pA1, j + 1);
    finishSM(pB0, pB1, alB, l_reg, pa0, pa1, pa2, pa3); SBAR();
    if (j + 3 < NT) SLOAD(SE, (j + 3) * KVBLK); SBAR();
    pv_d0(o, vb0 + (int)SHM_V, pa0, pa1, pa2, pa3); partialSM(pA0, pA1, m_reg, mnA, alA);
    __syncthreads(); SWAIT(); SWRITE(1, SO);
    RESC(alA); __syncthreads();
  }
  SBAR(); qkt(pB0, pB1, (bf16*)((char*)K_lds + SHM_K), qr, r32, hi); TMASK(pB0, pB1, NT - 1);
  finishSM(pA0, pA1, alA, l_reg, pa0, pa1, pa2, pa3); SBAR();
  pv_d0(o, vb0, pa0, pa1, pa2, pa3); partialSM(pB0, pB1, m_reg, mnB, alB);
  __syncthreads(); RESC(alB);
  finishSM(pB0, pB1, alB, l_reg, pa0, pa1, pa2, pa3); SBAR();
  pv_d0(o, vb0 + (int)SHM_V, pa0, pa1, pa2, pa3);
  if (hi == 0) li_l[r32] = l_reg; asm volatile("s_waitcnt lgkmcnt(0)" ::: "memory");
  float rli[16];
#pragma unroll
  for (int r = 0; r < 16; ++r) rli[r] = __builtin_amdgcn_rcpf(li_l[crow(r, hi)]);
  bf16* Ow = Ob + (long)(wid * QBLK) * LDO;
#pragma unroll
  for (int r = 0; r < 16; ++r) { int orow = crow(r, hi);
#pragma unroll
    for (int d0 = 0; d0 < 4; ++d0) Ow[(long)orow * LDO + d0 * 32 + r32] = (bf16)(cvtpk(o[d0][r] * rli[r], 0.f) & 0xffffu); }
  __syncthreads();
#undef SLOAD
#undef SWRITE
#undef SWAIT
#undef TMASK
}


constexpr int A2_K = 0, A2_V = 16384, A2_BUF = 49152, A2_SCR = 2 * A2_BUF;
__device__ __forceinline__ void attn_prompt_unit2(const unsigned char* wsb, const bf16* __restrict__ Qb, const bf16* __restrict__ Kh, const bf16* __restrict__ Vh, bf16* __restrict__ Ob, int qb, char* lds, const int tid_) {
  int tid = tid_; asm volatile("" : "+s"(Qb), "+s"(Kh), "+s"(Vh), "+s"(Ob), "+s"(qb), "+v"(tid));
  const int wid = tid >> 6, lane = tid & 63, r32 = lane & 31, hi = lane >> 5;
  float* wsf = (float*)(lds + A2_SCR) + wid * 64; float* li_l = wsf; float* al_l = wsf + 32;
  float m_reg = -1e30f, l_reg = 0; f32x16 o[8] = {}; bf16x8 qr[8];
  const bf16* Qw = Qb + (long)(wid * QBLK + r32) * LDQ + hi * 8;
#pragma unroll
  for (int d0 = 0; d0 < 8; ++d0) qr[d0] = *reinterpret_cast<const bf16x8*>(Qw + d0 * 16);
  unsigned vK[2], vV[2];
#pragma unroll
  for (int i = 0; i < 2; ++i) { const int P = 64 * (2 * wid + i) + lane;
    { const int row = P >> 4, c = (P & 15) ^ (row & 7); vK[i] = (unsigned)(row * (LDK * 2) + c * 16); }
    { const int sub = P >> 5, r16 = P & 31, kk = ((sub >> 2) << 3) | (r16 >> 2), k = (kk & ~0xC) | ((kk & 4) << 1) | ((kk & 8) >> 1), c = (sub & 3) * 32 + (r16 & 3) * 8; vV[i] = (unsigned)(k * (LDK * 2) + c * 2); } }
  const __amdgpu_buffer_rsrc_t rs = __builtin_amdgcn_make_buffer_rsrc((void*)wsb, 0, (int)0x7fffffff, 0x00020000);
  const unsigned gK = (unsigned)((const unsigned char*)Kh - wsb), gV = (unsigned)((const unsigned char*)Vh - wsb);
  const int wu = __builtin_amdgcn_readfirstlane(wid);
  typedef __attribute__((address_space(3))) void* lvp;
  typedef __attribute__((address_space(3))) unsigned char* lcp;
  lcp const L0 = (lcp)0 + (unsigned)(uintptr_t)lds;
#define A2_ISSUE(t) do { const unsigned ko_ = gK + (unsigned)(t) * (KVBLK * LDK * 2), vo_ = gV + (unsigned)(t) * (KVBLK * LDK * 2); lcp bb_ = L0 + ((t) & 1) * A2_BUF + wu * 2048; \
    __builtin_amdgcn_raw_ptr_buffer_load_lds(rs, (lvp)(bb_ + A2_K), 16, (int)vK[0], (int)ko_, 0, 0); __builtin_amdgcn_raw_ptr_buffer_load_lds(rs, (lvp)(bb_ + A2_K + 1024), 16, (int)vK[1], (int)ko_, 0, 0); \
    __builtin_amdgcn_raw_ptr_buffer_load_lds(rs, (lvp)(bb_ + A2_V), 16, (int)vV[0], (int)vo_, 0, 0); __builtin_amdgcn_raw_ptr_buffer_load_lds(rs, (lvp)(bb_ + A2_V + 1024), 16, (int)vV[1], (int)vo_, 0, 0); \
    __builtin_amdgcn_raw_ptr_buffer_load_lds(rs, (lvp)(bb_ + A2_V + 16384), 16, (int)vV[0], (int)(vo_ + 256u), 0, 0); __builtin_amdgcn_raw_ptr_buffer_load_lds(rs, (lvp)(bb_ + A2_V + 16384 + 1024), 16, (int)vV[1], (int)(vo_ + 256u), 0, 0); } while (0)
  const int NT = 4 * (qb + 1), lastvis = 4 * qb + (wid >> 1);
  const int vbase = (int)(uintptr_t)lds + A2_V + v_rd_base(lane);
  A2_ISSUE(0);
  for (int j = 0; j < NT; ++j) {
    asm volatile("s_waitcnt vmcnt(0)" ::: "memory"); __builtin_amdgcn_s_barrier(); asm volatile("" ::: "memory");
    if (j + 1 < NT) A2_ISSUE(j + 1);
    f32x16 p0, p1; float mn, al; bf16x8 pa0, pa1, pa2, pa3;
    qkt(p0, p1, (const bf16*)(lds + (j & 1) * A2_BUF + A2_K), qr, r32, hi);
    if (j > lastvis) {
#pragma unroll
      for (int r = 0; r < 16; ++r) { p0[r] = -1e30f; p1[r] = -1e30f; } }
    partialSM(p0, p1, m_reg, mn, al);
    if (__any(al < 1.f)) { if (hi == 0) al_l[r32] = al; asm volatile("s_waitcnt lgkmcnt(0)" ::: "memory");
#pragma unroll
      for (int d = 0; d < 8; ++d)
#pragma unroll
        for (int r = 0; r < 16; ++r) o[d][r] *= al_l[crow(r, hi)]; }
    finishSM(p0, p1, al, l_reg, pa0, pa1, pa2, pa3); SBAR();
    const int vb = vbase + (j & 1) * A2_BUF;
    pv_d0(o, vb, pa0, pa1, pa2, pa3); pv_d0(o + 4, vb + 16384, pa0, pa1, pa2, pa3);
  }
  if (hi == 0) li_l[r32] = l_reg; asm volatile("s_waitcnt lgkmcnt(0)" ::: "memory");
  float rli[16];
#pragma unroll
  for (int r = 0; r < 16; ++r) rli[r] = __builtin_amdgcn_rcpf(li_l[crow(r, hi)]);
  bf16* Ow = Ob + (long)(wid * QBLK) * LDO;
#pragma unroll
  for (int r = 0; r < 16; ++r) { int orow = crow(r, hi);
#pragma unroll
    for (int d0 = 0; d0 < 8; ++d0) Ow[(long)orow * LDO + d0 * 32 + r32] = (bf16)(cvtpk(o[d0][r] * rli[r], 0.f) & 0xffffu); }
#undef A2_ISSUE
}

__device__ __forceinline__ void attn_sample_unit(const bf16* __restrict__ QB, const bf16* __restrict__ KB, const bf16* __restrict__ VB, const float* __restrict__ ck, const float* __restrict__ cv,
                                                 float* __restrict__ OPS, float* __restrict__ MLS, int b, int h, int split, char* lds, const int tid) {
  const int wid = tid >> 6, lane = tid & 63, r32 = lane & 31, hi = lane >> 5, j = wid >> 2, c = wid & 3;
  bf16* K_lds = (bf16*)(lds + j * 16384);
  char* V_base = lds + 32768;
  float* ws = (float*)(lds + 65536) + wid * 64; float* al_l = ws + 32;
  float m_reg = -1e30f, l_reg = 0; f32x16 o[2] = {}; bf16x8 qr[8];
  const long qrow0 = 32768 + 32 * b;
  const bf16* Qw = QB + (qrow0 + r32) * LDQ + (2 * h + j) * 128 + hi * 8;
#pragma unroll
  for (int d0 = 0; d0 < 8; ++d0) qr[d0] = *reinterpret_cast<const bf16x8*>(Qw + d0 * 16);
  const int vb = (int)(uintptr_t)(V_base + (c >> 1) * 16384) + v_rd_base(lane);
  const int skey = tid >> 3, sg = tid & 7;
  const float* ckb = ck + ((long)(b * 2048 + split * 1024 + skey) * 16 + 2 * h) * 128 + sg * 8;
  const float* cvb = cv + ((long)(b * 2048 + split * 1024 + skey) * 8 + h) * 256 + sg * 8;
  f32x8 kreg[4], vreg[4];
#define S_LOAD(t) do { _Pragma("unroll") for (int i = 0; i < 4; ++i) { kreg[i] = *reinterpret_cast<const f32x8*>(ckb + (long)(t) * 64 * 2048 + i * 64); vreg[i] = *reinterpret_cast<const f32x8*>(cvb + (long)(t) * 64 * 2048 + i * 64); } } while (0)
#define S_WRITE() do { _Pragma("unroll") for (int i = 0; i < 4; ++i) { const int col = (sg + 8 * i) * 8, jj = col >> 7, cc = col & 127; \
    *(bf16x8*)(lds + jj * 16384 + KSWZ(skey, cc * 2)) = tobf(kreg[i]); *(bf16x8*)(V_base + jj * 16384 + v_st(skey, cc)) = tobf(vreg[i]); } } while (0)
#define S_TILE(MASKP1) do { f32x16 p0, p1; float mn, al; bf16x8 pa0, pa1, pa2, pa3; \
    qkt(p0, p1, K_lds, qr, r32, hi); if (MASKP1) { _Pragma("unroll") for (int r = 0; r < 16; ++r) p1[r] = -1e30f; } \
    partialSM(p0, p1, m_reg, mn, al); \
    if (__any(al < 1.f)) { if (hi == 0) al_l[r32] = al; asm volatile("s_waitcnt lgkmcnt(0)" ::: "memory"); \
      _Pragma("unroll") for (int d = 0; d < 2; ++d) _Pragma("unroll") for (int r = 0; r < 16; ++r) o[d][r] *= al_l[crow(r, hi)]; } \
    finishSM(p0, p1, al, l_reg, pa0, pa1, pa2, pa3); SBAR(); \
    if (c & 1) { pv_one<2>(o[0], vb, pa0, pa1, pa2, pa3); pv_one<3>(o[1], vb, pa0, pa1, pa2, pa3); } \
    else { pv_one<0>(o[0], vb, pa0, pa1, pa2, pa3); pv_one<1>(o[1], vb, pa0, pa1, pa2, pa3); } } while (0)
  S_LOAD(0);
  for (int t = 0; t < 16; ++t) {
    asm volatile("s_waitcnt vmcnt(0)" ::: "memory"); __syncthreads(); S_WRITE(); __syncthreads();
    if (t + 1 < 16) S_LOAD(t + 1);
    S_TILE(false);
  }
  if (split == 1) {
    __syncthreads();
    { const int key = tid >> 4, g16 = tid & 15;
#pragma unroll
      for (int i = 0; i < 2; ++i) { const int col = g16 * 16 + i * 8, jj = col >> 7, cc = col & 127;
        const bf16x8 kv = *reinterpret_cast<const bf16x8*>(KB + (qrow0 + key) * LDK + h * 256 + col);
        const bf16x8 vv = *reinterpret_cast<const bf16x8*>(VB + (qrow0 + key) * LDK + h * 256 + col);
        *(bf16x8*)(lds + jj * 16384 + KSWZ(key, cc * 2)) = kv; *(bf16x8*)(V_base + jj * 16384 + v_st(key, cc)) = vv;
        *(bf16x8*)(lds + jj * 16384 + KSWZ(32 + key, cc * 2)) = bf16x8{}; *(bf16x8*)(V_base + jj * 16384 + v_st(32 + key, cc)) = bf16x8{}; } }
    __syncthreads();
    S_TILE(true);
  }
  const long pbase = ((((long)b * 8 + h) * 2 + split) * 2 + j) * 32;
#pragma unroll
  for (int r = 0; r < 16; ++r) { const int orow = crow(r, hi);
#pragma unroll
    for (int d = 0; d < 2; ++d) OPS[(pbase + orow) * 256 + c * 64 + d * 32 + r32] = o[d][r]; }
  if (c == 0 && hi == 0) { MLS[(pbase + r32) * 2] = m_reg; MLS[(pbase + r32) * 2 + 1] = l_reg; }
  __syncthreads();
#undef S_LOAD
#undef S_WRITE
#undef S_TILE
}
#undef RESC
#undef KSWZ
}

constexpr int NWAVES = 8;
constexpr int DM = 2048, MP = 32768, MS = 512, M = MP + MS, SEQ = 4096, TS = 32, NSTREAM = 24, DFF = 5632, NGRP = 128, SP = 64;
constexpr float LN_EPS = 1e-5f;
constexpr float LAM_INIT = 0.35550906759f;
constexpr size_t OUT_Y = 0, OUT_KP = (size_t)M * DM, OUT_VP = OUT_KP + (size_t)MP * DM, OUT_SRP = OUT_VP + (size_t)MP * DM, OUT_SIP = OUT_SRP + 8 * 128 * 64, OUT_CVP = OUT_SIP + 8 * 128 * 64,
                 OUT_KS = OUT_CVP + 2 * 8 * 2 * DFF, OUT_VS = OUT_KS + (size_t)MS * DM, OUT_SRS = OUT_VS + (size_t)MS * DM, OUT_SIS = OUT_SRS + 16 * 128 * 64, OUT_CVS = OUT_SIS + 16 * 128 * 64,
                 OUT_END = OUT_CVS + 2 * 16 * 2 * DFF;
static_assert(OUT_END == 205406208 && OUT_VP - OUT_KP == (size_t)MP * DM && OUT_VS - OUT_KS == (size_t)MS * DM, "output size");
constexpr size_t MiB = 1u << 20;
constexpr size_t WS_CTL = 0, WS_STAT = 1 * MiB  , CTL_ZERO_BYTES = 2 * MiB + 256 * 1024;
constexpr size_t WS_MOD = 2 * MiB + 256 * 1024;
constexpr size_t WS_ABAR = 4 * MiB + 512 * 1024;
constexpr size_t WS_BBT = 5 * MiB;
constexpr size_t WS_CMT = 6 * MiB;
constexpr size_t WS_WIN = 8 * MiB, WS_WGLU = 16 * MiB, WS_WUP8 = 32 * MiB  , WS_WDOWN8 = 76 * MiB  , WS_WQKV = 98 * MiB, WS_WO = 122 * MiB;
constexpr size_t WS_HB = 136 * MiB;
constexpr size_t WS_CVP = 130 * MiB;
constexpr size_t WS_BIG = 266 * MiB;
constexpr size_t WS_U = WS_BIG, WS_Z = WS_BIG + 130 * MiB;
constexpr size_t WS_G = WS_BIG, WS_V = WS_BIG + 358 * MiB;
constexpr size_t WS_GT = WS_BIG + 400 * MiB  , WS_FR = WS_BIG + 408 * MiB  ;
constexpr size_t WS_ACT8 = WS_BIG + 716 * MiB;
constexpr size_t WS_Q = WS_BIG, WS_K = WS_BIG + 130 * MiB, WS_VA = WS_BIG + 260 * MiB, WS_OP = WS_BIG + 390 * MiB  , WS_OPS = WS_BIG + 650 * MiB  , WS_MLS = WS_BIG + 666 * MiB;
constexpr size_t WS_PART = WS_ACT8 + 180 * MiB;
constexpr size_t WS_END = WS_PART + 8 * MiB;
static_assert(WS_STAT + (size_t)4 * M * 2 * 4 <= CTL_ZERO_BYTES && WS_MOD + (size_t)2 * NSTREAM * 12288 * 4 <= WS_ABAR && WS_VA - WS_K == WS_K - WS_Q && (size_t)M * DFF * 2 <= 358 * MiB && (size_t)M * DM * 2 <= 130 * MiB && (size_t)M * 4096 * 2 <= 260 * MiB && (size_t)M * DFF <= 179 * MiB && (size_t)4 * 48 * DFF * 4 <= 6 * MiB, "ws map");
constexpr unsigned SC_H1 = 0x7b7b7b7bu, SC_WUP = 0x73737373u, SC_ACT = 0x7a7a7a7au, SC_WDN = 0x72727272u;
constexpr float F8_Z = 64.f, F8_WGLU = 4096.f; constexpr float F8_H1 = 16.f, F8_WUP = 4096.f, F8_ACT = 32.f, F8_WDN = 8192.f;
constexpr int CW_BAR = 4096;
constexpr int RING_BYTES = 131072, LDSCTL_OFF = RING_BYTES, MISC_OFF = LDSCTL_OFF + 320, XCH_OFF = LDSCTL_OFF + 512  , LDS_BYTES = 147456;

#define GAS __attribute__((address_space(1)))
#define LAS __attribute__((address_space(3)))
typedef unsigned short bf16;
typedef unsigned v4u __attribute__((ext_vector_type(4)));
typedef float f32x4 __attribute__((ext_vector_type(4)));
typedef short bf16x8 __attribute__((ext_vector_type(8)));
typedef GAS unsigned gu32;
typedef GAS unsigned long long gu64;
#define RLX_AGENT __ATOMIC_RELAXED, __HIP_MEMORY_SCOPE_AGENT
#define LDS_WAIT() asm volatile("s_waitcnt lgkmcnt(0)" ::: "memory")
#define VM_WAIT() asm volatile("s_waitcnt vmcnt(0)" ::: "memory")
__device__ __forceinline__ unsigned long long rt() { return __builtin_amdgcn_s_memrealtime(); }
__device__ __forceinline__ unsigned f2bf(float f) { unsigned u = __builtin_bit_cast(unsigned, f); return (u + 0x7fffu + ((u >> 16) & 1u)) >> 16; }
__device__ __forceinline__ unsigned pk2(float lo, float hi) { return f2bf(lo) | (f2bf(hi) << 16); }

#define XB_TMO      128
#define XB_XCNT(j)  (256  + 64 * (j))
#define XB_XSUB(j)  (1280 + 64 * (j))
#define XB_XGEN(j)  (2304 + 64 * (j))
#define XB_TOP      3328
#define XB_TOPGEN   3392
#define XCD_BAR_WORDS 3456
#define XB_SPIN_CAP (1u << 18)

__device__ __forceinline__ unsigned xb_ld(unsigned* p)              { return __hip_atomic_load(p, __ATOMIC_RELAXED, __HIP_MEMORY_SCOPE_AGENT); }
__device__ __forceinline__ unsigned xb_add(unsigned* p, unsigned v) { return __hip_atomic_fetch_add(p, v, __ATOMIC_RELAXED, __HIP_MEMORY_SCOPE_AGENT); }
__device__ __forceinline__ unsigned xb_xcc_id() { return (unsigned)__builtin_amdgcn_s_getreg((3 << 11) | 20) & 0xFu; }
#define XB_SPIN(cond, bar) do { unsigned _sp = 0; while (cond) { __builtin_amdgcn_s_sleep(1); \
    if ((++_sp & 255u) == 0u) { if (xb_ld(&(bar)[XB_TMO])) break; if (_sp > XB_SPIN_CAP) { atomicAdd(&(bar)[XB_TMO], 1u); break; } } } } while (0)

struct XcdBarrier {
    unsigned* bar; unsigned x;
    volatile LAS unsigned* st;
};

__device__ __forceinline__ XcdBarrier xcd_barrier_post(unsigned* bar, volatile LAS unsigned* st) {
    XcdBarrier b; b.bar = bar; b.x = xb_xcc_id(); b.st = st;
    if (threadIdx.x == 0) (void)xb_add(&bar[XB_XCNT(b.x)], 1u);
    return b;
}
__device__ __forceinline__ void xcd_barrier_complete(unsigned* bar, unsigned x, unsigned& nloc, unsigned& nx) {
    const unsigned G = gridDim.x * gridDim.y * gridDim.z;
    unsigned sum, cnt, mine, sp = 0u;
    for (;;) {
        sum = 0u; cnt = 0u; mine = 0u;
#pragma unroll
        for (unsigned j = 0; j < 16; ++j) { const unsigned c = xb_ld(&bar[XB_XCNT(j)]); sum += c; cnt += (c > 0u) ? 1u : 0u; mine = (j == x) ? c : mine; }
        if (sum == G) break;
        __builtin_amdgcn_s_sleep(1);
        if ((++sp & 255u) == 0u) { if (xb_ld(&bar[XB_TMO])) break; if (sp > XB_SPIN_CAP) { atomicAdd(&bar[XB_TMO], 1u); break; } }
    }
    nloc = mine > 0u ? mine : 1u; nx = cnt > 0u ? cnt : 1u;
}

__device__ __forceinline__ void xcd_barrier(const XcdBarrier& b, const bool thread0) {
    asm volatile("s_waitcnt vmcnt(0)" ::: "memory");
    __syncthreads();
    if (thread0) {
        unsigned* bar = b.bar;
        __builtin_amdgcn_s_waitcnt(0);
        unsigned nloc = b.st[0], nx = b.st[1];
        if (nloc == 0u) { xcd_barrier_complete(bar, b.x, nloc, nx); b.st[0] = nloc; b.st[1] = nx; }
        const unsigned old = xb_add(&bar[XB_XSUB(b.x)], 1u);
        const unsigned gen = old / nloc;
        if (old + 1u == (gen + 1u) * nloc) {
            __builtin_amdgcn_fence(__ATOMIC_RELEASE, "agent");
            asm volatile("s_waitcnt vmcnt(0)" ::: "memory");
            const unsigned og = xb_add(&bar[XB_TOP], 1u);
            const unsigned tg = og / nx;
            if (og + 1u == (tg + 1u) * nx) xb_add(&bar[XB_TOPGEN], 1u);
            else XB_SPIN(xb_ld(&bar[XB_TOPGEN]) == tg, bar);
            __builtin_amdgcn_fence(__ATOMIC_ACQUIRE, "agent");
            xb_add(&bar[XB_XGEN(b.x)], 1u);
            asm volatile("s_waitcnt vmcnt(0)" ::: "memory");
        } else {
            XB_SPIN(xb_ld(&bar[XB_XGEN(b.x)]) == gen, bar);
            __builtin_amdgcn_fence(__ATOMIC_ACQUIRE, "agent");
            asm volatile("s_waitcnt vmcnt(0)" ::: "memory");
        }
    }
    __syncthreads();
}

struct Args { const float* in[34]; float* out; unsigned char* ws; int ph_lo, ph_hi, grid, pad; };
enum { I_XP = 0, I_XS, I_CP, I_CS, I_CK, I_CV, I_SRE, I_SIM, I_SCONV, I_WADA, I_BADA, I_LNG, I_LNB, I_WUP, I_WDC, I_BDC, I_WDOWN, I_WIN, I_LRE, I_LIM, I_LSTEP, I_BRE, I_BIM, I_CRE, I_CIM, I_SSMD, I_WGLU, I_WQKV, I_LQ1, I_LK1, I_LQ2, I_LK2, I_SUBG, I_WO };


typedef __attribute__((address_space(4))) const Args* CArgsP;
__device__ __forceinline__ CArgsP launder_args(CArgsP p) { asm volatile("" : "+s"(p)); return p; }
__device__ __forceinline__ int mk_lane() { int r; asm volatile("v_mbcnt_lo_u32_b32 %0, -1, 0\n\tv_mbcnt_hi_u32_b32 %0, -1, %0" : "=v"(r)); return r; }
#define REPEAT(k)
#define PHASE_ARGS const int lane = mk_lane(), tid = wave * 64 + lane; (void)tid; const Args& A = *(const Args*)launder_args((CArgsP)__builtin_amdgcn_kernarg_segment_ptr()); const int G = A.grid, bx = blockIdx.x, gw = bx * NWAVES + wave, NGW = G * NWAVES, vcu = (G % 8 == 0) ? (bx % 8) * (G / 8) + bx / 8 : bx; (void)gw; (void)NGW; (void)vcu
namespace pg8 {
__device__ __forceinline__ float dpp_ror1(float x) { return __builtin_bit_cast(float, __builtin_amdgcn_update_dpp(0, __builtin_bit_cast(int, x), 0x121, 0xf, 0xf, false)); }
__device__ __forceinline__ float dpp_ror2(float x) { return __builtin_bit_cast(float, __builtin_amdgcn_update_dpp(0, __builtin_bit_cast(int, x), 0x122, 0xf, 0xf, false)); }
template <int layer> struct EpiUpConv {
    static constexpr bool PERM = true, AFTER_DRAIN = false;
    __device__ static __forceinline__ unsigned pk4(float a, float b, float c, float d) {
        a = __builtin_amdgcn_fmed3f(a * 32.f, -448.f, 448.f); b = __builtin_amdgcn_fmed3f(b * 32.f, -448.f, 448.f); c = __builtin_amdgcn_fmed3f(c * 32.f, -448.f, 448.f); d = __builtin_amdgcn_fmed3f(d * 32.f, -448.f, 448.f);
        unsigned w = 0u; w = (unsigned)__builtin_amdgcn_cvt_pk_fp8_f32(a, b, (int)w, false); w = (unsigned)__builtin_amdgcn_cvt_pk_fp8_f32(c, d, (int)w, true); return w; }
    __device__ __forceinline__ void operator()(const f32x4 (&acc)[2][2][4][2], const Unit& u, int wr, int wc, int fr, int fq) const {
        typedef unsigned u32x2 __attribute__((ext_vector_type(2)));
        const Args& Aq = *(const Args*)launder_args((CArgsP)__builtin_amdgcn_kernarg_segment_ptr());
        unsigned char* const ws = Aq.ws; unsigned char* const ACT = ws + WS_ACT8; float* const GT = (float*)(ws + WS_GT); float* const FR = (float*)(ws + WS_FR);
        const float* const wdc = Aq.in[I_WDC] + (size_t)layer * 3 * DFF; const float* const bdc = Aq.in[I_BDC] + (size_t)layer * DFF; const float* const stc = Aq.in[I_SCONV] + (size_t)layer * 16 * 2 * DFF;
        PG8_LAS unsigned char* const xch = (PG8_LAS unsigned char*)0 + XCH_OFF;
        const int col = u.pn * HALF + wc * 32 + 8 * fq;
        float w0[8], w1[8], w2[8], bb[8];
        { const f32x4 a0 = *(const f32x4*)(wdc + col), a1 = *(const f32x4*)(wdc + col + 4), b0 = *(const f32x4*)(wdc + 5632 + col), b1 = *(const f32x4*)(wdc + 5632 + col + 4),
                      c0 = *(const f32x4*)(wdc + 2 * 5632 + col), c1 = *(const f32x4*)(wdc + 2 * 5632 + col + 4), d0 = *(const f32x4*)(bdc + col), d1 = *(const f32x4*)(bdc + col + 4);
#pragma unroll
          for (int e = 0; e < 4; ++e) { w0[e] = a0[e]; w0[4 + e] = a1[e]; w1[e] = b0[e]; w1[4 + e] = b1[e]; w2[e] = c0[e]; w2[4 + e] = c1[e]; bb[e] = d0[e]; bb[4 + e] = d1[e]; } }
        if (fr >= 14) {
#pragma unroll
            for (int ai = 0; ai < 2; ++ai) { PG8_LAS unsigned char* p = xch + (size_t)(((((ai * 2 + wr) * 4 + wc) * 2 + (fr - 14)) * 4 + fq) * 32);
                *(PG8_LAS f32x4*)p = acc[ai][0][3][0]; *(PG8_LAS f32x4*)(p + 16) = acc[ai][0][3][1]; } }
        asm volatile("s_waitcnt lgkmcnt(0)" ::: "memory"); __builtin_amdgcn_s_barrier(); asm volatile("" ::: "memory");
        const bool samp = u.pm >= (EP_MP / BM);
        int rb = u.pm * BM + wr * 64 + fr; asm volatile("" : "+v"(rb));
#pragma unroll
        for (int ai = 0; ai < 2; ++ai) {
            float xb1[8], xb2[8]; bool defer = false;
            if (ai == 0 && wr == 0) {
#pragma unroll
                for (int e = 0; e < 8; ++e) { xb1[e] = 0.f; xb2[e] = 0.f; }
                defer = !samp && (u.pm & 15) != 0;
            } else { const int ps = (wr == 1) ? ai * 2 : (ai - 1) * 2 + 1;
                const PG8_LAS unsigned char* p = xch + (size_t)((((ps * 4 + wc) * 2 + 0) * 4 + fq) * 32);
                const f32x4 q0 = *(const PG8_LAS f32x4*)p, q1 = *(const PG8_LAS f32x4*)(p + 16), r0 = *(const PG8_LAS f32x4*)(p + 128), r1 = *(const PG8_LAS f32x4*)(p + 144);
#pragma unroll
                for (int e = 0; e < 4; ++e) { xb2[e] = q0[e]; xb2[4 + e] = q1[e]; xb1[e] = r0[e]; xb1[4 + e] = r1[e]; } }
#pragma unroll
            for (int m = 0; m < 4; ++m) {
                const int r = rb + ai * HALF + m * 16;
                float g[8], v[8], p1[8], p2[8];
#pragma unroll
                for (int e = 0; e < 4; ++e) { g[e] = acc[ai][0][m][0][e]; g[4 + e] = acc[ai][0][m][1][e]; v[e] = acc[ai][1][m][0][e]; v[4 + e] = acc[ai][1][m][1][e]; }
#pragma unroll
                for (int e = 0; e < 8; ++e) {
                    const float s1 = dpp_ror1(g[e]), s2 = dpp_ror2(g[e]);
                    float c1, c2;
                    if (m > 0) { const float gp = e < 4 ? acc[ai][0][m - 1][0][e] : acc[ai][0][m - 1][1][e - 4]; c1 = dpp_ror1(gp); c2 = dpp_ror2(gp); }
                    else { c1 = xb1[e]; c2 = (fr == 0) ? xb2[e] : xb1[e]; }
                    p1[e] = (fr >= 1) ? s1 : c1; p2[e] = (fr >= 2) ? s2 : c2; }
                if (samp && (r & 31) < 2) { const float* st = stc + (size_t)(((r - EP_MP) >> 5) * 2) * 5632 + col;
                    const f32x4 a0 = *(const f32x4*)st, a1 = *(const f32x4*)(st + 4), b0 = *(const f32x4*)(st + 5632), b1 = *(const f32x4*)(st + 5632 + 4);
                    if ((r & 31) == 0) {
#pragma unroll
                        for (int e = 0; e < 4; ++e) { p2[e] = a0[e]; p2[4 + e] = a1[e]; p1[e] = b0[e]; p1[4 + e] = b1[e]; } }
                    else {
#pragma unroll
                        for (int e = 0; e < 4; ++e) { p2[e] = b0[e]; p2[4 + e] = b1[e]; } } }
                float o[8];
#pragma unroll
                for (int e = 0; e < 8; e += 2) { const float c0 = bb[e] + w0[e] * p2[e] + w1[e] * p1[e] + w2[e] * g[e], c1 = bb[e + 1] + w0[e + 1] * p2[e + 1] + w1[e + 1] * p1[e + 1] + w2[e + 1] * g[e + 1];
                    const f32x2 a = gelu_pk((f32x2){c0, c1}); o[e] = a.x * v[e]; o[e + 1] = a.y * v[e + 1]; }
                if (defer && m == 0 && fr < 2) {
                    float* fp = FR + (size_t)((u.pm * 2 + fr) * 2) * 5632 + col;
                    *(f32x4*)fp = (f32x4){g[0], g[1], g[2], g[3]}; *(f32x4*)(fp + 4) = (f32x4){g[4], g[5], g[6], g[7]};
                    *(f32x4*)(fp + 5632) = (f32x4){v[0], v[1], v[2], v[3]}; *(f32x4*)(fp + 5632 + 4) = (f32x4){v[4], v[5], v[6], v[7]};
                } else { u32x2 w; w.x = pk4(o[0], o[1], o[2], o[3]); w.y = pk4(o[4], o[5], o[6], o[7]); *(u32x2*)(ACT + (size_t)r * 5632 + col) = w; }
                if (ai == 1 && wr == 1 && m == 3 && fr >= 14) { float* gp = GT + (size_t)(u.pm * 2 + (fr - 14)) * 5632 + col;
                    *(f32x4*)gp = (f32x4){g[0], g[1], g[2], g[3]}; *(f32x4*)(gp + 4) = (f32x4){g[4], g[5], g[6], g[7]}; }
            }
        }
        asm volatile("s_waitcnt lgkmcnt(0)" ::: "memory"); __builtin_amdgcn_s_barrier(); asm volatile("" ::: "memory");
    }
};
}

__device__ __forceinline__ float wave_sum(float v) {
#pragma unroll
    for (int o = 1; o < 64; o <<= 1) v += __shfl_xor(v, o);
    return v;
}
__device__ __forceinline__ unsigned cvtpk2(float lo, float hi) { unsigned r; asm volatile("v_cvt_pk_bf16_f32 %0, %1, %2" : "=v"(r) : "v"(lo), "v"(hi)); return r; }
__device__ __forceinline__ int row_stream(int r) { return r < MP ? (r >> 12) : 8 + ((r - MP) >> 5); }

__device__ __forceinline__ void p0_transpose_item(const float* W, int K, int N, bf16* WT, int kind, LAS float* scr, int item, int lane) {
    const int nblk = N / 32, kb = item / nblk, nb = item % nblk, k0 = 64 * kb, n0 = 32 * nb;
    int d0 = n0;
    if (kind == 1) { const int hn = N / 2, half = n0 / hn, rem = n0 % hn; d0 = 256 * (rem >> 7) + 128 * half + (rem & 127); }
    { float tv[32]; const float* wp = W + (size_t)(k0 + (lane >> 5)) * N + n0 + (lane & 31);
#pragma unroll
      for (int i = 0; i < 32; ++i) tv[i] = wp[(size_t)(2 * i) * N];
#pragma unroll
      for (int i = 0; i < 32; ++i) scr[(2 * i + (lane >> 5)) * 33 + (lane & 31)] = tv[i]; }
    LDS_WAIT(); asm volatile("" ::: "memory");
    const int c = lane & 7;
#pragma unroll
    for (int j = 0; j < 4; ++j) { const int n = (lane >> 3) + 8 * j; const LAS float* s = scr + (8 * c) * 33 + n;
        v4u o; o.x = pk2(s[0 * 33], s[1 * 33]); o.y = pk2(s[2 * 33], s[3 * 33]); o.z = pk2(s[4 * 33], s[5 * 33]); o.w = pk2(s[6 * 33], s[7 * 33]);
        *(GAS v4u*)(WT + (size_t)(d0 + n) * K + k0 + 8 * c) = o; }
    LDS_WAIT(); asm volatile("" ::: "memory");
}

__device__ __forceinline__ unsigned pk4_fp8(float a, float b, float c, float d) {
    a = __builtin_amdgcn_fmed3f(a, -448.f, 448.f); b = __builtin_amdgcn_fmed3f(b, -448.f, 448.f); c = __builtin_amdgcn_fmed3f(c, -448.f, 448.f); d = __builtin_amdgcn_fmed3f(d, -448.f, 448.f);
    unsigned w = 0u; w = (unsigned)__builtin_amdgcn_cvt_pk_fp8_f32(a, b, (int)w, false); w = (unsigned)__builtin_amdgcn_cvt_pk_fp8_f32(c, d, (int)w, true); return w;
}
__device__ __forceinline__ void p0_transpose_item_fp8(const float* W, int K, int N, unsigned char* WT, int kind, float scale, LAS float* scr, int item, int lane) {
    const int nblk = N / 32, kb = item / nblk, nb = item % nblk, k0 = 64 * kb, n0 = 32 * nb;
    int d0 = n0;
    if (kind == 1) { const int hn = N / 2, half = n0 / hn, rem = n0 % hn; d0 = 256 * (rem >> 7) + 128 * half + (rem & 127); }
    { float tv[32]; const float* wp = W + (size_t)(k0 + (lane >> 5)) * N + n0 + (lane & 31);
#pragma unroll
      for (int i = 0; i < 32; ++i) tv[i] = wp[(size_t)(2 * i) * N];
#pragma unroll
      for (int i = 0; i < 32; ++i) scr[(2 * i + (lane >> 5)) * 33 + (lane & 31)] = tv[i]; }
    LDS_WAIT(); asm volatile("" ::: "memory");
    const int n = lane >> 1, kh = (lane & 1) * 32; const LAS float* sp = scr + kh * 33 + n;
    v4u o0, o1;
    o0.x = pk4_fp8(sp[0 * 33] * scale, sp[1 * 33] * scale, sp[2 * 33] * scale, sp[3 * 33] * scale);     o0.y = pk4_fp8(sp[4 * 33] * scale, sp[5 * 33] * scale, sp[6 * 33] * scale, sp[7 * 33] * scale);
    o0.z = pk4_fp8(sp[8 * 33] * scale, sp[9 * 33] * scale, sp[10 * 33] * scale, sp[11 * 33] * scale);   o0.w = pk4_fp8(sp[12 * 33] * scale, sp[13 * 33] * scale, sp[14 * 33] * scale, sp[15 * 33] * scale);
    o1.x = pk4_fp8(sp[16 * 33] * scale, sp[17 * 33] * scale, sp[18 * 33] * scale, sp[19 * 33] * scale); o1.y = pk4_fp8(sp[20 * 33] * scale, sp[21 * 33] * scale, sp[22 * 33] * scale, sp[23 * 33] * scale);
    o1.z = pk4_fp8(sp[24 * 33] * scale, sp[25 * 33] * scale, sp[26 * 33] * scale, sp[27 * 33] * scale); o1.w = pk4_fp8(sp[28 * 33] * scale, sp[29 * 33] * scale, sp[30 * 33] * scale, sp[31 * 33] * scale);
    GAS v4u* dst = (GAS v4u*)(WT + (size_t)(d0 + n) * K + k0 + kh); dst[0] = o0; dst[1] = o1;
    LDS_WAIT(); asm volatile("" ::: "memory");
}
__device__ __forceinline__ void sincos_cw(float x, float& s, float& c) {
    const float k = rintf(x * 0.63661977236758134f);
    float r = fmaf(k, -1.5703125f, x); r = fmaf(k, -4.837512969970703125e-4f, r); r = fmaf(k, -7.54978995489188216e-8f, r);
    const float r2 = r * r;
    const float sp = r + r * r2 * (-1.6666654611e-1f + r2 * (8.3321608736e-3f + r2 * -1.9515295891e-4f));
    const float cp = 1.0f - 0.5f * r2 + r2 * r2 * (4.166664568298827e-2f + r2 * (-1.388731625493765e-3f + r2 * 2.443315711809948e-5f));
    const int q = (int)k & 3;
    const float ss = (q & 1) ? cp : sp, cc = (q & 1) ? sp : cp;
    s = (q & 2) ? -ss : ss; c = ((q + 1) & 2) ? -cc : cc;
}
__device__ __forceinline__ void p0_ssm_tables(const Args& A, int g, int lane) {
    const int p = lane;
    const float lr = fminf(A.in[I_LRE][g * 64 + p], -1e-4f), li = A.in[I_LIM][g * 64 + p], dt = expf(A.in[I_LSTEP][g]);
    const float mag = expf(lr * dt); float sn, cs; sincos_cw(li * dt, sn, cs);
    const float ar = mag * cs, ai = mag * sn, nr = ar - 1.0f, ni = ai, den = lr * lr + li * li;
    const float kr = (nr * lr + ni * li) / den, ki = (ni * lr - nr * li) / den;
    float2* ab = (float2*)(A.ws + WS_ABAR); ab[g * 64 + p] = make_float2(ar, ai);
    bf16* bbt = (bf16*)(A.ws + WS_BBT) + (size_t)g * 128 * 16;
    const float* bre = A.in[I_BRE] + ((size_t)g * 64 + p) * 16; const float* bim = A.in[I_BIM] + ((size_t)g * 64 + p) * 16;
#pragma unroll
    for (int c = 0; c < 16; ++c) { const float br = bre[c], bi = bim[c];
        bbt[p * 16 + c] = (bf16)f2bf(kr * br - ki * bi); bbt[(64 + p) * 16 + c] = (bf16)f2bf(kr * bi + ki * br); }
    bf16* cmt = (bf16*)(A.ws + WS_CMT) + (size_t)g * 16 * 128;
#pragma unroll
    for (int c = 0; c < 16; ++c) { const float cr = A.in[I_CRE][((size_t)g * 16 + c) * 64 + p], ci = A.in[I_CIM][((size_t)g * 16 + c) * 64 + p];
        *(unsigned*)(cmt + c * 128 + 2 * p) = f2bf(cr) | (f2bf(-ci) << 16); }
}
__device__ __forceinline__ void p0_ada_item(const Args& A, LAS unsigned char* lds, int item, int tid, int wave, int lane) {
    const int l = item / 96, cb = item % 96;
    LAS float* SC = (LAS float*)lds;
    LAS float* RED = (LAS float*)(lds + 98304);
    float acx[24], acy[24];
#pragma unroll
    for (int s = 0; s < 24; ++s) { acx[s] = 0.f; acy[s] = 0.f; }
    const float* W = A.in[I_WADA] + (size_t)l * DM * 12288 + cb * 128 + lane * 2;
    for (int half = 0; half < 2; ++half) {
        for (int i = tid; i < 24 * 1024; i += 512) { const int s = i >> 10, k = (i & 1023) + half * 1024;
            const float c = s < 8 ? A.in[I_CP][s * DM + k] : A.in[I_CS][(s - 8) * DM + k]; SC[i] = c / (1.0f + __expf(-c)); }
        __syncthreads();
        const int k0 = wave * 128; const float* Wk = W + (size_t)(half * 1024 + k0) * 12288;
#pragma unroll 1
        for (int kb = 0; kb < 128; kb += 16) { pg8::f32x2 wv[16];
#pragma unroll
            for (int j = 0; j < 16; ++j) wv[j] = *(const pg8::f32x2*)(Wk + (size_t)(kb + j) * 12288);
#pragma unroll
            for (int j = 0; j < 16; ++j) {
#pragma unroll
                for (int s = 0; s < 24; ++s) { const float c = SC[s * 1024 + k0 + kb + j]; acx[s] = fmaf(c, wv[j].x, acx[s]); acy[s] = fmaf(c, wv[j].y, acy[s]); } } }
        __syncthreads();
    }
    for (int w8 = 0; w8 < 8; ++w8) {
        if (wave == w8) {
#pragma unroll
            for (int s = 0; s < 24; ++s) { pg8::f32x2 v; v.x = acx[s]; v.y = acy[s]; LAS pg8::f32x2* rp = (LAS pg8::f32x2*)(RED + s * 128 + lane * 2); if (w8) v += *rp; *rp = v; } }
        __syncthreads();
    }
    float* mod = (float*)(A.ws + WS_MOD);
    for (int i = tid; i < 24 * 128; i += 512) { const int s = i >> 7, c = i & 127; mod[((size_t)l * 24 + s) * 12288 + cb * 128 + c] = RED[i] + A.in[I_BADA][l * 12288 + cb * 128 + c]; }
    __syncthreads();
}
__device__ __forceinline__ void mod_row(const float* __restrict__ xr, const float* __restrict__ sc, const float* __restrict__ sh, bf16* __restrict__ hr, int lane) {
    f32x4 xa[4], xb[4];
#pragma unroll
    for (int j = 0; j < 4; ++j) { const int col = j * 512 + lane * 8; xa[j] = *(const f32x4*)(xr + col); xb[j] = *(const f32x4*)(xr + col + 4); }
#pragma unroll
    for (int j = 0; j < 4; ++j) { const int col = j * 512 + lane * 8;
        const f32x4 a0 = xa[j], a1 = xb[j], s0 = *(const f32x4*)(sc + col), s1 = *(const f32x4*)(sc + col + 4), h0 = *(const f32x4*)(sh + col), h1 = *(const f32x4*)(sh + col + 4);
        v4u w; w.x = cvtpk2(a0[0] * (1.f + s0[0]) + h0[0], a0[1] * (1.f + s0[1]) + h0[1]); w.y = cvtpk2(a0[2] * (1.f + s0[2]) + h0[2], a0[3] * (1.f + s0[3]) + h0[3]);
        w.z = cvtpk2(a1[0] * (1.f + s1[0]) + h1[0], a1[1] * (1.f + s1[1]) + h1[1]); w.w = cvtpk2(a1[2] * (1.f + s1[2]) + h1[2], a1[3] * (1.f + s1[3]) + h1[3]);
        *(v4u*)(hr + col) = w; }
}
#ifndef MK_DIAG_Y
#define MK_DIAG_Y 1.0f
#endif
__device__ __forceinline__ void ln_row(float* xr, const float* lg, const float* lb, const float* sc, const float* sh, bf16* hr, int lane, float dscale = 1.0f, unsigned char* h8 = nullptr) {
    f32x4 v[8]; float s = 0.f;
#pragma unroll
    for (int j = 0; j < 8; ++j) { v[j] = *(const f32x4*)(xr + j * 256 + lane * 4); s += (v[j][0] + v[j][1]) + (v[j][2] + v[j][3]); }
    const float mean = wave_sum(s) * (1.f / DM); float s2 = 0.f;
#pragma unroll
    for (int j = 0; j < 8; ++j) { v[j] = v[j] - mean; s2 += (v[j][0] * v[j][0] + v[j][1] * v[j][1]) + (v[j][2] * v[j][2] + v[j][3] * v[j][3]); }
    const float rstd = 1.f / sqrtf(wave_sum(s2) * (1.f / DM) + LN_EPS);
#pragma unroll
    for (int j = 0; j < 8; ++j) { const int col = j * 256 + lane * 4; const f32x4 g = *(const f32x4*)(lg + col), b = *(const f32x4*)(lb + col);
        f32x4 y;
#pragma unroll
        for (int e = 0; e < 4; ++e) y[e] = (v[j][e] * rstd * g[e] + b[e]) * dscale;
        *(f32x4*)(xr + col) = y;
        if (hr) { const f32x4 a = *(const f32x4*)(sc + col), h = *(const f32x4*)(sh + col);
            uint2 w; w.x = cvtpk2(y[0] * (1.f + a[0]) + h[0], y[1] * (1.f + a[1]) + h[1]); w.y = cvtpk2(y[2] * (1.f + a[2]) + h[2], y[3] * (1.f + a[3]) + h[3]);
            *(uint2*)(hr + col) = w; }
        if (h8) { const f32x4 a = *(const f32x4*)(sc + col), h = *(const f32x4*)(sh + col);
            *(unsigned*)(h8 + col) = pk4_fp8((y[0] * (1.f + a[0]) + h[0]) * F8_H1, (y[1] * (1.f + a[1]) + h[1]) * F8_H1, (y[2] * (1.f + a[2]) + h[2]) * F8_H1, (y[3] * (1.f + a[3]) + h[3]) * F8_H1); } }
}

template <int MODE> __device__ __forceinline__ void ln_rows_span(float* Xs, const float* stt, const float* lg, const float* lb, const float* modb, int sc_off, int sh_off, unsigned char* H8, bf16* HBp, int r0, int r1, int lane) {
    if (r0 >= r1) return;
    f32x4 Gv[8], Bv[8], v[8]; int cur = -1;
    { const float* xr = Xs + (size_t)r0 * DM + lane * 4;
#pragma unroll
      for (int j = 0; j < 8; ++j) v[j] = *(const f32x4*)(xr + j * 256); }
    float s0 = stt[2 * (size_t)r0], s1 = stt[2 * (size_t)r0 + 1];
    for (int r = r0; r < r1; ++r) {
        if ((r >> 12) != cur) { cur = r >> 12; const float* md = modb + (size_t)cur * 12288;
#pragma unroll
            for (int j = 0; j < 8; ++j) { const int col = j * 256 + lane * 4; const f32x4 g = *(const f32x4*)(lg + col), b = *(const f32x4*)(lb + col);
                if (MODE == 0) { Gv[j] = g; Bv[j] = b; }
                else { const f32x4 a = *(const f32x4*)(md + sc_off + col) + 1.0f, h = *(const f32x4*)(md + sh_off + col); const float F = MODE == 1 ? F8_H1 : 1.0f; Gv[j] = g * a * F; Bv[j] = (b * a + h) * F; } } }
        f32x4 vn[8]; float n0 = 0.f, n1 = 0.f;
        if (r + 1 < r1) { const float* xr = Xs + (size_t)(r + 1) * DM + lane * 4;
#pragma unroll
            for (int j = 0; j < 8; ++j) vn[j] = *(const f32x4*)(xr + j * 256);
            n0 = stt[2 * (size_t)(r + 1)]; n1 = stt[2 * (size_t)(r + 1) + 1]; }
        const float mu = s0 * (1.f / DM), rstd = 1.f / sqrtf(fmaxf(s1 * (1.f / DM) - mu * mu, 0.f) + LN_EPS);
#pragma unroll
        for (int j = 0; j < 8; ++j) { const int col = j * 256 + lane * 4; f32x4 z;
#pragma unroll
            for (int e = 0; e < 4; ++e) z[e] = ((v[j][e] - mu) * rstd) * Gv[j][e] + Bv[j][e];
            if (MODE == 0) *(f32x4*)(Xs + (size_t)r * DM + col) = z;
            else if (MODE == 1) *(unsigned*)(H8 + (size_t)r * DM + col) = pk4_fp8(z[0], z[1], z[2], z[3]);
            else { uint2 w; w.x = cvtpk2(z[0], z[1]); w.y = cvtpk2(z[2], z[3]); *(uint2*)(HBp + (size_t)r * DM + col) = w; } }
        if (r + 1 < r1) {
#pragma unroll
            for (int j = 0; j < 8; ++j) v[j] = vn[j];
            s0 = n0; s1 = n1; }
    }
}
#define SPAN_ROWS(NS, HW, NR, R0, R1) const int vw_ = bx < (NS) ? ((wave < (HW)) ? bx * (HW) + wave : -1) : (NS) * (HW) + (bx - (NS)) * NWAVES + wave, nv_ = (NS) * (HW) + (G - (NS)) * NWAVES; \
        const int R0 = vw_ < 0 ? 0 : (int)((long)vw_ * (NR) / nv_), R1 = vw_ < 0 ? 0 : (int)((long)(vw_ + 1) * (NR) / nv_)
__device__ __forceinline__ void ln_row_st(float* __restrict__ xr, const float* __restrict__ st, const float* __restrict__ lg, const float* __restrict__ lb, const float* __restrict__ sc, const float* __restrict__ sh, unsigned char* __restrict__ h8, bf16* __restrict__ hb, bool yout, int lane) {
    const float mu = st[0] * (1.f / DM), rstd = 1.f / sqrtf(fmaxf(st[1] * (1.f / DM) - mu * mu, 0.f) + LN_EPS);
    f32x4 v[8];
#pragma unroll
    for (int j = 0; j < 8; ++j) v[j] = *(const f32x4*)(xr + j * 256 + lane * 4);
#pragma unroll
    for (int j = 0; j < 8; ++j) { const int col = j * 256 + lane * 4; const f32x4 g = *(const f32x4*)(lg + col), b = *(const f32x4*)(lb + col);
        f32x4 y;
#pragma unroll
        for (int e = 0; e < 4; ++e) y[e] = (v[j][e] - mu) * rstd * g[e] + b[e];
        if (yout) *(f32x4*)(xr + col) = y;
        if (h8 || hb) { const f32x4 a = *(const f32x4*)(sc + col), h = *(const f32x4*)(sh + col);
            const float z0 = y[0] * (1.f + a[0]) + h[0], z1 = y[1] * (1.f + a[1]) + h[1], z2 = y[2] * (1.f + a[2]) + h[2], z3 = y[3] * (1.f + a[3]) + h[3];
            if (h8) *(unsigned*)(h8 + col) = pk4_fp8(z0 * F8_H1, z1 * F8_H1, z2 * F8_H1, z3 * F8_H1);
            if (hb) { uint2 w; w.x = cvtpk2(z0, z1); w.y = cvtpk2(z2, z3); *(uint2*)(hb + col) = w; } } }
}
__device__ __forceinline__ void down_sample_row(const Args& A, int layer, int r, int lane) {
    float* xr = A.out + OUT_Y + (size_t)r * DM; const float* p0 = (const float*)(A.ws + WS_PART) + (size_t)(r - MP) * DM; const float* p1 = p0 + (size_t)512 * DM;
    float* STAT = (float*)(A.ws + WS_STAT); const float* sti = STAT + ((size_t)(layer ? 2 : 0) * M + r) * 2; float* sto = STAT + ((size_t)(layer ? 3 : 1) * M + r) * 2;
    const float* lga = A.in[I_LNG] + (size_t)(layer * 2) * DM; const float* lba = A.in[I_LNB] + (size_t)(layer * 2) * DM;
    const float* lgb = A.in[I_LNG] + (size_t)(layer * 2 + 1) * DM; const float* lbb = A.in[I_LNB] + (size_t)(layer * 2 + 1) * DM;
    const float* MOD = (const float*)(A.ws + WS_MOD); const int st = row_stream(r);
    const float* gt = MOD + ((size_t)layer * NSTREAM + st) * 12288 + 5 * DM; const float* mdn = MOD + ((size_t)NSTREAM + st) * 12288;
    const float mu = sti[0] * (1.f / DM), rs = 1.f / sqrtf(fmaxf(sti[1] * (1.f / DM) - mu * mu, 0.f) + LN_EPS);
    f32x4 v[8]; float s1 = 0.f, s2 = 0.f;
#pragma unroll
    for (int j = 0; j < 8; ++j) { const int col = j * 256 + lane * 4; const f32x4 a = *(const f32x4*)(p0 + col), b = *(const f32x4*)(p1 + col), xp = *(const f32x4*)(xr + col), g = *(const f32x4*)(lga + col), bb = *(const f32x4*)(lba + col), ga = *(const f32x4*)(gt + col);
#pragma unroll
        for (int e = 0; e < 4; ++e) { const float x = (xp[e] - mu) * rs * g[e] + bb[e]; const float rn = 1.4142135623730951f * x + (1.f + ga[e]) * (a[e] + b[e]); v[j][e] = rn; s1 += rn; s2 += rn * rn; } }
    s1 = wave_sum(s1); s2 = wave_sum(s2);
    if (lane == 0) { sto[0] = s1; sto[1] = s2; }
    const float mu2 = s1 * (1.f / DM), rs2 = 1.f / sqrtf(fmaxf(s2 * (1.f / DM) - mu2 * mu2, 0.f) + LN_EPS);
#pragma unroll
    for (int j = 0; j < 8; ++j) { const int col = j * 256 + lane * 4; const f32x4 g = *(const f32x4*)(lgb + col), bb = *(const f32x4*)(lbb + col); f32x4 y;
#pragma unroll
        for (int e = 0; e < 4; ++e) y[e] = (v[j][e] - mu2) * rs2 * g[e] + bb[e];
        if (layer == 0) { *(f32x4*)(xr + col) = v[j]; const f32x4 a = *(const f32x4*)(mdn + 1 * DM + col), h = *(const f32x4*)(mdn + col);
            uint2 w; w.x = cvtpk2(y[0] * (1.f + a[0]) + h[0], y[1] * (1.f + a[1]) + h[1]); w.y = cvtpk2(y[2] * (1.f + a[2]) + h[2], y[3] * (1.f + a[3]) + h[3]);
            *(uint2*)((bf16*)(A.ws + WS_HB) + (size_t)r * DM + col) = w; }
        else *(f32x4*)(xr + col) = y; }
}
#ifndef MK_DIAG_SR
#define MK_DIAG_SR 1.0f
#endif
typedef short s16x4v __attribute__((ext_vector_type(4)));
typedef float f32x2v __attribute__((ext_vector_type(2)));
__device__ __forceinline__ void ssm_seq(const Args& A, LAS unsigned char* wl, int stream, int g, int lane) {
    const bool prompt = stream < 8;
    const int nch = prompt ? SEQ / 16 : TS / 16;
    const size_t row0 = prompt ? (size_t)stream * SEQ : (size_t)MP + (size_t)(stream - 8) * TS;
    const bf16* U = (const bf16*)(A.ws + WS_U) + row0 * DM + 16 * g;
    unsigned char* Z = (unsigned char*)(A.ws + WS_Z) + row0 * DM + 16 * g;
    const int n16 = lane & 15, q4 = lane >> 4;
    s16x4v bB[8]; bf16x8 cB[4]; s16x4v dB;
    { const bf16* bbt = (const bf16*)(A.ws + WS_BBT) + (size_t)g * 128 * 16;
#pragma unroll
      for (int nb = 0; nb < 8; ++nb) bB[nb] = *(const s16x4v*)(bbt + (16 * nb + n16) * 16 + 4 * q4);
      const bf16* cmt = (const bf16*)(A.ws + WS_CMT) + (size_t)g * 16 * 128;
#pragma unroll
      for (int ks = 0; ks < 4; ++ks) cB[ks] = *(const bf16x8*)(cmt + n16 * 128 + 32 * ks + 8 * q4);
      const short dv = (short)f2bf(A.in[I_SSMD][16 * g + n16]);
#pragma unroll
      for (int j = 0; j < 4; ++j) dB[j] = (4 * q4 + j == n16) ? dv : (short)0; }
    const float2 ab = ((const float2*)(A.ws + WS_ABAR))[g * 64 + lane];
    const float ar = ab.x, ai = ab.y;
    float hr = 0.f, hi = 0.f;
    if (!prompt) { hr = A.in[I_SRE][((size_t)(stream - 8) * NGRP + g) * SP + lane]; hi = A.in[I_SIM][((size_t)(stream - 8) * NGRP + g) * SP + lane]; }
    LAS unsigned char* hl = wl + 10240;
#define SSM_LD(ch) (*(const s16x4v*)(U + (size_t)((ch) * 16 + n16) * DM + 4 * q4))
#define SSM_STEP(ua, ch) do { \
        f32x4 bu[8]; \
        _Pragma("unroll") for (int nb = 0; nb < 8; ++nb) bu[nb] = __builtin_amdgcn_mfma_f32_16x16x16bf16_1k(ua, bB[nb], (f32x4){0.f, 0.f, 0.f, 0.f}, 0, 0, 0); \
        _Pragma("unroll") for (int nb = 0; nb < 8; ++nb) *(LAS f32x4*)(wl + ((16 * nb + n16) * 20 + 4 * q4) * 4) = bu[nb]; \
        LDS_WAIT(); asm volatile("" ::: "memory"); \
        f32x4 br[4], bi[4]; \
        _Pragma("unroll") for (int j = 0; j < 4; ++j) { br[j] = *(const LAS f32x4*)(wl + (lane * 20 + 4 * j) * 4); bi[j] = *(const LAS f32x4*)(wl + ((64 + lane) * 20 + 4 * j) * 4); } \
        _Pragma("unroll") for (int t = 0; t < 16; ++t) { \
            const float nhr = fmaf(ar, hr, fmaf(-ai, hi, br[t >> 2][t & 3])), nhi = fmaf(ar, hi, fmaf(ai, hr, bi[t >> 2][t & 3])); hr = nhr; hi = nhi; \
            *(LAS unsigned*)(hl + (t * 68 + lane) * 4) = cvtpk2(hr, hi); } \
        LDS_WAIT(); asm volatile("" ::: "memory"); \
        f32x4 y = (f32x4){0.f, 0.f, 0.f, 0.f}; \
        _Pragma("unroll") for (int ks = 0; ks < 4; ++ks) { const bf16x8 hA = *(const LAS bf16x8*)(hl + (n16 * 68 + 16 * ks + 4 * q4) * 4); y = __builtin_amdgcn_mfma_f32_16x16x32_bf16(hA, cB[ks], y, 0, 0, 0); } \
        { const f32x4 ysk = __builtin_amdgcn_mfma_f32_16x16x16bf16_1k(ua, dB, (f32x4){0.f, 0.f, 0.f, 0.f}, 0, 0, 0); y = y + ysk; }     \
        LDS_WAIT(); asm volatile("" ::: "memory"); \
        const pg8::f32x2 z0 = pg8::gelu_pk((pg8::f32x2){y[0], y[1]}), z1 = pg8::gelu_pk((pg8::f32x2){y[2], y[3]}); \
        unsigned char* zp = Z + (size_t)((ch) * 16 + 4 * q4) * DM + n16; \
        const unsigned w8 = pk4_fp8(z0.x * F8_Z, z0.y * F8_Z, z1.x * F8_Z, z1.y * F8_Z); \
        zp[0] = (unsigned char)(w8 & 0xffu); zp[DM] = (unsigned char)((w8 >> 8) & 0xffu); zp[2 * DM] = (unsigned char)((w8 >> 16) & 0xffu); zp[3 * DM] = (unsigned char)(w8 >> 24); \
    } while (0)
    s16x4v c0 = SSM_LD(0), c1 = SSM_LD(1), c2 = s16x4v{}, c3 = s16x4v{};
    if (nch > 2) { c2 = SSM_LD(2); c3 = SSM_LD(3); }
    for (int ch = 0; ch < nch; ch += 4) {
        s16x4v n0 = s16x4v{}, n1 = s16x4v{}, n2 = s16x4v{}, n3 = s16x4v{};
        if (ch + 4 < nch) { n0 = SSM_LD(ch + 4); n1 = SSM_LD(ch + 5); n2 = SSM_LD(ch + 6); n3 = SSM_LD(ch + 7); }
        SSM_STEP(c0, ch); SSM_STEP(c1, ch + 1);
        if (ch + 2 < nch) { SSM_STEP(c2, ch + 2); SSM_STEP(c3, ch + 3); }
        c0 = n0; c1 = n1; c2 = n2; c3 = n3;
    }
#undef SSM_LD
#undef SSM_STEP
    float* ore = A.out + (prompt ? OUT_SRP + ((size_t)stream * NGRP + g) * SP : OUT_SRS + ((size_t)(stream - 8) * NGRP + g) * SP);
    float* oim = A.out + (prompt ? OUT_SIP + ((size_t)stream * NGRP + g) * SP : OUT_SIS + ((size_t)(stream - 8) * NGRP + g) * SP);
    ore[lane] = hr * (prompt ? 1.0f : MK_DIAG_SR); oim[lane] = hi;
}


__device__ __forceinline__ void ssm_seq_sample_simple(const Args& A, int bs, int g, int lane) {
    const int p = lane;
    const size_t row0 = (size_t)MP + (size_t)bs * TS;
    const bf16* U = (const bf16*)(A.ws + WS_U) + row0 * DM + 16 * g;
    unsigned char* Z = (unsigned char*)(A.ws + WS_Z) + row0 * DM + 16 * g;
    const float lr = fminf(A.in[I_LRE][g * 64 + p], -1e-4f), li = A.in[I_LIM][g * 64 + p], dt = expf(A.in[I_LSTEP][g]);
    const float mag = expf(lr * dt); float sn, cs; sincos_cw(li * dt, sn, cs);
    const float ar = mag * cs, ai = mag * sn, nr = ar - 1.0f, ni = ai, den = lr * lr + li * li;
    const float kr = (nr * lr + ni * li) / den, ki = (ni * lr - nr * li) / den;
    float bbr[16], bbi[16], ccr[16], cci[16];
#pragma unroll
    for (int c = 0; c < 16; ++c) { const float br = A.in[I_BRE][((size_t)g * 64 + p) * 16 + c], bi = A.in[I_BIM][((size_t)g * 64 + p) * 16 + c];
        bbr[c] = kr * br - ki * bi; bbi[c] = kr * bi + ki * br;
        ccr[c] = A.in[I_CRE][((size_t)g * 16 + c) * 64 + p]; cci[c] = A.in[I_CIM][((size_t)g * 16 + c) * 64 + p]; }
    float hr = A.in[I_SRE][((size_t)bs * NGRP + g) * SP + p], hi = A.in[I_SIM][((size_t)bs * NGRP + g) * SP + p];
    const float dsk = A.in[I_SSMD][16 * g + (lane & 15)];
    for (int t = 0; t < TS; ++t) {
        float br = 0.f, bi = 0.f, myu = 0.f;
#pragma unroll
        for (int c = 0; c < 16; ++c) { const float uc = __uint_as_float((unsigned)U[(size_t)t * DM + c] << 16); br = fmaf(bbr[c], uc, br); bi = fmaf(bbi[c], uc, bi); if ((lane & 15) == c) myu = uc; }
        const float nhr = fmaf(ar, hr, fmaf(-ai, hi, br)), nhi = fmaf(ar, hi, fmaf(ai, hr, bi)); hr = nhr; hi = nhi;
        float yv = 0.f;
#pragma unroll
        for (int c = 0; c < 16; ++c) { const float s = wave_sum(ccr[c] * hr - cci[c] * hi); if ((lane & 15) == c) yv = s; }
        yv += dsk * myu;
        const pg8::f32x2 zz = pg8::gelu_pk((pg8::f32x2){yv, yv});
        if (lane < 16) Z[(size_t)t * DM + lane] = (unsigned char)(pk4_fp8(zz.x * F8_Z, 0.f, 0.f, 0.f) & 0xffu);
    }
    A.out[OUT_SRS + ((size_t)bs * NGRP + g) * SP + p] = hr; A.out[OUT_SIS + ((size_t)bs * NGRP + g) * SP + p] = hi;
}

__device__ __forceinline__ void fp8x8_to_f32(uint2 w, float (&o)[8]) {
    typedef float f2 __attribute__((ext_vector_type(2)));
    const f2 a = __builtin_amdgcn_cvt_pk_f32_fp8((int)w.x, false), b = __builtin_amdgcn_cvt_pk_f32_fp8((int)w.x, true), c = __builtin_amdgcn_cvt_pk_f32_fp8((int)w.y, false), d = __builtin_amdgcn_cvt_pk_f32_fp8((int)w.y, true);
    o[0] = a.x * (1.f / 64.f); o[1] = a.y * (1.f / 64.f); o[2] = b.x * (1.f / 64.f); o[3] = b.y * (1.f / 64.f); o[4] = c.x * (1.f / 64.f); o[5] = c.y * (1.f / 64.f); o[6] = d.x * (1.f / 64.f); o[7] = d.y * (1.f / 64.f);
}
__device__ __forceinline__ void conv_item(const Args& A, int layer, int item, int lane) {
    const int rb = item / 11, cs = item % 11, r0 = rb * 32, col = cs * 512 + lane * 8;
    const unsigned char* G = (const unsigned char*)(A.ws + WS_G); const unsigned char* V = (const unsigned char*)(A.ws + WS_V);
    const float* wc = A.in[I_WDC] + (size_t)layer * 3 * DFF + col; const float* bc = A.in[I_BDC] + (size_t)layer * DFF + col;
    float w0[8], w1[8], w2[8], bb[8], gm2[8], gm1[8];
#pragma unroll
    for (int e = 0; e < 8; ++e) { w0[e] = wc[e]; w1[e] = wc[DFF + e]; w2[e] = wc[2 * DFF + e]; bb[e] = bc[e]; gm2[e] = 0.f; gm1[e] = 0.f; }
    if (r0 >= MP) { const float* st = A.in[I_SCONV] + ((size_t)(layer * 16 + ((r0 - MP) >> 5)) * 2) * DFF + col;
#pragma unroll
        for (int e = 0; e < 8; ++e) { gm2[e] = st[e]; gm1[e] = st[DFF + e]; } }
    else if ((r0 & 4095) != 0) { fp8x8_to_f32(*(const uint2*)(G + (size_t)(r0 - 2) * DFF + col), gm2); fp8x8_to_f32(*(const uint2*)(G + (size_t)(r0 - 1) * DFF + col), gm1); }
#pragma unroll 4
    for (int t = 0; t < 32; ++t) {
        float gv[8], vv[8], o[8];
        fp8x8_to_f32(*(const uint2*)(G + (size_t)(r0 + t) * DFF + col), gv); fp8x8_to_f32(*(const uint2*)(V + (size_t)(r0 + t) * DFF + col), vv);
#pragma unroll
        for (int e = 0; e < 8; e += 2) { const float g0 = gv[e], g1 = gv[e + 1];
            const float c0 = bb[e] + w0[e] * gm2[e] + w1[e] * gm1[e] + w2[e] * g0, c1 = bb[e + 1] + w0[e + 1] * gm2[e + 1] + w1[e + 1] * gm1[e + 1] + w2[e + 1] * g1;
            const pg8::f32x2 a = pg8::gelu_pk((pg8::f32x2){c0, c1});
            o[e] = a.x * vv[e]; o[e + 1] = a.y * vv[e + 1];
            gm2[e] = gm1[e]; gm1[e] = g0; gm2[e + 1] = gm1[e + 1]; gm1[e + 1] = g1; }
        uint2 w; w.x = pk4_fp8(o[0] * F8_ACT, o[1] * F8_ACT, o[2] * F8_ACT, o[3] * F8_ACT); w.y = pk4_fp8(o[4] * F8_ACT, o[5] * F8_ACT, o[6] * F8_ACT, o[7] * F8_ACT);
        *(uint2*)((unsigned char*)(A.ws + WS_ACT8) + (size_t)(r0 + t) * DFF + col) = w;
    }
}


__device__ __forceinline__ void convfix_items(const Args& A, int layer, int gtid, int ngt) {
    const float* GT = (const float*)(A.ws + WS_GT); const float* FR = (const float*)(A.ws + WS_FR); unsigned char* ACT = (unsigned char*)(A.ws + WS_ACT8);
    const float* wc = A.in[I_WDC] + (size_t)layer * 3 * DFF; const float* bc = A.in[I_BDC] + (size_t)layer * DFF;
    for (int i = gtid; i < 120 * DFF; i += ngt) { const int j = i / DFF, col = i - j * DFF, pm = (j / 15) * 16 + (j % 15) + 1;
        const float gm2 = GT[(size_t)((pm - 1) * 2 + 0) * DFF + col], gm1 = GT[(size_t)((pm - 1) * 2 + 1) * DFF + col];
        const float g0 = FR[(size_t)((pm * 2 + 0) * 2 + 0) * DFF + col], v0 = FR[(size_t)((pm * 2 + 0) * 2 + 1) * DFF + col], g1 = FR[(size_t)((pm * 2 + 1) * 2 + 0) * DFF + col], v1 = FR[(size_t)((pm * 2 + 1) * 2 + 1) * DFF + col];
        const float w0 = wc[col], w1 = wc[DFF + col], w2 = wc[2 * DFF + col], bb = bc[col];
        const pg8::f32x2 a = pg8::gelu_pk((pg8::f32x2){bb + w0 * gm2 + w1 * gm1 + w2 * g0, bb + w0 * gm1 + w1 * g0 + w2 * g1});
        const unsigned w8 = pk4_fp8(a.x * v0 * F8_ACT, a.y * v1 * F8_ACT, 0.f, 0.f);
        ACT[(size_t)(pm * 256) * DFF + col] = (unsigned char)(w8 & 0xffu); ACT[(size_t)(pm * 256 + 1) * DFF + col] = (unsigned char)((w8 >> 8) & 0xffu); }
}
__device__ __forceinline__ void cvstate_item(const Args& A, int layer, LAS unsigned char* lds, int item, int tid) {
    const int cb = item % 88, q = item / 88;
    LAS float* H = (LAS float*)lds;
    const float* Xs = A.out + OUT_Y; const float* modl = (const float*)(A.ws + WS_MOD) + (size_t)layer * NSTREAM * 12288;
    for (int i = tid; i < 48 * 512; i += 512) { const int rr = i >> 9, k = (i & 511) + q * 512, st = rr >> 1, j = rr & 1;
        const size_t row = st < 8 ? (size_t)st * SEQ + (SEQ - 2) + j : (size_t)MP + (size_t)(st - 8) * TS + (TS - 2) + j; const float* md = modl + (size_t)st * 12288;
        const float* stt = (const float*)(A.ws + WS_STAT) + ((size_t)(layer ? 2 : 0) * M + row) * 2; const float mu = stt[0] * (1.f / DM), rstd = 1.f / sqrtf(fmaxf(stt[1] * (1.f / DM) - mu * mu, 0.f) + LN_EPS);
        const float x1 = (Xs[row * DM + k] - mu) * rstd * A.in[I_LNG][(size_t)(layer * 2) * DM + k] + A.in[I_LNB][(size_t)(layer * 2) * DM + k];
        H[i] = x1 * (1.0f + md[4 * DM + k]) + md[3 * DM + k]; }
    __syncthreads();
    const int c = tid & 63, rg = tid >> 6;
    const float* W = A.in[I_WUP] + (size_t)layer * DM * 2 * DFF + (size_t)(q * 512) * (2 * DFF) + cb * 64 + c;
    float acc[6];
#pragma unroll
    for (int i = 0; i < 6; ++i) acc[i] = 0.f;
    float wa[16], wb[16];
#pragma unroll
    for (int j = 0; j < 16; ++j) wa[j] = W[(size_t)j * (2 * DFF)];
    for (int k0 = 0; k0 < 512; k0 += 32) {
#pragma unroll
        for (int j = 0; j < 16; ++j) wb[j] = W[(size_t)(k0 + 16 + j) * (2 * DFF)];
#pragma unroll
        for (int j = 0; j < 16; ++j)
#pragma unroll
            for (int i = 0; i < 6; ++i) acc[i] = fmaf(H[(rg * 6 + i) * 512 + k0 + j], wa[j], acc[i]);
        if (k0 + 32 < 512) {
#pragma unroll
            for (int j = 0; j < 16; ++j) wa[j] = W[(size_t)(k0 + 32 + j) * (2 * DFF)]; }
#pragma unroll
        for (int j = 0; j < 16; ++j)
#pragma unroll
            for (int i = 0; i < 6; ++i) acc[i] = fmaf(H[(rg * 6 + i) * 512 + k0 + 16 + j], wb[j], acc[i]);
    }
    float* cvp = (float*)(A.ws + WS_CVP) + (size_t)q * 48 * DFF;
#pragma unroll
    for (int i = 0; i < 6; ++i) cvp[(size_t)(rg * 6 + i) * DFF + cb * 64 + c] = acc[i];
    __syncthreads();
}
__device__ __forceinline__ void cvstate_reduce(const Args& A, int layer, int gtid, int ngt) {
    const float* cvp = (const float*)(A.ws + WS_CVP);
    for (int i = gtid; i < 48 * DFF; i += ngt) { const int rr = i / DFF, col = i - rr * DFF, st = rr >> 1, j = rr & 1;
        const float v = (cvp[i] + cvp[(size_t)48 * DFF + i]) + (cvp[(size_t)2 * 48 * DFF + i] + cvp[(size_t)3 * 48 * DFF + i]);
        float* o = st < 8 ? A.out + OUT_CVP + ((size_t)(layer * 8 + st) * 2 + j) * DFF : A.out + OUT_CVS + ((size_t)(layer * 16 + (st - 8)) * 2 + j) * DFF;
        o[col] = v; }
}
__device__ __forceinline__ void comb_row_head(const Args& A, int r, int h, float lam, const f32x4 sg, int lane) {
    const bf16* op = (const bf16*)(A.ws + WS_OP) + (size_t)r * 4096 + h * 512 + lane * 4;
    const uint2 a = *(const uint2*)op, b = *(const uint2*)(op + 256);
    float o1[4], o2[4];
    o1[0] = __uint_as_float(a.x << 16); o1[1] = __uint_as_float(a.x & 0xffff0000u); o1[2] = __uint_as_float(a.y << 16); o1[3] = __uint_as_float(a.y & 0xffff0000u);
    o2[0] = __uint_as_float(b.x << 16); o2[1] = __uint_as_float(b.x & 0xffff0000u); o2[2] = __uint_as_float(b.y << 16); o2[3] = __uint_as_float(b.y & 0xffff0000u);
    float d[4], ss = 0.f;
#pragma unroll
    for (int e = 0; e < 4; ++e) { d[e] = o1[e] - lam * o2[e]; ss += d[e] * d[e]; }
    const float rs_ = 1.0f / sqrtf(wave_sum(ss) * (1.0f / 256.0f) + LN_EPS) * (1.0f - LAM_INIT);
    uint2 w; w.x = cvtpk2(d[0] * rs_ * sg[0], d[1] * rs_ * sg[1]); w.y = cvtpk2(d[2] * rs_ * sg[2], d[3] * rs_ * sg[3]);
    *(uint2*)((bf16*)(A.ws + WS_HB) + (size_t)r * DM + h * 256 + lane * 4) = w;
}
__device__ __forceinline__ void comb_rows8_head(const Args& A, int r0, int h, float lam, const f32x4 sg, int lane) {
    const bf16* op = (const bf16*)(A.ws + WS_OP) + (size_t)r0 * 4096 + h * 512 + lane * 4;
    uint2 a[8], b[8];
#pragma unroll
    for (int i = 0; i < 8; ++i) { a[i] = *(const uint2*)(op + (size_t)i * 4096); b[i] = *(const uint2*)(op + (size_t)i * 4096 + 256); }
#pragma unroll
    for (int i = 0; i < 8; ++i) {
        float d[4], ss = 0.f;
        d[0] = __uint_as_float(a[i].x << 16) - lam * __uint_as_float(b[i].x << 16); d[1] = __uint_as_float(a[i].x & 0xffff0000u) - lam * __uint_as_float(b[i].x & 0xffff0000u);
        d[2] = __uint_as_float(a[i].y << 16) - lam * __uint_as_float(b[i].y << 16); d[3] = __uint_as_float(a[i].y & 0xffff0000u) - lam * __uint_as_float(b[i].y & 0xffff0000u);
#pragma unroll
        for (int e = 0; e < 4; ++e) ss += d[e] * d[e];
        const float rs_ = 1.0f / sqrtf(wave_sum(ss) * (1.0f / 256.0f) + LN_EPS) * (1.0f - LAM_INIT);
        uint2 w; w.x = cvtpk2(d[0] * rs_ * sg[0], d[1] * rs_ * sg[1]); w.y = cvtpk2(d[2] * rs_ * sg[2], d[3] * rs_ * sg[3]);
        *(uint2*)((bf16*)(A.ws + WS_HB) + (size_t)(r0 + i) * DM + h * 256 + lane * 4) = w; }
}
__device__ __forceinline__ void comb_row(const Args& A, int r, float lam, int lane) {
    bf16* ob = (bf16*)(A.ws + WS_HB) + (size_t)r * DM;
    const f32x4 sg = *(const f32x4*)(A.in[I_SUBG] + lane * 4);
    constexpr float C = att::SCALE * 1.4426950408889634f;
    for (int h = 0; h < 8; ++h) {
        float o1[4], o2[4];
        if (r < MP) {
            const bf16* op = (const bf16*)(A.ws + WS_OP) + (size_t)r * 4096 + h * 512 + lane * 4;
            const uint2 a = *(const uint2*)op, b = *(const uint2*)(op + 256);
            o1[0] = __uint_as_float(a.x << 16); o1[1] = __uint_as_float(a.x & 0xffff0000u); o1[2] = __uint_as_float(a.y << 16); o1[3] = __uint_as_float(a.y & 0xffff0000u);
            o2[0] = __uint_as_float(b.x << 16); o2[1] = __uint_as_float(b.x & 0xffff0000u); o2[2] = __uint_as_float(b.y << 16); o2[3] = __uint_as_float(b.y & 0xffff0000u);
        } else {
            const int rs = r - MP, b = rs >> 5, row = rs & 31;
            const float* ops = (const float*)(A.ws + WS_OPS); const float* mls = (const float*)(A.ws + WS_MLS);
#pragma unroll
            for (int j = 0; j < 2; ++j) {
                const size_t p0 = ((((size_t)b * 8 + h) * 2 + 0) * 2 + j) * 32 + row, p1 = ((((size_t)b * 8 + h) * 2 + 1) * 2 + j) * 32 + row;
                const float m0 = mls[p0 * 2], l0 = mls[p0 * 2 + 1], m1 = mls[p1 * 2], l1 = mls[p1 * 2 + 1], mm = fmaxf(m0, m1);
                const float e0 = __builtin_amdgcn_exp2f((m0 - mm) * C), e1 = __builtin_amdgcn_exp2f((m1 - mm) * C), inv = 1.0f / (l0 * e0 + l1 * e1);
                const f32x4 a = *(const f32x4*)(ops + p0 * 256 + lane * 4), bq = *(const f32x4*)(ops + p1 * 256 + lane * 4);
#pragma unroll
                for (int e = 0; e < 4; ++e) { const float v = (a[e] * e0 + bq[e] * e1) * inv; if (j == 0) o1[e] = v; else o2[e] = v; }
            }
        }
        float d[4], ss = 0.f;
#pragma unroll
        for (int e = 0; e < 4; ++e) { d[e] = o1[e] - lam * o2[e]; ss += d[e] * d[e]; }
        const float rs_ = 1.0f / sqrtf(wave_sum(ss) * (1.0f / 256.0f) + LN_EPS) * (1.0f - LAM_INIT);
        uint2 w; w.x = cvtpk2(d[0] * rs_ * sg[0], d[1] * rs_ * sg[1]); w.y = cvtpk2(d[2] * rs_ * sg[2], d[3] * rs_ * sg[3]);
        *(uint2*)(ob + h * 256 + lane * 4) = w;
    }
}


__device__ __forceinline__ void ssm_pair(const Args& A, LAS unsigned char* pl, int stream, int g, int role, int lane) {
    const bool prompt = stream < 8; const int b = prompt ? stream : stream - 8;
    const int nch = prompt ? SEQ / 16 : TS / 16;
    const size_t row0 = prompt ? (size_t)stream * SEQ : (size_t)MP + (size_t)(stream - 8) * TS;
    const bf16* U = (const bf16*)(A.ws + WS_U) + row0 * DM + 16 * g;
    unsigned char* Z = (unsigned char*)(A.ws + WS_Z) + row0 * DM + 16 * g;
    const int n16 = lane & 15, q4 = lane >> 4;
#define PB_BUT(i) (pl + ((i) & 1) * 10240)
#define PB_H(i) (pl + 20480 + ((i) & 1) * 4352)
#define PB_BAR() do { asm volatile("s_waitcnt lgkmcnt(0)" ::: "memory"); __builtin_amdgcn_s_barrier(); asm volatile("" ::: "memory"); } while (0)
    if (role == 0) {
        const float2 ab = ((const float2*)(A.ws + WS_ABAR))[g * 64 + lane];
        const float ar = ab.x, ai = ab.y; float hr = 0.f, hi = 0.f;
        if (!prompt) { hr = A.in[I_SRE][((size_t)b * NGRP + g) * SP + lane]; hi = A.in[I_SIM][((size_t)b * NGRP + g) * SP + lane]; }
        PB_BAR();
        for (int i = 0; i < nch; ++i) {
            LAS unsigned char* wl = PB_BUT(i); LAS unsigned char* hl = PB_H(i);
            f32x4 br[4], bi[4];
#pragma unroll
            for (int j = 0; j < 4; ++j) { br[j] = *(const LAS f32x4*)(wl + (lane * 20 + 4 * j) * 4); bi[j] = *(const LAS f32x4*)(wl + ((64 + lane) * 20 + 4 * j) * 4); }
#pragma unroll
            for (int t = 0; t < 16; ++t) {
                const float nhr = fmaf(ar, hr, fmaf(-ai, hi, br[t >> 2][t & 3])), nhi = fmaf(ar, hi, fmaf(ai, hr, bi[t >> 2][t & 3])); hr = nhr; hi = nhi;
                *(LAS unsigned*)(hl + (t * 68 + lane) * 4) = cvtpk2(hr, hi); }
            PB_BAR();
        }
        A.out[(prompt ? OUT_SRP : OUT_SRS) + ((size_t)b * NGRP + g) * SP + lane] = hr; A.out[(prompt ? OUT_SIP : OUT_SIS) + ((size_t)b * NGRP + g) * SP + lane] = hi;
    } else {
        s16x4v bB[8]; bf16x8 cB[4]; s16x4v dB;
        { const bf16* bbt = (const bf16*)(A.ws + WS_BBT) + (size_t)g * 128 * 16;
#pragma unroll
          for (int nb = 0; nb < 8; ++nb) bB[nb] = *(const s16x4v*)(bbt + (16 * nb + n16) * 16 + 4 * q4);
          const bf16* cmt = (const bf16*)(A.ws + WS_CMT) + (size_t)g * 16 * 128;
#pragma unroll
          for (int ks = 0; ks < 4; ++ks) cB[ks] = *(const bf16x8*)(cmt + n16 * 128 + 32 * ks + 8 * q4);
          const short dv = (short)f2bf(A.in[I_SSMD][16 * g + n16]);
#pragma unroll
          for (int j = 0; j < 4; ++j) dB[j] = (4 * q4 + j == n16) ? dv : (short)0; }
#define PB_LD(ch) (*(const s16x4v*)(U + (size_t)((ch) * 16 + n16) * DM + 4 * q4))
#define PB_BU(ua, ch) do { LAS unsigned char* wl = PB_BUT(ch); \
            _Pragma("unroll") for (int nb = 0; nb < 8; ++nb) { const f32x4 bu = __builtin_amdgcn_mfma_f32_16x16x16bf16_1k(ua, bB[nb], (f32x4){0.f, 0.f, 0.f, 0.f}, 0, 0, 0); \
                *(LAS f32x4*)(wl + ((16 * nb + n16) * 20 + 4 * q4) * 4) = bu; } } while (0)
#define PB_CP(ua, ch) do { LAS unsigned char* hl = PB_H(ch); f32x4 y = (f32x4){0.f, 0.f, 0.f, 0.f}; \
            _Pragma("unroll") for (int ks = 0; ks < 4; ++ks) { const bf16x8 hA = *(const LAS bf16x8*)(hl + (n16 * 68 + 16 * ks + 4 * q4) * 4); y = __builtin_amdgcn_mfma_f32_16x16x32_bf16(hA, cB[ks], y, 0, 0, 0); } \
            { const f32x4 ysk = __builtin_amdgcn_mfma_f32_16x16x16bf16_1k(ua, dB, (f32x4){0.f, 0.f, 0.f, 0.f}, 0, 0, 0); y = y + ysk; } \
            const pg8::f32x2 z0 = pg8::gelu_pk((pg8::f32x2){y[0], y[1]}), z1 = pg8::gelu_pk((pg8::f32x2){y[2], y[3]}); \
            unsigned char* zp = Z + (size_t)((ch) * 16 + 4 * q4) * DM + n16; \
            const unsigned w8 = pk4_fp8(z0.x * F8_Z, z0.y * F8_Z, z1.x * F8_Z, z1.y * F8_Z); \
            zp[0] = (unsigned char)(w8 & 0xffu); zp[DM] = (unsigned char)((w8 >> 8) & 0xffu); zp[2 * DM] = (unsigned char)((w8 >> 16) & 0xffu); zp[3 * DM] = (unsigned char)(w8 >> 24); } while (0)
        s16x4v r0 = PB_LD(0), r1 = PB_LD(1), r2 = s16x4v{}, r3 = s16x4v{}, r4 = s16x4v{};
        if (nch > 2) { r2 = PB_LD(2); r3 = PB_LD(3); r4 = PB_LD(4); }
        PB_BU(r0, 0);
        s16x4v uprev = r0, ucur = r0;
        PB_BAR();
        for (int i = 0; i < nch; ++i) {
            const s16x4v rn = (i + 5 < nch) ? PB_LD(i + 5) : s16x4v{};
            if (i + 1 < nch) PB_BU(r1, i + 1);
            if (i >= 1) PB_CP(uprev, i - 1);
            uprev = ucur; ucur = r1; r1 = r2; r2 = r3; r3 = r4; r4 = rn;
            PB_BAR();
        }
        PB_CP(uprev, nch - 1);
    }
#undef PB_BUT
#undef PB_H
#undef PB_BAR
#undef PB_LD
#undef PB_BU
#undef PB_CP
}


struct TDesc { const float* W; unsigned char* WT; int K, N, kind, fp8, item; float scale; };
__device__ __forceinline__ void p0_decode(const Args& A, int r, TDesc& d) {
    constexpr int I_IN = 2048, I_GLU = 4096, I_UP = 11264, I_DN = 5632, I_QKV = 6144, I_O = 2048;
    if (r < I_IN) { d = TDesc{A.in[I_WIN], A.ws + WS_WIN, DM, DM, 0, 0, r, 1.f}; return; } r -= I_IN;
    if (r < I_GLU) { d = TDesc{A.in[I_WGLU], A.ws + WS_WGLU, DM, 2 * DM, 1, 1, r, F8_WGLU}; return; } r -= I_GLU;
    if (r < I_UP) { d = TDesc{A.in[I_WUP], A.ws + WS_WUP8, DM, 2 * DFF, 1, 1, r, F8_WUP}; return; } r -= I_UP;
    if (r < I_DN) { d = TDesc{A.in[I_WDOWN], A.ws + WS_WDOWN8, DFF, DM, 0, 1, r, F8_WDN}; return; } r -= I_DN;
    if (r < I_QKV) { d = TDesc{A.in[I_WQKV], A.ws + WS_WQKV, DM, 3 * DM, 0, 0, r, 1.f}; return; } r -= I_QKV;
    if (r < I_O) { d = TDesc{A.in[I_WO], A.ws + WS_WO, DM, DM, 0, 0, r, 1.f}; return; } r -= I_O;
    if (r < I_UP) { d = TDesc{A.in[I_WUP] + (size_t)DM * 2 * DFF, A.ws + WS_WUP8 + (size_t)22 * MiB, DM, 2 * DFF, 1, 1, r, F8_WUP}; return; } r -= I_UP;
    d = TDesc{A.in[I_WDOWN] + (size_t)DFF * DM, A.ws + WS_WDOWN8 + (size_t)11 * MiB, DFF, DM, 0, 1, r, F8_WDN};
}
constexpr int TI_P0 = 0, TI_WINB = 6144  , TI_UPB = 23040  , TI_QKVB = 31232  , TI_END = 48128;
__device__ __forceinline__ void p0_tload(const TDesc& d, float (&tv)[32], int lane) {
    const int nblk = d.N / 32, kb = d.item / nblk, nb = d.item % nblk;
    const float* wp = d.W + (size_t)(64 * kb + (lane >> 5)) * d.N + 32 * nb + (lane & 31);
#pragma unroll
    for (int i = 0; i < 32; ++i) tv[i] = wp[(size_t)(2 * i) * d.N];
}
__device__ __forceinline__ void p0_tstore(const TDesc& d, const float (&tv)[32], LAS float* scr, int lane) {
    const int nblk = d.N / 32, kb = d.item / nblk, nb = d.item % nblk, k0 = 64 * kb, n0 = 32 * nb, K = d.K;
    int d0 = n0;
    if (d.kind == 1) { const int hn = d.N / 2, half = n0 / hn, rem = n0 % hn; d0 = 256 * (rem >> 7) + 128 * half + (rem & 127); }
#pragma unroll
    for (int i = 0; i < 32; ++i) scr[(2 * i + (lane >> 5)) * 33 + (lane & 31)] = tv[i];
    LDS_WAIT(); asm volatile("" ::: "memory");
    if (d.fp8) {
        const float scale = d.scale; const int n = lane >> 1, kh = (lane & 1) * 32; const LAS float* sp = scr + kh * 33 + n;
        v4u o0, o1;
        o0.x = pk4_fp8(sp[0 * 33] * scale, sp[1 * 33] * scale, sp[2 * 33] * scale, sp[3 * 33] * scale);     o0.y = pk4_fp8(sp[4 * 33] * scale, sp[5 * 33] * scale, sp[6 * 33] * scale, sp[7 * 33] * scale);
        o0.z = pk4_fp8(sp[8 * 33] * scale, sp[9 * 33] * scale, sp[10 * 33] * scale, sp[11 * 33] * scale);   o0.w = pk4_fp8(sp[12 * 33] * scale, sp[13 * 33] * scale, sp[14 * 33] * scale, sp[15 * 33] * scale);
        o1.x = pk4_fp8(sp[16 * 33] * scale, sp[17 * 33] * scale, sp[18 * 33] * scale, sp[19 * 33] * scale); o1.y = pk4_fp8(sp[20 * 33] * scale, sp[21 * 33] * scale, sp[22 * 33] * scale, sp[23 * 33] * scale);
        o1.z = pk4_fp8(sp[24 * 33] * scale, sp[25 * 33] * scale, sp[26 * 33] * scale, sp[27 * 33] * scale); o1.w = pk4_fp8(sp[28 * 33] * scale, sp[29 * 33] * scale, sp[30 * 33] * scale, sp[31 * 33] * scale);
        GAS v4u* dst = (GAS v4u*)(d.WT + (size_t)(d0 + n) * K + k0 + kh); dst[0] = o0; dst[1] = o1;
    } else {
        const int c = lane & 7;
#pragma unroll
        for (int j = 0; j < 4; ++j) { const int n = (lane >> 3) + 8 * j; const LAS float* sp = scr + (8 * c) * 33 + n;
            v4u o; o.x = pk2(sp[0 * 33], sp[1 * 33]); o.y = pk2(sp[2 * 33], sp[3 * 33]); o.z = pk2(sp[4 * 33], sp[5 * 33]); o.w = pk2(sp[6 * 33], sp[7 * 33]);
            *(GAS v4u*)((bf16*)d.WT + (size_t)(d0 + n) * K + k0 + 8 * c) = o; }
    }
    LDS_WAIT(); asm volatile("" ::: "memory");
}

__device__ __forceinline__ void p0_wimages(const Args& A, LAS float* scr, int first, int last, int w, int NW, int lane) {
        int it = first + w;
        if (it < last) { TDesc cur; p0_decode(A, it, cur); float tv[32]; p0_tload(cur, tv, lane);
            for (;;) { const int nx = it + NW; TDesc nxt; float tn[32];
                if (nx < last) { p0_decode(A, nx, nxt); p0_tload(nxt, tn, lane); }
                p0_tstore(cur, tv, scr, lane);
                if (nx >= last) break;
                cur = nxt; it = nx;
#pragma unroll
                for (int i = 0; i < 32; ++i) tv[i] = tn[i]; } }
}
#define BUBBLE_IMAGES(NUNITS, FIRST, LAST) do { const int rem_ = (NUNITS) % G; const int lane_ = mk_lane(); if (bx >= rem_) p0_wimages(A, (LAS float*)(L + wave * 16384), (FIRST), (LAST), (bx - rem_) * NWAVES + wave, (G - rem_) * NWAVES, lane_); } while (0)
__device__ __forceinline__ void phase_p0a(const Args& A, LAS unsigned char* L, int bx, int G, int gw, int NGW, int wave, int lane, int tid) {
        for (int it = bx; it < 192; it += G) p0_ada_item(A, L, it, tid, wave, lane);
        __syncthreads();
        LAS float* scr = (LAS float*)(L + wave * 16384);
        const int na = G > 192 ? 192 : 0;
        if (bx >= na) { const int w = (bx - na) * NWAVES + wave, NW = (G - na) * NWAVES;
            for (int t = w; t < 128; t += NW) p0_ssm_tables(A, t, lane);
            p0_wimages(A, scr, TI_P0, TI_WINB, w, NW, lane); }
}
__device__ __forceinline__ void phase_scan(const Args& A, LAS unsigned char* L, int bx, int G, int wave, int lane) {
#if MK_PROBE_PAIR_SAMPLE
    { const int pr = wave & 3, role = wave >> 2; LAS unsigned char* pl = L + pr * 29184;
      for (int u = bx * 4 + pr; u < 16 * NGRP; u += G * 4) ssm_pair(A, pl, 8 + (u >> 7), u & 127, role, lane); }
#else
    { LAS unsigned char* wl = L + wave * 14592;
      for (int u = bx * NWAVES + wave; u < 16 * NGRP; u += G * NWAVES) ssm_seq(A, wl, 8 + (u >> 7), u & 127, lane); }
    __syncthreads();
#endif
    { const int pr = wave & 3, role = wave >> 2; LAS unsigned char* pl = L + pr * 29184;
      for (int u = bx * 4 + pr; u < 8 * NGRP; u += G * 4) ssm_pair(A, pl, u >> 7, u & 127, role, lane); }
}
__device__ __forceinline__ void phase_attn(const Args& A, unsigned char* lds, int vcu, int G, int tid) {
                const att::bf16* QB = (const att::bf16*)(A.ws + WS_Q); const att::bf16* KB = (const att::bf16*)(A.ws + WS_K); const att::bf16* VB = (const att::bf16*)(A.ws + WS_VA);
                att::bf16* OP = (att::bf16*)(A.ws + WS_OP);
#ifndef MK_NO_ATTP
                {
                  for (int gi_ = vcu; gi_ < (MK_REP == 110 ? 1024 : 512); gi_ += G) { const int gi = gi_ & 511;
                    const int qp = gi & 7, h = (gi >> 3) & 7, b = gi >> 6;
                    const size_t seq0 = (size_t)b * SEQ;
#pragma unroll 1
                    for (int u4 = 0; u4 < 4; ++u4) { const int s = 2 * h + (u4 >> 1), qb = (u4 & 1) ? qp : 15 - qp;
                        att::attn_prompt_unit2(A.ws, QB + (seq0 + qb * 256) * DM + s * 128, KB + seq0 * DM + s * 128, VB + seq0 * DM + h * 256, OP + (seq0 + qb * 256) * 4096 + s * 256, qb, (char*)lds, tid); }
                    asm volatile("s_waitcnt vmcnt(0)" ::: "memory"); __syncthreads();
                    const int lane = tid & 63, wid = tid >> 6;
                    float d1 = A.in[I_LQ1][lane] * A.in[I_LK1][lane] + A.in[I_LQ1][64 + lane] * A.in[I_LK1][64 + lane];
                    float d2 = A.in[I_LQ2][lane] * A.in[I_LK2][lane] + A.in[I_LQ2][64 + lane] * A.in[I_LK2][64 + lane];
                    const float lam = expf(wave_sum(d1)) - expf(wave_sum(d2)) + LAM_INIT;
                    const f32x4 sg = *(const f32x4*)(A.in[I_SUBG] + lane * 4);
#pragma unroll 1
                    for (int i = 0; i < 64; i += 8) { const int rr = wid * 64 + i, qb = (rr >> 8) ? qp : 15 - qp; comb_rows8_head(A, (int)seq0 + qb * 256 + (rr & 255), h, lam, sg, lane); }
                  } }
                __syncthreads();
#endif
#ifndef MK_NO_ATTS
                for (int si_ = vcu; si_ < (MK_REP == 111 ? 512 : 256); si_ += G) { const int si = si_ & 255;
                    att::attn_sample_unit(QB, KB, VB, A.in[I_CK], A.in[I_CV], (float*)(A.ws + WS_OPS), (float*)(A.ws + WS_MLS), si >> 4, (si >> 1) & 7, si & 1, (char*)lds, tid); }
#endif
}

#ifndef MK_PHMASK
#define MK_PHMASK 0x7ffff
#endif
__device__ __forceinline__ bool mk_in(int k) { const Args& Aq = *(const Args*)launder_args((CArgsP)__builtin_amdgcn_kernarg_segment_ptr()); return Aq.ph_lo <= k && k < Aq.ph_hi; }
#define IN(k) (((MK_PHMASK >> (k)) & 1) && mk_in(k))
#define SEAM(k) do { if (IN(k) && IN((k) + 1)) { XcdBarrier b_; b_.bar = (unsigned*)(A.ws + WS_CTL) + CW_BAR; b_.x = xb_xcc_id(); b_.st = (volatile LAS unsigned*)(L + MISC_OFF) + 8; xcd_barrier(b_, wave == 0 && mk_lane() == 0); if (MK_REP == 99) xcd_barrier(b_, wave == 0 && mk_lane() == 0); } } while (0)
#define GRIDBAR() do { XcdBarrier b_; b_.bar = (unsigned*)(A.ws + WS_CTL) + CW_BAR; b_.x = xb_xcc_id(); b_.st = (volatile LAS unsigned*)(L + MISC_OFF) + 8; xcd_barrier(b_, wave == 0 && mk_lane() == 0); if (MK_REP == 99) xcd_barrier(b_, wave == 0 && mk_lane() == 0); } while (0)
#define SHARE_ROWS(NS, HW, NR, BODY) do { const int vw_ = bx < (NS) ? ((wave < (HW)) ? bx * (HW) + wave : -1) : (NS) * (HW) + (bx - (NS)) * NWAVES + wave, nv_ = (NS) * (HW) + (G - (NS)) * NWAVES; \
        if (vw_ >= 0) for (int r__ = vw_; r__ < (NR); r__ += nv_) { BODY; } } while (0)
constexpr int CW_Q = 8192;
template <int layer> __device__ __forceinline__ void ffn_phases(LAS unsigned char* L, const int wave) {
        const int fb = layer ? 14 : 5;
        if (IN(fb)) {
            PHASE_ARGS; float* const Xs = A.out + OUT_Y; float* const MOD = (float*)(A.ws + WS_MOD); const float* modl = MOD + (size_t)layer * NSTREAM * 12288; (void)Xs; (void)modl;
            const float* lg = A.in[I_LNG] + (size_t)(layer * 2 + 0) * DM; const float* lb = A.in[I_LNB] + (size_t)(layer * 2 + 0) * DM;
            if (layer == 0) { pg8::Gemm g{(const bf16*)(A.ws + WS_Z), (const bf16*)(A.ws + WS_WGLU), M, 2 * DM, DM / 2, 1.0f / (F8_Z * F8_WGLU), A.ws}; pg8::StaticOrder S; S.init(MS, 2 * DM, G, bx, 1, MP / 256);
                pg8::EpiRes<true, false> E{A.in[I_XP], A.in[I_XS], Xs, MOD + 2 * DM, (float*)(A.ws + WS_STAT), nullptr, nullptr, nullptr};
                pg8::gemm_phase<pg8::EpiRes<true, false>, pg8::StaticOrder, true, true, true>(L, g, S, E, tid); }
            else { pg8::Gemm g{(const bf16*)(A.ws + WS_HB), (const bf16*)(A.ws + WS_WO), M, DM, DM, 0.f, A.ws}; pg8::StaticOrder S; S.init(MS, DM, G, bx, 1, MP / 256);
                float* const STAT = (float*)(A.ws + WS_STAT);
                pg8::EpiRes<false, true, 2> E{Xs, Xs + (size_t)MP * DM, Xs, MOD + (size_t)NSTREAM * 12288 + 2 * DM, STAT + (size_t)2 * M * 2, STAT + (size_t)1 * M * 2, A.in[I_LNG] + (size_t)1 * DM, A.in[I_LNB] + (size_t)1 * DM};
                pg8::gemm_phase<pg8::EpiRes<false, true, 2>, pg8::StaticOrder, true, true>(L, g, S, E, tid); }
            const float* stt = (const float*)(A.ws + WS_STAT) + (size_t)(layer ? 2 : 0) * M * 2;
            { const int lane_ = mk_lane(); SPAN_ROWS((layer ? 16 : 32), (layer ? 0 : 4), MP, r0_, r1_); ln_rows_span<1>(Xs, stt, lg, lb, modl, 4 * DM, 3 * DM, (unsigned char*)(A.ws + WS_HB), (bf16*)nullptr, r0_, r1_, lane_); }
            GRIDBAR();
            { const int lane = mk_lane(); for (int r = MP + gw; r < M; r += NGW) { const float* md = modl + (size_t)row_stream(r) * 12288; ln_row_st(Xs + (size_t)r * DM, stt + 2 * (size_t)r, lg, lb, md + 4 * DM, md + 3 * DM, (unsigned char*)(A.ws + WS_HB) + (size_t)r * DM, (bf16*)nullptr, false, lane); } }
            SEAM(fb);
        }
        if (IN(fb + 1)) {
            PHASE_ARGS;
            pg8::Gemm g{(const bf16*)(A.ws + WS_HB), (const bf16*)(A.ws + WS_WUP8 + (size_t)layer * 22 * MiB), M, 2 * DFF, DM / 2, 1.0f / (F8_H1 * F8_WUP), A.ws}; pg8::StaticOrder S; S.init(M, 2 * DFF, G, bx, (MK_REP == 6 && layer == 0) ? 2 : 1);
            pg8::EpiUpConv<layer> E{};
            pg8::gemm_phase<pg8::EpiUpConv<layer>, pg8::StaticOrder, true, true, true>(L, g, S, E, tid);
            if (layer == 0) BUBBLE_IMAGES((M / 256) * (2 * DFF / 256), TI_UPB, TI_QKVB);
            SEAM(fb + 1);
        }
        if (IN(fb + 2)) {
            PHASE_ARGS;
            convfix_items(A, layer, gw * 64 + lane, NGW * 64);
            for (int it_ = bx; it_ < ((MK_REP == 70 && layer == 0) ? 704 : 352); it_ += G) { const int it = it_ % 352; cvstate_item(A, layer, L, it, tid); }
            SEAM(fb + 2);
        }
        if (IN(fb + 3)) {
            PHASE_ARGS; float* const Xs = A.out + OUT_Y; float* const MOD = (float*)(A.ws + WS_MOD); const float* modl = MOD + (size_t)layer * NSTREAM * 12288; (void)Xs; (void)modl;
            pg8::Gemm g{(const bf16*)(A.ws + WS_ACT8), (const bf16*)(A.ws + WS_WDOWN8 + (size_t)layer * 11 * MiB), M, DM, DFF / 2, 1.0f / (F8_ACT * F8_WDN), A.ws}; pg8::StaticOrder S; S.init(MP, DM, G, bx);
            float* const STAT = (float*)(A.ws + WS_STAT);
            pg8::EpiRes<false, true, 1> E{Xs, Xs + (size_t)MP * DM, Xs, modl + 5 * DM, STAT + (size_t)(layer ? 3 : 1) * M * 2, STAT + (size_t)(layer ? 2 : 0) * M * 2, A.in[I_LNG] + (size_t)(layer * 2) * DM, A.in[I_LNB] + (size_t)(layer * 2) * DM};
            pg8::gemm_phase<pg8::EpiRes<false, true, 1>, pg8::StaticOrder, true, true, true>(L, g, S, E, tid);
            SEAM(fb + 3);
        }
        if (IN(fb + 4)) {
            PHASE_ARGS; float* const Xs = A.out + OUT_Y; float* const MOD = (float*)(A.ws + WS_MOD); const float* modl = MOD + (size_t)layer * NSTREAM * 12288; (void)Xs; (void)modl;
            const float* lg = A.in[I_LNG] + (size_t)(layer * 2 + 1) * DM; const float* lb = A.in[I_LNB] + (size_t)(layer * 2 + 1) * DM;
            const float* modn = MOD + (size_t)NSTREAM * 12288;
            { pg8::Gemm g{(const bf16*)(A.ws + WS_ACT8), (const bf16*)(A.ws + WS_WDOWN8 + (size_t)layer * 11 * MiB), M, DM, DFF / 2, 1.0f / (F8_ACT * F8_WDN), A.ws}; pg8::StaticOrder S; S.init(MS, DM, G, bx, 1, MP / 256, 2);
              pg8::EpiRaw E{(float*)(A.ws + WS_PART)};
              pg8::gemm_phase<pg8::EpiRaw, pg8::StaticOrder, true, true, true>(L, g, S, E, tid); }
            { const int lane = mk_lane();
            cvstate_reduce(A, layer, gw * 64 + lane, NGW * 64);
            const float* stt = (const float*)(A.ws + WS_STAT) + (size_t)(layer ? 3 : 1) * M * 2;
            { SPAN_ROWS(32, 0, MP, r0_, r1_); if (layer == 0) ln_rows_span<2>(Xs, stt, lg, lb, modn, 1 * DM, 0 * DM, (unsigned char*)nullptr, (bf16*)(A.ws + WS_HB), r0_, r1_, lane); else ln_rows_span<0>(Xs, stt, lg, lb, modn, 0, 0, (unsigned char*)nullptr, (bf16*)nullptr, r0_, r1_, lane); }
            GRIDBAR();
            for (int r = MP + gw; r < M; r += NGW) down_sample_row(A, layer, r, lane);
            }
            if (layer == 0) SEAM(9);
        }
    }

constexpr int NPHASE = 19;
__global__ void __launch_bounds__(NWAVES * 64, 2) mk_fwd(Args A0) {
    extern __shared__ __attribute__((aligned(16))) unsigned char lds[];
    LAS unsigned char* L = (LAS unsigned char*)lds;
    const int wave = __builtin_amdgcn_readfirstlane((int)threadIdx.x >> 6);
    for (int u = threadIdx.x; u < (LDS_BYTES - LDSCTL_OFF) / 4; u += NWAVES * 64) ((LAS unsigned*)(L + LDSCTL_OFF))[u] = 0u;
    __syncthreads();
    if (A0.ph_hi - A0.ph_lo > 1) (void)xcd_barrier_post((unsigned*)(A0.ws + WS_CTL) + CW_BAR, (volatile LAS unsigned*)(L + MISC_OFF) + 8);

    if (IN(0)) { PHASE_ARGS; float* const Xs = A.out + OUT_Y; float* const MOD = (float*)(A.ws + WS_MOD); bf16* const HB = (bf16*)(A.ws + WS_HB); (void)Xs; (void)MOD; (void)HB;
            REPEAT(0) {
        phase_p0a(A, L, bx, G, gw, NGW, wave, lane, tid);
#if MK_REP == 0
        __syncthreads(); phase_p0a(A, L, bx, G, gw, NGW, wave, lane, tid);
#endif
        }
            SEAM(0);
    }
    if (IN(1)) { PHASE_ARGS; float* const Xs = A.out + OUT_Y; float* const MOD = (float*)(A.ws + WS_MOD); bf16* const HB = (bf16*)(A.ws + WS_HB); (void)Xs; (void)MOD; (void)HB;
            REPEAT(1) {
        for (int r_ = gw; r_ < (MK_REP == 1 ? 2 * M : M); r_ += NGW) { const int r = r_ >= M ? r_ - M : r_; const float* xr = r < MP ? A.in[I_XP] + (size_t)r * DM : A.in[I_XS] + (size_t)(r - MP) * DM; const float* md = MOD + (size_t)row_stream(r) * 12288;
            mod_row(xr, md + 1 * DM, md + 0 * DM, HB + (size_t)r * DM, lane); }
        }
            SEAM(1);
    }
    {
        {
            if (IN(2)) { PHASE_ARGS; float* const Xs = A.out + OUT_Y; float* const MOD = (float*)(A.ws + WS_MOD); bf16* const HB = (bf16*)(A.ws + WS_HB); (void)Xs; (void)MOD; (void)HB;
                pg8::Gemm g{HB, (const bf16*)(A.ws + WS_WIN), M, DM, DM, 0.f, A.ws}; pg8::StaticOrder S; S.init(M, DM, G, bx, MK_REP == 2 ? 2 : 1);
                pg8::EpiBf16<0> E{(bf16*)(A.ws + WS_U), DM, nullptr, 0, 0, 1.f};
                pg8::gemm_phase<pg8::EpiBf16<0>, pg8::StaticOrder, true, true>(L, g, S, E, tid);
                BUBBLE_IMAGES((M / 256) * (DM / 256), TI_WINB, TI_UPB);
                SEAM(2);
            }
            if (IN(3)) { PHASE_ARGS; float* const Xs = A.out + OUT_Y; float* const MOD = (float*)(A.ws + WS_MOD); bf16* const HB = (bf16*)(A.ws + WS_HB); (void)Xs; (void)MOD; (void)HB;
            REPEAT(3) {
                phase_scan(A, L, bx, G, wave, lane);
#if MK_REP == 3
                phase_scan(A, L, bx, G, wave, lane);
#endif
                }
            SEAM(3);
            }
            if (IN(4)) { PHASE_ARGS; float* const Xs = A.out + OUT_Y; float* const MOD = (float*)(A.ws + WS_MOD); bf16* const HB = (bf16*)(A.ws + WS_HB); (void)Xs; (void)MOD; (void)HB;
                pg8::Gemm g{(const bf16*)(A.ws + WS_Z), (const bf16*)(A.ws + WS_WGLU), M, 2 * DM, DM / 2, 1.0f / (F8_Z * F8_WGLU), A.ws}; pg8::StaticOrder S; S.init(MP, 2 * DM, G, bx);
                pg8::EpiRes<true, false, 1> E{A.in[I_XP], A.in[I_XS], Xs, MOD + 2 * DM, (float*)(A.ws + WS_STAT), nullptr, nullptr, nullptr};
                pg8::gemm_phase<pg8::EpiRes<true, false, 1>, pg8::StaticOrder, true, true, true>(L, g, S, E, tid);
                SEAM(4);
            }
        }
        ffn_phases<0>(L, wave);
    }
    {
        {
            if (IN(10)) { PHASE_ARGS; float* const Xs = A.out + OUT_Y; float* const MOD = (float*)(A.ws + WS_MOD); bf16* const HB = (bf16*)(A.ws + WS_HB); (void)Xs; (void)MOD; (void)HB;
                pg8::Gemm g{HB, (const bf16*)(A.ws + WS_WQKV), M, 3 * DM, DM, 0.f, A.ws}; pg8::StaticOrder S; S.init(M, 3 * DM, G, bx, MK_REP == 10 ? 2 : 1);
                pg8::EpiQkv E{(bf16*)(A.ws + WS_Q), (size_t)(WS_K - WS_Q) / 2, A.out + OUT_KP, A.out + OUT_KS};
                pg8::gemm_phase<pg8::EpiQkv, pg8::StaticOrder, true, true>(L, g, S, E, tid);
                BUBBLE_IMAGES((M / 256) * (3 * DM / 256), TI_QKVB, TI_END);
                SEAM(10);
            }
            if (IN(11)) { PHASE_ARGS; float* const Xs = A.out + OUT_Y; float* const MOD = (float*)(A.ws + WS_MOD); bf16* const HB = (bf16*)(A.ws + WS_HB); (void)Xs; (void)MOD; (void)HB;
            REPEAT(11) {
                phase_attn(A, lds, vcu, G, tid);
#if MK_REP == 11
                phase_attn(A, lds, vcu, G, tid);
#endif
                }
            SEAM(11);
            }
            if (IN(12)) { PHASE_ARGS; float* const Xs = A.out + OUT_Y; float* const MOD = (float*)(A.ws + WS_MOD); bf16* const HB = (bf16*)(A.ws + WS_HB); (void)Xs; (void)MOD; (void)HB;
            REPEAT(12) {
                float d1 = A.in[I_LQ1][lane] * A.in[I_LK1][lane] + A.in[I_LQ1][64 + lane] * A.in[I_LK1][64 + lane];
                float d2 = A.in[I_LQ2][lane] * A.in[I_LK2][lane] + A.in[I_LQ2][64 + lane] * A.in[I_LK2][64 + lane];
                const float lam = expf(wave_sum(d1)) - expf(wave_sum(d2)) + LAM_INIT;
                for (int r = MP + gw; r < M; r += NGW) comb_row(A, r, lam, lane);
                }
            SEAM(12);
            }
            if (IN(13)) { PHASE_ARGS; float* const Xs = A.out + OUT_Y; float* const MOD = (float*)(A.ws + WS_MOD); bf16* const HB = (bf16*)(A.ws + WS_HB); (void)Xs; (void)MOD; (void)HB;
                pg8::Gemm g{HB, (const bf16*)(A.ws + WS_WO), M, DM, DM, 0.f, A.ws}; pg8::StaticOrder S; S.init(MP, DM, G, bx);
                float* const STAT = (float*)(A.ws + WS_STAT);
                pg8::EpiRes<false, true, 1> E{Xs, Xs + (size_t)MP * DM, Xs, MOD + (size_t)NSTREAM * 12288 + 2 * DM, STAT + (size_t)2 * M * 2, STAT + (size_t)1 * M * 2, A.in[I_LNG] + (size_t)1 * DM, A.in[I_LNB] + (size_t)1 * DM};
                pg8::gemm_phase<pg8::EpiRes<false, true, 1>, pg8::StaticOrder, true, true>(L, g, S, E, tid);
                SEAM(13);
            }
        }
        ffn_phases<1>(L, wave);
    }
#undef IN
#undef SEAM
}

extern "C" void kernel_launch(void* const* d_in, const int* in_sizes, int n_in, void* d_out, int out_size, void* d_ws, size_t ws_size, hipStream_t stream) {
    static int grid = 0;
    if (grid == 0) {
        if (n_in != 34 || out_size != (int)OUT_END || ws_size < WS_END) { fprintf(stderr, "kernel_launch: expected 34 inputs, %zu outputs, >= %zu ws bytes; got %d, %d, %zu\n", (size_t)OUT_END, (size_t)WS_END, n_in, out_size, ws_size); grid = -1; return; }
        int dev = 0, cus = 0, per_cu = 0;
        if (hipGetDevice(&dev) != hipSuccess || hipDeviceGetAttribute(&cus, hipDeviceAttributeMultiprocessorCount, dev) != hipSuccess) { grid = -1; return; }
        if (hipFuncSetAttribute((const void*)mk_fwd, hipFuncAttributeMaxDynamicSharedMemorySize, LDS_BYTES) != hipSuccess) { fprintf(stderr, "kernel_launch: hipFuncSetAttribute failed\n"); grid = -1; return; }
        if (hipOccupancyMaxActiveBlocksPerMultiprocessor(&per_cu, (const void*)mk_fwd, NWAVES * 64, LDS_BYTES) != hipSuccess || per_cu < 1) fprintf(stderr, "kernel_launch: occupancy query says %d\n", per_cu);
        (void)hipGetLastError();
        grid = cus;
    }
    if (grid < 0) return;
    if (hipMemsetAsync((char*)d_ws + WS_CTL, 0, CTL_ZERO_BYTES, stream) != hipSuccess) return;
    Args a{};
    for (int i = 0; i < 34; ++i) a.in[i] = (const float*)d_in[i];
    a.out = (float*)d_out; a.ws = (unsigned char*)d_ws; a.grid = grid;
#if MK_ONE_LAUNCH
    a.ph_lo = 0; a.ph_hi = NPHASE;
    hipLaunchKernelGGL(mk_fwd, dim3(grid), dim3(NWAVES * 64), LDS_BYTES, stream, a);
#else
    for (int k = 0; k < NPHASE; ++k) { a.ph_lo = k; a.ph_hi = k + 1; hipLaunchKernelGGL(mk_fwd, dim3(grid), dim3(NWAVES * 64), LDS_BYTES, stream, a); }
#endif
    const hipError_t le = hipPeekAtLastError();
    if (le != hipSuccess) fprintf(stderr, "kernel_launch: launch failed: %s\n", hipGetErrorName(le));
}
```

```cpp
#include <hip/hip_runtime.h>
#include <cstdio>
#include <cstdint>
#ifndef MK_SSM_SIMPLE
#define MK_SSM_SIMPLE 0
#endif
#ifndef MK_REP
#define MK_REP (-1)
#endif
#ifndef MK_PROBE_PAIR_SAMPLE
#define MK_PROBE_PAIR_SAMPLE 0
#endif
#ifndef MK_ONE_LAUNCH
#define MK_ONE_LAUNCH 1
#endif
namespace pg8 {
#define PG8_LAS __attribute__((address_space(3)))
typedef unsigned short bf16_t;
typedef short bf16x8 __attribute__((ext_vector_type(8)));
typedef float f32x4 __attribute__((ext_vector_type(4)));
typedef unsigned u32x4 __attribute__((ext_vector_type(4)));
constexpr int BM = 256, BK = 64, HALF = 128, HTB = HALF * BK * 2  , STAGE_BYTES = 8 * HTB, NXCD = 8, WGM = 8;

__host__ __device__ __forceinline__ int lds_byte(int r, int c) { const int st = (r >> 4) * 2 + (c >> 5), rr = r & 15, cc = c & 31, ob = rr * 64 + cc * 2; return st * 1024 + (ob ^ (((ob >> 9) & 1) << 5)); }
__host__ __device__ __forceinline__ void stage_rc(int b, int& R, int& C) { const int st = b / 1024, sb = b % 1024, swz = sb ^ (((sb >> 9) & 1) << 5); R = (st >> 1) * 16 + swz / 64; C = (st & 1) * 32 + (swz % 64) / 2; }
__host__ __device__ __forceinline__ int perm32(int rho) { const int n = rho >> 4, i = rho & 15; return 8 * (i >> 2) + 4 * n + (i & 3); }

struct Unit { int pm, pn, kh; };
struct Gemm { const bf16_t* A; const bf16_t* Bt; int M, N, K; float oscale; const void* base; };
typedef int v8i32 __attribute__((ext_vector_type(8)));
typedef short s16x16 __attribute__((ext_vector_type(16)));

struct StaticOrder {
    int nM, nN, nwg, G, c, rep, pm0, ksplit;
    __host__ __device__ void init(int M, int N, int G_, int c_, int rep_ = 1, int pm0_ = 0, int ksplit_ = 1) { nM = M / BM; nN = N / BM; nwg = nM * nN; G = G_; c = c_; rep = rep_; pm0 = pm0_; ksplit = ksplit_; }
    __host__ __device__ bool next(int i, Unit& u) const {
        const long L0 = (long)i * G + c; if (L0 >= (long)nwg * rep * ksplit) return false;
        const long L1 = L0 % ((long)nwg * ksplit); u.kh = (int)(L1 % ksplit); const long L = L1 / ksplit;
        int wgid = (int)L; { const int q = nwg / NXCD, r = nwg % NXCD, xcd = wgid % NXCD, off = wgid / NXCD; wgid = (xcd < r ? xcd * (q + 1) : r * (q + 1) + (xcd - r) * q) + off; }
        const int nig = WGM * nN, gid = wgid / nig, fm = gid * WGM, gsz = (nM - fm) < WGM ? (nM - fm) : WGM;
        u.pm = pm0 + fm + ((wgid % nig) % gsz); u.pn = (wgid % nig) / gsz; return true;
    }
    __device__ __forceinline__ void a_ready(const Unit&) const {}
    __device__ __forceinline__ void done(const Unit&) const {}
};

__device__ __forceinline__ unsigned cvt_pk_bf16(float lo, float hi) { unsigned r; asm volatile("v_cvt_pk_bf16_f32 %0, %1, %2" : "=v"(r) : "v"(lo), "v"(hi)); return r; }
typedef float f32x2 __attribute__((ext_vector_type(2)));
__device__ __forceinline__ f32x2 gelu_pk(f32x2 v) {
    const f32x2 av = __builtin_elementwise_abs(v), d = av * 0.2316418882f + 1.0f;
    f32x2 t; t.x = __builtin_amdgcn_rcpf(d.x); t.y = __builtin_amdgcn_rcpf(d.y);
    f32x2 q = t * 0.5307027145f + (-0.7265760135f); q = q * t + 0.7107068705f; q = q * t + (-0.142248368f); q = q * t + 0.127414796f; q = q * t;
    const f32x2 s = (v * v) * (-0.72134752044f);
    f32x2 e; e.x = __builtin_amdgcn_exp2f(s.x); e.y = __builtin_amdgcn_exp2f(s.y);
    const f32x2 m = v * (q * e), r = v - m;
    f32x2 o; o.x = v.x < 0.f ? m.x : r.x; o.y = v.y < 0.f ? m.y : r.y; return o;
}

template <int ACT  > struct EpiBf16 {
    static constexpr bool PERM = true, AFTER_DRAIN = false; static_assert(ACT == 0 || ACT == 1, "EpiBf16: ACT is 0 (none) or 1 (gelu_pk)");
    bf16_t* O; int ldc; const float* bias; int split_cols; size_t split_stride; float scale0;
    __device__ __forceinline__ void operator()(const f32x4 (&acc)[2][2][4][2], const Unit& u, int wr, int wc, int fr, int fq) const {
        const int row0 = u.pm * BM + wr * 64 + fr; int colt = u.pn * BM; bf16_t* base = O;
        float sc = 1.f; if (split_cols) { const int t = colt / split_cols; base += (size_t)t * split_stride; colt -= t * split_cols; if (t == 0) sc = scale0; }
        const int col0 = colt + wc * 32 + 8 * fq, bcol0 = u.pn * BM + wc * 32 + 8 * fq;
        f32x4 bv[2][2];
#pragma unroll
        for (int bj = 0; bj < 2; ++bj)
#pragma unroll
            for (int n = 0; n < 2; ++n) bv[bj][n] = bias ? *(const f32x4*)(bias + bcol0 + bj * HALF + 4 * n) : (f32x4){0.f, 0.f, 0.f, 0.f};
#pragma unroll
        for (int ai = 0; ai < 2; ++ai)
#pragma unroll
            for (int m = 0; m < 4; ++m) { bf16_t* rowp = base + (size_t)(row0 + ai * HALF + m * 16) * ldc + col0;
#pragma unroll
                for (int bj = 0; bj < 2; ++bj) { f32x4 v0 = acc[ai][bj][m][0] + bv[bj][0], v1 = acc[ai][bj][m][1] + bv[bj][1];
                    if (ACT == 1) { f32x2 a = gelu_pk((f32x2){v0[0], v0[1]}), b = gelu_pk((f32x2){v0[2], v0[3]}), c = gelu_pk((f32x2){v1[0], v1[1]}), d = gelu_pk((f32x2){v1[2], v1[3]});
                        v0 = (f32x4){a.x, a.y, b.x, b.y}; v1 = (f32x4){c.x, c.y, d.x, d.y}; }
                    v0 = v0 * sc; v1 = v1 * sc; u32x4 w; w.x = cvt_pk_bf16(v0[0], v0[1]); w.y = cvt_pk_bf16(v0[2], v0[3]); w.z = cvt_pk_bf16(v1[0], v1[1]); w.w = cvt_pk_bf16(v1[2], v1[3]);
                    *(u32x4*)(rowp + bj * HALF) = w; } }
    }
};

constexpr int EP_MP = 32768;
constexpr int EP_D = 2048, EP_MODLD = 12288;
constexpr float EP_ALPHA = 1.4142135623730951f;
template <bool GLU, bool RENORM, bool HOIST = false> struct EpiRes {
    static constexpr bool PERM = false, AFTER_DRAIN = false;
    static constexpr int NG = GLU ? 2 : 4;
    const float* xin_p; const float* xin_s; float* xout; const float* gate;
    float* stat_out; const float* stat_in; const float* lng; const float* lnb;
    __device__ __forceinline__ int colof(const Unit& u, int wc, int fq, int q) const { return GLU ? u.pn * HALF + wc * 32 + q * 16 + 4 * fq : u.pn * BM + (q >> 1) * HALF + wc * 32 + (q & 1) * 16 + 4 * fq; }
    __device__ __forceinline__ void ldrow(const Unit& u, int wr, int wc, int fr, int fq, int idx, int h, f32x4 (&xv)[2], f32x2& st) const {
        const int r = u.pm * BM + (idx >> 2) * HALF + wr * 64 + (idx & 3) * 16 + fr;
        const float* xr = xin_p + (size_t)r * EP_D;
#pragma unroll
        for (int p = 0; p < 2; ++p) xv[p] = *(const f32x4*)(xr + colof(u, wc, fq, 2 * h + p));
        if (RENORM) st = *(const f32x2*)(stat_in + 2 * r);
    }
    __device__ __forceinline__ void hoisted(const f32x4 (&acc)[2][2][4][2], const Unit& u, int wr, int wc, int fr, int fq) const {
        const float* gr = gate + (size_t)((u.pm * BM) >> 12) * EP_MODLD;
#pragma unroll
        for (int h = 0; h < NG / 2; ++h) {
            f32x4 g1[2], la[2], ba[2];
#pragma unroll
            for (int p = 0; p < 2; ++p) { const int col = colof(u, wc, fq, 2 * h + p); g1[p] = *(const f32x4*)(gr + col) + 1.0f;
                if (RENORM) { la[p] = *(const f32x4*)(lng + col) * EP_ALPHA; ba[p] = *(const f32x4*)(lnb + col) * EP_ALPHA; } }
            f32x4 xr3[3][2]; f32x2 st3[3] = {{0.f, 0.f}, {0.f, 0.f}, {0.f, 0.f}};
            ldrow(u, wr, wc, fr, fq, 0, h, xr3[0], st3[0]); ldrow(u, wr, wc, fr, fq, 1, h, xr3[1], st3[1]);
#pragma unroll
            for (int idx = 0; idx < 8; ++idx) { const int ai = idx >> 2, m = idx & 3;
                if (idx + 2 < 8) ldrow(u, wr, wc, fr, fq, idx + 2, h, xr3[(idx + 2) % 3], st3[(idx + 2) % 3]);
                const f32x4 (&xc)[2] = xr3[idx % 3]; const f32x2 sc_ = st3[idx % 3];
                const int r = u.pm * BM + ai * HALF + wr * 64 + m * 16 + fr;
                float* orow = xout + (size_t)r * EP_D;
                float mu = 0.f, rs = 1.f;
                if (RENORM) { mu = sc_.x * (1.0f / EP_D); rs = __builtin_amdgcn_rsqf(fmaxf(sc_.y * (1.0f / EP_D) - mu * mu, 0.f) + 1e-5f); }
                float t1 = 0.f, t2 = 0.f;
                f32x4 o[2];
#pragma unroll
                for (int p = 0; p < 2; ++p) { const f32x4 xv = xc[p];
                    if (GLU) { const f32x4 a = acc[ai][0][m][p], g = acc[ai][1][m][p];
#pragma unroll
                        for (int e = 0; e < 4; ++e) { const float sg = __builtin_amdgcn_rcpf(1.0f + __builtin_amdgcn_exp2f(-1.4426950408889634f * g[e])); o[p][e] = EP_ALPHA * xv[e] + g1[p][e] * (a[e] * sg); }
                    } else { const f32x4 a = acc[ai][h][m][p];
#pragma unroll
                        for (int e = 0; e < 4; ++e) o[p][e] = (RENORM ? ((xv[e] - mu) * rs) * la[p][e] + ba[p][e] : EP_ALPHA * xv[e]) + g1[p][e] * a[e]; }
#pragma unroll
                    for (int e = 0; e < 4; ++e) { t1 += o[p][e]; t2 += o[p][e] * o[p][e]; } }
#pragma unroll
                for (int p = 0; p < 2; ++p) *(f32x4*)(orow + colof(u, wc, fq, 2 * h + p)) = o[p];
                t1 += __shfl_xor(t1, 16); t2 += __shfl_xor(t2, 16); t1 += __shfl_xor(t1, 32); t2 += __shfl_xor(t2, 32);
                if (fq == 0) { atomicAdd(stat_out + 2 * r, t1); atomicAdd(stat_out + 2 * r + 1, t2); }
            }
        }
    }
    __device__ __forceinline__ void operator()(const f32x4 (&acc)[2][2][4][2], const Unit& u, int wr, int wc, int fr, int fq) const {
        if constexpr (HOIST) { hoisted(acc, u, wr, wc, fr, fq); return; }
#pragma unroll
        for (int ai = 0; ai < 2; ++ai)
#pragma unroll
            for (int m = 0; m < 4; ++m) {
                const int r = u.pm * BM + ai * HALF + wr * 64 + m * 16 + fr;
                const int stream = r < EP_MP ? (r >> 12) : 8 + ((r - EP_MP) >> 5);
                const float* xr = r < EP_MP ? xin_p + (size_t)r * EP_D : xin_s + (size_t)(r - EP_MP) * EP_D;
                float* orow = xout + (size_t)r * EP_D; const float* gr = gate + (size_t)stream * EP_MODLD;
                float mu = 0.f, rs = 1.f;
                if (RENORM) { const f32x2 st = *(const f32x2*)(stat_in + 2 * r); mu = st.x * (1.0f / EP_D); rs = __builtin_amdgcn_rsqf(fmaxf(st.y * (1.0f / EP_D) - mu * mu, 0.f) + 1e-5f); }
                float t1 = 0.f, t2 = 0.f;
                if (GLU) {
#pragma unroll
                    for (int n = 0; n < 2; ++n) { const int col = u.pn * HALF + wc * 32 + n * 16 + 4 * fq;
                        const f32x4 a = acc[ai][0][m][n], g = acc[ai][1][m][n], xv = *(const f32x4*)(xr + col), gt = *(const f32x4*)(gr + col); f32x4 o;
#pragma unroll
                        for (int e = 0; e < 4; ++e) { const float sg = __builtin_amdgcn_rcpf(1.0f + __builtin_amdgcn_exp2f(-1.4426950408889634f * g[e])); o[e] = EP_ALPHA * xv[e] + (1.0f + gt[e]) * (a[e] * sg); t1 += o[e]; t2 += o[e] * o[e]; }
                        *(f32x4*)(orow + col) = o; }
                } else {
#pragma unroll
                    for (int bj = 0; bj < 2; ++bj)
#pragma unroll
                        for (int n = 0; n < 2; ++n) { const int col = u.pn * BM + bj * HALF + wc * 32 + n * 16 + 4 * fq;
                            const f32x4 a = acc[ai][bj][m][n], gt = *(const f32x4*)(gr + col); f32x4 xv = *(const f32x4*)(xr + col), o;
                            if (RENORM) { const f32x4 lg = *(const f32x4*)(lng + col), lb = *(const f32x4*)(lnb + col);
#pragma unroll
                                for (int e = 0; e < 4; ++e) xv[e] = (xv[e] - mu) * rs * lg[e] + lb[e]; }
#pragma unroll
                            for (int e = 0; e < 4; ++e) { o[e] = EP_ALPHA * xv[e] + (1.0f + gt[e]) * a[e]; t1 += o[e]; t2 += o[e] * o[e]; }
                            *(f32x4*)(orow + col) = o; }
                }
                t1 += __shfl_xor(t1, 16); t2 += __shfl_xor(t2, 16); t1 += __shfl_xor(t1, 32); t2 += __shfl_xor(t2, 32);
                if (fq == 0) { atomicAdd(stat_out + 2 * r, t1); atomicAdd(stat_out + 2 * r + 1, t2); }
            }
    }
};
struct EpiUp {
    static constexpr bool PERM = true, AFTER_DRAIN = false;
    unsigned char* G; unsigned char* V;
    __device__ static __forceinline__ unsigned pk4(float a, float b, float c, float d) {
        a = __builtin_amdgcn_fmed3f(a * 64.f, -448.f, 448.f); b = __builtin_amdgcn_fmed3f(b * 64.f, -448.f, 448.f); c = __builtin_amdgcn_fmed3f(c * 64.f, -448.f, 448.f); d = __builtin_amdgcn_fmed3f(d * 64.f, -448.f, 448.f);
        unsigned w = 0u; w = (unsigned)__builtin_amdgcn_cvt_pk_fp8_f32(a, b, (int)w, false); w = (unsigned)__builtin_amdgcn_cvt_pk_fp8_f32(c, d, (int)w, true); return w; }
    __device__ __forceinline__ void operator()(const f32x4 (&acc)[2][2][4][2], const Unit& u, int wr, int wc, int fr, int fq) const {
        const int col = u.pn * HALF + wc * 32 + 8 * fq;
        typedef unsigned u32x2 __attribute__((ext_vector_type(2)));
#pragma unroll
        for (int ai = 0; ai < 2; ++ai)
#pragma unroll
            for (int m = 0; m < 4; ++m) {
                const int r = u.pm * BM + ai * HALF + wr * 64 + m * 16 + fr;
                const f32x4 g0 = acc[ai][0][m][0], g1 = acc[ai][0][m][1], v0 = acc[ai][1][m][0], v1 = acc[ai][1][m][1];
                u32x2 w; w.x = pk4(g0[0], g0[1], g0[2], g0[3]); w.y = pk4(g1[0], g1[1], g1[2], g1[3]);
                *(u32x2*)(G + (size_t)r * 5632 + col) = w;
                w.x = pk4(v0[0], v0[1], v0[2], v0[3]); w.y = pk4(v1[0], v1[1], v1[2], v1[3]);
                *(u32x2*)(V + (size_t)r * 5632 + col) = w;
            }
    }
};

struct EpiRaw {
    static constexpr bool PERM = false, AFTER_DRAIN = false;
    float* part;
    __device__ __forceinline__ void operator()(const f32x4 (&acc)[2][2][4][2], const Unit& u, int wr, int wc, int fr, int fq) const {
#pragma unroll
        for (int ai = 0; ai < 2; ++ai)
#pragma unroll
            for (int m = 0; m < 4; ++m) { const int rs = u.pm * BM + ai * HALF + wr * 64 + m * 16 + fr - EP_MP; float* orow = part + ((size_t)u.kh * 512 + rs) * EP_D;
#pragma unroll
                for (int bj = 0; bj < 2; ++bj)
#pragma unroll
                    for (int n = 0; n < 2; ++n) *(f32x4*)(orow + u.pn * BM + bj * HALF + wc * 32 + n * 16 + 4 * fq) = acc[ai][bj][m][n]; }
    }
};
#ifndef MK_DIAG_KS
#define MK_DIAG_KS 0.0f
#endif
struct EpiQkv {
    static constexpr bool PERM = true, AFTER_DRAIN = false;
    bf16_t* QB; size_t qkv_stride; float* ok_p; float* ok_s;
    __device__ __forceinline__ void operator()(const f32x4 (&acc)[2][2][4][2], const Unit& u, int wr, int wc, int fr, int fq) const {
        const int which = u.pn >> 3; const int colt = (u.pn & 7) * BM + wc * 32 + 8 * fq;
        bf16_t* ob = QB + (size_t)which * qkv_stride;
        const bool samp = u.pm >= (EP_MP / BM);
        const size_t fo = (samp ? (size_t)(ok_s - ok_p) : (size_t)0) + (size_t)(which == 2 ? (samp ? 512 * EP_D : EP_MP * EP_D) : 0);
        float* fbase = ok_p + fo;
        const int rsub = samp ? EP_MP : 0;
#pragma unroll
        for (int ai = 0; ai < 2; ++ai)
#pragma unroll
            for (int m = 0; m < 4; ++m) {
                const int r = u.pm * BM + ai * HALF + wr * 64 + m * 16 + fr;
#pragma unroll
                for (int bj = 0; bj < 2; ++bj) { const f32x4 v0 = acc[ai][bj][m][0], v1 = acc[ai][bj][m][1]; const int col = colt + bj * HALF;
                    u32x4 w; w.x = cvt_pk_bf16(v0[0], v0[1]); w.y = cvt_pk_bf16(v0[2], v0[3]); w.z = cvt_pk_bf16(v1[0], v1[1]); w.w = cvt_pk_bf16(v1[2], v1[3]);
                    *(u32x4*)(ob + (size_t)r * EP_D + col) = w;
                    if (which) { float* of = fbase + (size_t)(r - rsub) * EP_D + col; float ds = 1.0f; if (!samp && which == 1) { unsigned hsh = (unsigned)(r * 2048 + col) * 2654435761u; hsh ^= hsh >> 15; ds = (hsh & 1u) ? 1.0f + MK_DIAG_KS : 1.0f - MK_DIAG_KS; } *(f32x4*)of = v0 * ds; *(f32x4*)(of + 4) = v1 * ds; } }
            }
    }
};
template <class Epi, class Sched, bool ALIGN_EPI = false, bool SP2 = false, bool FP8 = false>
__device__ __forceinline__ void gemm_phase(PG8_LAS unsigned char* lds, const Gemm g, const Sched& S, const Epi& E, const int tid) {
    const int wid = __builtin_amdgcn_readfirstlane(tid >> 6), lane = tid & 63, wr = wid >> 2, wc = wid & 3, fr = lane & 15, fq = lane >> 4;
    const int K = g.K, nt = (K / BK) / S.ksplit;
    unsigned voffA[2], voffB[2];
#pragma unroll
    for (int i = 0; i < 2; ++i) { int R, C; stage_rc(tid * 16 + i * 8192, R, C); const int Rb = Epi::PERM ? ((R & ~31) + perm32(R & 31)) : R;
        voffA[i] = (unsigned)(R * K + C) * 2u; voffB[i] = (unsigned)(Rb * K + C) * 2u; }
    const unsigned kstep = (unsigned)(BK * 2);
    const unsigned hstep = (unsigned)HALF * (unsigned)K * 2u;
    const unsigned tstep = 2u * hstep;
    const unsigned ldsw = (unsigned)wid * 1024u;
    const int aoff = lds_byte(wr * 64 + fr, fq * 8), boff = lds_byte(wc * 32 + fr, fq * 8);
#define PG8_SA(b, h) (((b) * 2 + (h)) * HTB)
#define PG8_SB(b, h) ((4 + (b) * 2 + (h)) * HTB)
#define PG8_STAGE(bufoff, gbase, voff) do { _Pragma("unroll") for (int _i = 0; _i < 2; ++_i) \
        __builtin_amdgcn_raw_ptr_buffer_load_lds(rs_##voff, (PG8_LAS void*)(lds + (bufoff) + ldsw + _i * 8192), 16, (int)(voff)[_i], (int)(gbase), 0, 0); } while (0)
#define PG8_LDA(dst, b, h) do { _Pragma("unroll") for (int m = 0; m < 4; ++m) _Pragma("unroll") for (int k = 0; k < 2; ++k) dst[m][k] = *(const PG8_LAS bf16x8*)(lds + PG8_SA(b, h) + aoff + m * 2048 + k * 1024); } while (0)
#define PG8_LDB(dst, b, h) do { _Pragma("unroll") for (int n = 0; n < 2; ++n) _Pragma("unroll") for (int k = 0; k < 2; ++k) dst[n][k] = *(const PG8_LAS bf16x8*)(lds + PG8_SB(b, h) + boff + n * 2048 + k * 1024); } while (0)
#define PG8_MMA(ai, bj, At, Bt) do { __builtin_amdgcn_s_setprio(1); _Pragma("unroll") for (int m = 0; m < 4; ++m) _Pragma("unroll") for (int n = 0; n < 2; ++n) { \
        if constexpr (FP8) { const v8i32 b8 = __builtin_bit_cast(v8i32, __builtin_shufflevector(Bt[n][0], Bt[n][1], 0, 1, 2, 3, 4, 5, 6, 7, 8, 9, 10, 11, 12, 13, 14, 15)), a8 = __builtin_bit_cast(v8i32, __builtin_shufflevector(At[m][0], At[m][1], 0, 1, 2, 3, 4, 5, 6, 7, 8, 9, 10, 11, 12, 13, 14, 15)); \
            acc[ai][bj][m][n] = __builtin_amdgcn_mfma_scale_f32_16x16x128_f8f6f4(b8, a8, acc[ai][bj][m][n], 0, 0, 0, 0, 0, 0); } \
        else { _Pragma("unroll") for (int k = 0; k < 2; ++k) acc[ai][bj][m][n] = __builtin_amdgcn_mfma_f32_16x16x32_bf16(Bt[n][k], At[m][k], acc[ai][bj][m][n], 0, 0, 0); } } __builtin_amdgcn_s_setprio(0); } while (0)
#define PG8_WAIT_V(n) asm volatile("s_waitcnt vmcnt(" #n ")" ::: "memory")
#define PG8_WAIT_L(n) asm volatile("s_waitcnt lgkmcnt(" #n ")" ::: "memory")
#define PG8_BAR __builtin_amdgcn_s_barrier()
#define PG8_SCHED __builtin_amdgcn_sched_barrier(0)
    Unit cur, nxt; int ui = 0;
    if (!S.next(0, cur)) return;
    f32x4 acc[2][2][4][2];
#pragma unroll
    for (int a = 0; a < 2; ++a)
#pragma unroll
        for (int b = 0; b < 2; ++b)
#pragma unroll
            for (int m = 0; m < 4; ++m)
#pragma unroll
                for (int n = 0; n < 2; ++n) acc[a][b][m][n] = (f32x4){0.f, 0.f, 0.f, 0.f};
    bf16x8 At[4][2], B0[2][2], B1[2][2];
    const __amdgpu_buffer_rsrc_t rs_voffA = __builtin_amdgcn_make_buffer_rsrc((void*)g.base, 0, (int)0x7fffffff, 0x00020000);
#define rs_voffB rs_voffA
    const unsigned offA = (unsigned)((const char*)g.A - (const char*)g.base), offB = (unsigned)((const char*)g.Bt - (const char*)g.base);
    const unsigned ksub = (unsigned)nt * kstep;
    unsigned cA = offA + (unsigned)cur.pm * tstep + (unsigned)cur.kh * ksub, cB = offB + (unsigned)cur.pn * tstep + (unsigned)cur.kh * ksub;
    S.a_ready(cur);
    if constexpr (SP2) {
        PG8_STAGE(PG8_SB(0, 0), cB, voffB); PG8_STAGE(PG8_SB(0, 1), cB + hstep, voffB); PG8_STAGE(PG8_SA(0, 0), cA, voffA); PG8_STAGE(PG8_SA(0, 1), cA + hstep, voffA);
        if (wr == 1) PG8_BAR;
        PG8_WAIT_V(2); PG8_BAR;
        PG8_STAGE(PG8_SB(1, 0), cB + kstep, voffB); PG8_STAGE(PG8_SA(1, 0), cA + kstep, voffA); PG8_STAGE(PG8_SB(1, 1), cB + hstep + kstep, voffB);
        PG8_WAIT_V(6); PG8_BAR;
    } else {
        PG8_STAGE(PG8_SB(0, 0), cB, voffB); PG8_STAGE(PG8_SA(0, 0), cA, voffA); PG8_STAGE(PG8_SB(0, 1), cB + hstep, voffB); PG8_STAGE(PG8_SA(0, 1), cA + hstep, voffA);
        if (wr == 1) PG8_BAR;
        PG8_WAIT_V(4); PG8_BAR;
        PG8_STAGE(PG8_SB(1, 0), cB + kstep, voffB); PG8_STAGE(PG8_SA(1, 0), cA + kstep, voffA); PG8_STAGE(PG8_SB(1, 1), cB + hstep + kstep, voffB);
        PG8_WAIT_V(6); PG8_BAR;
    }
    for (;;) {
        const bool has_next = S.next(ui + 1, nxt);
        const unsigned nA = has_next ? offA + (unsigned)nxt.pm * tstep + (unsigned)nxt.kh * ksub : cA, nB = has_next ? offB + (unsigned)nxt.pn * tstep + (unsigned)nxt.kh * ksub : cB;
        for (int t = 0; t < nt; t += 2) {
            const bool last = (t == nt - 2);
            const unsigned a1 = cA + (unsigned)(t + 1) * kstep;
            const unsigned a2 = last ? nA : cA + (unsigned)(t + 2) * kstep, b2 = last ? nB : cB + (unsigned)(t + 2) * kstep;
            const unsigned a3 = a2 + kstep, b3 = b2 + kstep;
            if (last && has_next) S.a_ready(nxt);
            if constexpr (SP2) {
            PG8_LDB(B0, 0, 0); PG8_LDB(B1, 0, 1); PG8_SCHED; PG8_LDA(At, 0, 0); PG8_STAGE(PG8_SA(1, 1), a1 + hstep, voffA);
            PG8_WAIT_V(8); PG8_WAIT_L(0); PG8_BAR; PG8_MMA(0, 0, At, B0); PG8_MMA(0, 1, At, B1); PG8_BAR; PG8_SCHED;
            PG8_LDA(At, 0, 1); PG8_STAGE(PG8_SB(0, 0), b2, voffB); PG8_STAGE(PG8_SB(0, 1), b2 + hstep, voffB); PG8_STAGE(PG8_SA(0, 0), a2, voffA);
            PG8_WAIT_V(8); PG8_WAIT_L(0); PG8_BAR; PG8_MMA(1, 0, At, B0); PG8_MMA(1, 1, At, B1); PG8_BAR; PG8_SCHED;
            PG8_LDB(B0, 1, 0); PG8_LDB(B1, 1, 1); PG8_SCHED; PG8_LDA(At, 1, 0); PG8_STAGE(PG8_SA(0, 1), a2 + hstep, voffA);
            PG8_WAIT_V(8); PG8_WAIT_L(0); PG8_BAR; PG8_MMA(0, 0, At, B0); PG8_MMA(0, 1, At, B1); PG8_BAR; PG8_SCHED;
            PG8_LDA(At, 1, 1); PG8_STAGE(PG8_SB(1, 0), b3, voffB); PG8_STAGE(PG8_SB(1, 1), b3 + hstep, voffB); PG8_STAGE(PG8_SA(1, 0), a3, voffA);
            PG8_WAIT_V(8); PG8_WAIT_L(0); PG8_BAR; PG8_MMA(1, 0, At, B0); PG8_MMA(1, 1, At, B1); PG8_BAR; PG8_SCHED;
            } else {
            PG8_LDB(B0, 0, 0); PG8_SCHED; PG8_LDA(At, 0, 0); PG8_STAGE(PG8_SA(1, 1), a1 + hstep, voffA);
            PG8_WAIT_L(8); PG8_BAR; PG8_WAIT_L(0); PG8_MMA(0, 0, At, B0); PG8_BAR; PG8_SCHED;
            PG8_LDB(B1, 0, 1); PG8_STAGE(PG8_SB(0, 0), b2, voffB);
            PG8_BAR; PG8_WAIT_L(0); PG8_MMA(0, 1, At, B1); PG8_BAR;
            PG8_LDA(At, 0, 1); PG8_STAGE(PG8_SA(0, 0), a2, voffA);
            PG8_BAR; PG8_WAIT_L(0); PG8_MMA(1, 0, At, B0); PG8_BAR; PG8_SCHED;
            PG8_STAGE(PG8_SB(0, 1), b2 + hstep, voffB);
            PG8_WAIT_V(6); PG8_BAR; PG8_MMA(1, 1, At, B1); PG8_BAR;
            PG8_LDB(B0, 1, 0); PG8_SCHED; PG8_LDA(At, 1, 0); PG8_STAGE(PG8_SA(0, 1), a2 + hstep, voffA);
            PG8_WAIT_L(8); PG8_BAR; PG8_WAIT_L(0); PG8_MMA(0, 0, At, B0); PG8_BAR; PG8_SCHED;
            PG8_LDB(B1, 1, 1); PG8_STAGE(PG8_SB(1, 0), b3, voffB);
            PG8_BAR; PG8_WAIT_L(0); PG8_MMA(0, 1, At, B1); PG8_BAR;
            PG8_LDA(At, 1, 1); PG8_STAGE(PG8_SA(1, 0), a3, voffA);
            PG8_BAR; PG8_WAIT_L(0); PG8_MMA(1, 0, At, B0); PG8_BAR; PG8_SCHED;
            PG8_STAGE(PG8_SB(1, 1), b3 + hstep, voffB);
            PG8_WAIT_V(6); PG8_BAR; PG8_MMA(1, 1, At, B1); PG8_BAR;
            }
        }
        if constexpr (ALIGN_EPI) { if (wr == 0) PG8_BAR; }
        if constexpr (FP8) {
#pragma unroll
            for (int a = 0; a < 2; ++a)
#pragma unroll
                for (int b = 0; b < 2; ++b)
#pragma unroll
                    for (int m = 0; m < 4; ++m)
#pragma unroll
                        for (int n = 0; n < 2; ++n) acc[a][b][m][n] = acc[a][b][m][n] * g.oscale; }
        if constexpr (!Epi::AFTER_DRAIN) { E(acc, cur, wr, wc, fr, fq); S.done(cur); }
        if (!has_next) break;
#pragma unroll
        for (int a = 0; a < 2; ++a)
#pragma unroll
            for (int b = 0; b < 2; ++b)
#pragma unroll
                for (int m = 0; m < 4; ++m)
#pragma unroll
                    for (int n = 0; n < 2; ++n) acc[a][b][m][n] = (f32x4){0.f, 0.f, 0.f, 0.f};
        cur = nxt; cA = nA; cB = nB; ++ui;
        if constexpr (ALIGN_EPI) { if (wr == 1) PG8_BAR; }
    }
    PG8_WAIT_V(0);
    if constexpr (!ALIGN_EPI) { if (wr == 0) PG8_BAR; }
    PG8_BAR;
    if constexpr (Epi::AFTER_DRAIN) { E.fused(acc, cur, wr, wc, fr, fq, lds, wid, lane); S.done(cur); }
#undef PG8_SA
#undef PG8_SB
#undef PG8_STAGE
#undef rs_voffB
#undef PG8_LDA
#undef PG8_LDB
#undef PG8_MMA
#undef PG8_WAIT_V
#undef PG8_WAIT_L
#undef PG8_BAR
#undef PG8_SCHED
}
}

namespace att {
typedef unsigned short bf16;
using bf16x8 = __attribute__((ext_vector_type(8))) short;
using s16x4  = __attribute__((ext_vector_type(4))) short;
using f32x16 = __attribute__((ext_vector_type(16))) float;
using f32x8  = __attribute__((ext_vector_type(8))) float;
using f32x4  = __attribute__((ext_vector_type(4))) float;
using u32x4  = __attribute__((ext_vector_type(4))) unsigned;
constexpr int   D = 128, NW = 8, QBLK = 32, KVBLK = 64;
constexpr float SCALE = 0.088388347648318440f;
constexpr float THR = 8.f;
constexpr int LDQ = 2048, LDK = 2048, LDO = 4096;
constexpr size_t SHM_V = KVBLK * D * 2, SHM_K = KVBLK * D * 2, SHM_ATTN = 2 * SHM_V + 2 * SHM_K + NW * 64 * 4;
#define KSWZ(row, colB) ((row) * 256 + ((colB) ^ (((row) & 7) << 4)))
#define SBAR() __builtin_amdgcn_sched_barrier(0)
__device__ __forceinline__ int crow(int r, int hi) { return (r & 3) + 8 * (r >> 2) + 4 * hi; }
__device__ __forceinline__ unsigned cvtpk(float lo, float hi) { unsigned r; asm volatile("v_cvt_pk_bf16_f32 %0, %1, %2" : "=v"(r) : "v"(lo), "v"(hi)); return r; }
__device__ __forceinline__ bf16x8 tobf(f32x8 x) { u32x4 w = {cvtpk(x[0], x[1]), cvtpk(x[2], x[3]), cvtpk(x[4], x[5]), cvtpk(x[6], x[7])}; return *reinterpret_cast<bf16x8*>(&w); }

__device__ __forceinline__ void partialSM(f32x16& p0, f32x16& p1, float& m_reg, float& mn, float& alpha) {
  constexpr float C = SCALE * 1.4426950408889634f;
  float pmax = p0[0];
#pragma unroll
  for (int r = 1; r < 16; ++r) pmax = fmaxf(pmax, p0[r]);
#pragma unroll
  for (int r = 0; r < 16; ++r) pmax = fmaxf(pmax, p1[r]);
  { auto rr = __builtin_amdgcn_permlane32_swap(__float_as_uint(pmax), __float_as_uint(pmax), false, false);
    pmax = fmaxf(__uint_as_float(rr[0]), __uint_as_float(rr[1])); }
  if (__builtin_expect(__all(pmax - m_reg <= THR / SCALE), 1)) { mn = m_reg; alpha = 1.f; }
  else { mn = fmaxf(m_reg, pmax); alpha = __builtin_amdgcn_exp2f((m_reg - mn) * C); m_reg = mn; }
  float mnC = -mn * C;
#pragma unroll
  for (int r = 0; r < 16; ++r) p0[r] = fmaf(p0[r], C, mnC);
#pragma unroll
  for (int r = 0; r < 16; ++r) p1[r] = fmaf(p1[r], C, mnC);
#pragma unroll
  for (int r = 0; r < 16; ++r) p0[r] = __builtin_amdgcn_exp2f(p0[r]);
}
__device__ __forceinline__ void finishSM(f32x16& p0, f32x16& p1, float alpha, float& l_reg, bf16x8& pa0, bf16x8& pa1, bf16x8& pa2, bf16x8& pa3) {
#pragma unroll
  for (int r = 0; r < 16; ++r) p1[r] = __builtin_amdgcn_exp2f(p1[r]);
  float ps = 0;
#pragma unroll
  for (int r = 0; r < 16; ++r) ps += p0[r];
#pragma unroll
  for (int r = 0; r < 16; ++r) ps += p1[r];
  { auto rr = __builtin_amdgcn_permlane32_swap(__float_as_uint(ps), __float_as_uint(ps), false, false);
    ps = __uint_as_float(rr[0]) + __uint_as_float(rr[1]); }
  l_reg = l_reg * alpha + ps;
#define PK4(P, BASE, OUT) do { unsigned a0 = cvtpk(P[BASE + 0], P[BASE + 1]), a1 = cvtpk(P[BASE + 2], P[BASE + 3]);   \
    unsigned b0 = cvtpk(P[BASE + 4], P[BASE + 5]), b1 = cvtpk(P[BASE + 6], P[BASE + 7]);                              \
    auto r0 = __builtin_amdgcn_permlane32_swap(a0, b0, false, false); auto r1 = __builtin_amdgcn_permlane32_swap(a1, b1, false, false); \
    u32x4 w = {r0[0], r1[0], r0[1], r1[1]}; OUT = *reinterpret_cast<bf16x8*>(&w); } while (0)
  PK4(p0, 0, pa0); PK4(p0, 8, pa1); PK4(p1, 0, pa2); PK4(p1, 8, pa3);
#undef PK4
}
__device__ __forceinline__ void qkt(f32x16& p0, f32x16& p1, const bf16* Ks, const bf16x8* qr, int r32, int hi) {
  p0 = f32x16{}; p1 = f32x16{};
#pragma unroll
  for (int d0 = 0; d0 < 8; ++d0) { int cb = (d0 * 16 + hi * 8) * 2;
    bf16x8 b0 = *reinterpret_cast<const bf16x8*>((const char*)Ks + KSWZ(r32, cb));
    bf16x8 b1 = *reinterpret_cast<const bf16x8*>((const char*)Ks + KSWZ(32 + r32, cb));
    p0 = __builtin_amdgcn_mfma_f32_32x32x16_bf16(b0, qr[d0], p0, 0, 0, 0);
    p1 = __builtin_amdgcn_mfma_f32_32x32x16_bf16(b1, qr[d0], p1, 0, 0, 0); }
}
__device__ __forceinline__ int v_st(int k, int c) { const int kk = (k & ~0xC) | ((k & 4) << 1) | ((k & 8) >> 1); return ((kk >> 3) * 4 + (c >> 5)) * 512 + ((kk & 7) * 32 + (c & 31)) * 2; }
__device__ __forceinline__ int v_rd_base(int lane) { return ((lane & 3) << 3) | (((lane >> 2) & 3) << 6) | (((lane >> 4) & 1) << 5) | (((lane >> 5) & 1) << 8); }
constexpr int v_rd_off(int d0, int ks, int half) { return d0 * 512 + ks * 4096 + half * 2048; }
template <int OFF> __device__ __forceinline__ s16x4 tr_read(int vb) {
  s16x4 r; asm volatile("ds_read_b64_tr_b16 %0, %1 offset:%2" : "=&v"(r) : "v"(vb), "i"(OFF) : "memory"); return r;
}
template <int D0> __device__ __forceinline__ void pv_one(f32x16& od, int vb, bf16x8 pa0, bf16x8 pa1, bf16x8 pa2, bf16x8 pa3) {
  const s16x4 l0 = tr_read<v_rd_off(D0, 0, 0)>(vb), h0 = tr_read<v_rd_off(D0, 0, 1)>(vb), l1 = tr_read<v_rd_off(D0, 1, 0)>(vb), h1 = tr_read<v_rd_off(D0, 1, 1)>(vb);
  const s16x4 l2 = tr_read<v_rd_off(D0, 2, 0)>(vb), h2 = tr_read<v_rd_off(D0, 2, 1)>(vb), l3 = tr_read<v_rd_off(D0, 3, 0)>(vb), h3 = tr_read<v_rd_off(D0, 3, 1)>(vb);
  asm volatile("s_waitcnt lgkmcnt(0)" ::: "memory"); SBAR();
#define PK(L, H) (bf16x8){L[0], L[1], L[2], L[3], H[0], H[1], H[2], H[3]}
  od = __builtin_amdgcn_mfma_f32_32x32x16_bf16(pa0, PK(l0, h0), od, 0, 0, 0);
  od = __builtin_amdgcn_mfma_f32_32x32x16_bf16(pa1, PK(l1, h1), od, 0, 0, 0);
  od = __builtin_amdgcn_mfma_f32_32x32x16_bf16(pa2, PK(l2, h2), od, 0, 0, 0);
  od = __builtin_amdgcn_mfma_f32_32x32x16_bf16(pa3, PK(l3, h3), od, 0, 0, 0);
#undef PK
}
__device__ __forceinline__ void pv_d0(f32x16* o, int vb, bf16x8 pa0, bf16x8 pa1, bf16x8 pa2, bf16x8 pa3) {
  pv_one<0>(o[0], vb, pa0, pa1, pa2, pa3); pv_one<1>(o[1], vb, pa0, pa1, pa2, pa3); pv_one<2>(o[2], vb, pa0, pa1, pa2, pa3); pv_one<3>(o[3], vb, pa0, pa1, pa2, pa3);
}

__device__ __forceinline__ void attn_prompt_unit(const bf16* __restrict__ Qb, const bf16* __restrict__ Kh, const bf16* __restrict__ Vh, bf16* __restrict__ Ob, int qb, char* lds, const int tid) {
  asm volatile("" : "+s"(Qb), "+s"(Kh), "+s"(Vh), "+s"(Ob), "+s"(qb));
  const int wid = tid >> 6, lane = tid & 63, r32 = lane & 31, hi = lane >> 5;
  bf16* V_lds = (bf16*)lds; bf16* K_lds = (bf16*)(lds + 2 * SHM_V);
  float* ws = (float*)(lds + 2 * SHM_V + 2 * SHM_K) + wid * 64; float* li_l = ws; float* al_l = ws + 32;
  float m_reg = -1e30f, l_reg = 0; f32x16 o[4] = {}; bf16x8 qr[8];
  const bf16* Qw = Qb + (long)(wid * QBLK + r32) * LDQ + hi * 8;
#pragma unroll
  for (int d0 = 0; d0 < 8; ++d0) qr[d0] = *reinterpret_cast<const bf16x8*>(Qw + d0 * 16);
  const int sr = tid >> 4, sc = (tid & 15) * 8, vst0 = v_st(sr, sc), vst1 = v_st(32 + sr, sc);
  const int vb0 = (int)(uintptr_t)V_lds + v_rd_base(lane);
  struct { bf16x8 vs0, vs1, ks0, ks1; } sr_[2];
  const int NT = 4 * (qb + 1), lastvis = 4 * qb + (wid >> 1);
#define SLOAD(i, k0) do { sr_[i].vs0 = *reinterpret_cast<const bf16x8*>(&Vh[(long)((k0) + sr) * LDK + sc]); sr_[i].vs1 = *reinterpret_cast<const bf16x8*>(&Vh[(long)((k0) + 32 + sr) * LDK + sc]); \
    sr_[i].ks0 = *reinterpret_cast<const bf16x8*>(&Kh[(long)((k0) + sr) * LDK + sc]); sr_[i].ks1 = *reinterpret_cast<const bf16x8*>(&Kh[(long)((k0) + 32 + sr) * LDK + sc]); } while (0)
#define SWRITE(b, i) do { *(bf16x8*)((char*)V_lds + (b) * SHM_V + vst0) = sr_[i].vs0;          \
    *(bf16x8*)((char*)V_lds + (b) * SHM_V + vst1) = sr_[i].vs1; int kc = sc * 2;               \
    *(bf16x8*)((char*)K_lds + (b) * SHM_K + KSWZ(sr, kc)) = sr_[i].ks0;                       \
    *(bf16x8*)((char*)K_lds + (b) * SHM_K + KSWZ(32 + sr, kc)) = sr_[i].ks1; } while (0)
#define SWAIT() asm volatile("s_waitcnt vmcnt(4)" ::: "memory")
#define RESC(a) do { if (__any((a) < 1.f)) { if (hi == 0) al_l[r32] = (a); asm volatile("s_waitcnt lgkmcnt(0)" ::: "memory"); \
    _Pragma("unroll") for (int d = 0; d < 4; ++d) _Pragma("unroll") for (int r = 0; r < 16; ++r) o[d][r] *= al_l[crow(r, hi)]; } } while (0)
#define TMASK(P0, P1, jt) do { if ((jt) > lastvis) { _Pragma("unroll") for (int r = 0; r < 16; ++r) { P0[r] = -1e30f; P1[r] = -1e30f; } } } while (0)
  f32x16 pA0, pA1, pB0, pB1; float mnA, mnB, alA, alB; bf16x8 pa0, pa1, pa2, pa3;
  constexpr int SE = 0, SO = 1;
  SLOAD(SE, 0); asm volatile("s_waitcnt vmcnt(0)" ::: "memory"); SWRITE(0, SE); __syncthreads();
  qkt(pA0, pA1, K_lds, qr, r32, hi); partialSM(pA0, pA1, m_reg, mnA, alA);
  SLOAD(SO, KVBLK); if (2 < NT) SLOAD(SE, 2 * KVBLK);
  SWAIT(); SWRITE(1, SO); __syncthreads();
  for (int j = 1; j + 1 < NT; j += 2) {
    SBAR(); qkt(pB0, pB1, (bf16*)((char*)K_lds + SHM_K), qr, r32, hi); TMASK(pB0, pB1, j);
    finishSM(pA0, pA1, alA, l_reg, pa0, pa1, pa2, pa3); SBAR();
    SLOAD(SO, (j + 2) * KVBLK); SBAR();
    pv_d0(o, vb0, pa0, pa1, pa2, pa3); partialSM(pB0, pB1, m_reg, mnB, alB);
    __syncthreads(); SWAIT(); SWRITE(0, SE);
    RESC(alB); __syncthreads();
    SBAR(); qkt(pA0, pA1, K_lds, qr, r32, hi); TMASK(pA0, pA1, j + 1);
    finishSM(pB0, pB1, alB, l_reg, pa0, pa1, pa2, pa3); SBAR();
    if (j + 3 < NT) SLOAD(SE, (j + 3) * KVBLK); SBAR();
    pv_d0(o, vb0 + (int)SHM_V, pa0, pa1, pa2, pa3); partialSM(pA0, pA1, m_reg, mnA, alA);
    __syncthreads(); SWAIT(); SWRITE(1, SO);
    RESC(alA); __syncthreads();
  }
  SBAR(); qkt(pB0, pB1, (bf16*)((char*)K_lds + SHM_K), qr, r32, hi); TMASK(pB0, pB1, NT - 1);
  finishSM(pA0, pA1, alA, l_reg, pa0, pa1, pa2, pa3); SBAR();
  pv_d0(o, vb0, pa0, pa1, pa2, pa3); partialSM(pB0, pB1, m_reg, mnB, alB);
  __syncthreads(); RESC(alB);
  finishSM(pB0, pB1, alB, l_reg, pa0, pa1, pa2, pa3); SBAR();
  pv_d0(o, vb0 + (int)SHM_V, pa0, pa1, pa2, pa3);
  if (hi == 0) li_l[r32] = l_reg; asm volatile("s_waitcnt lgkmcnt(0)" ::: "memory");
  float rli[16];
#pragma unroll
  for (int r = 0; r < 16; ++r) rli[r] = __builtin_amdgcn_rcpf(li_l[crow(r, hi)]);
  bf16* Ow = Ob + (long)(wid * QBLK) * LDO;
#pragma unroll
  for (int r = 0; r < 16; ++r) { int orow = crow(r, hi);
#pragma unroll
    for (int d0 = 0; d0 < 4; ++d0) Ow[(long)orow * LDO + d0 * 32 + r32] = (bf16)(cvtpk(o[d0][r] * rli[r], 0.f) & 0xffffu); }
  __syncthreads();
#undef SLOAD
#undef SWRITE
#undef SWAIT
#undef TMASK
}


constexpr int A2_K = 0, A2_V = 16384, A2_BUF = 49152, A2_SCR = 2 * A2_BUF;
__device__ __forceinline__ void attn_prompt_unit2(const unsigned char* wsb, const bf16* __restrict__ Qb, const bf16* __restrict__ Kh, const bf16* __restrict__ Vh, bf16* __restrict__ Ob, int qb, char* lds, const int tid_) {
  int tid = tid_; asm volatile("" : "+s"(Qb), "+s"(Kh), "+s"(Vh), "+s"(Ob), "+s"(qb), "+v"(tid));
  const int wid = tid >> 6, lane = tid & 63, r32 = lane & 31, hi = lane >> 5;
  float* wsf = (float*)(lds + A2_SCR) + wid * 64; float* li_l = wsf; float* al_l = wsf + 32;
  float m_reg = -1e30f, l_reg = 0; f32x16 o[8] = {}; bf16x8 qr[8];
  const bf16* Qw = Qb + (long)(wid * QBLK + r32) * LDQ + hi * 8;
#pragma unroll
  for (int d0 = 0; d0 < 8; ++d0) qr[d0] = *reinterpret_cast<const bf16x8*>(Qw + d0 * 16);
  unsigned vK[2], vV[2];
#pragma unroll
  for (int i = 0; i < 2; ++i) { const int P = 64 * (2 * wid + i) + lane;
    { const int row = P >> 4, c = (P & 15) ^ (row & 7); vK[i] = (unsigned)(row * (LDK * 2) + c * 16); }
    { const int sub = P >> 5, r16 = P & 31, kk = ((sub >> 2) << 3) | (r16 >> 2), k = (kk & ~0xC) | ((kk & 4) << 1) | ((kk & 8) >> 1), c = (sub & 3) * 32 + (r16 & 3) * 8; vV[i] = (unsigned)(k * (LDK * 2) + c * 2); } }
  const __amdgpu_buffer_rsrc_t rs = __builtin_amdgcn_make_buffer_rsrc((void*)wsb, 0, (int)0x7fffffff, 0x00020000);
  const unsigned gK = (unsigned)((const unsigned char*)Kh - wsb), gV = (unsigned)((const unsigned char*)Vh - wsb);
  const int wu = __builtin_amdgcn_readfirstlane(wid);
  typedef __attribute__((address_space(3))) void* lvp;
  typedef __attribute__((address_space(3))) unsigned char* lcp;
  lcp const L0 = (lcp)0 + (unsigned)(uintptr_t)lds;
#define A2_ISSUE(t) do { const unsigned ko_ = gK + (unsigned)(t) * (KVBLK * LDK * 2), vo_ = gV + (unsigned)(t) * (KVBLK * LDK * 2); lcp bb_ = L0 + ((t) & 1) * A2_BUF + wu * 2048; \
    __builtin_amdgcn_raw_ptr_buffer_load_lds(rs, (lvp)(bb_ + A2_K), 16, (int)vK[0], (int)ko_, 0, 0); __builtin_amdgcn_raw_ptr_buffer_load_lds(rs, (lvp)(bb_ + A2_K + 1024), 16, (int)vK[1], (int)ko_, 0, 0); \
    __builtin_amdgcn_raw_ptr_buffer_load_lds(rs, (lvp)(bb_ + A2_V), 16, (int)vV[0], (int)vo_, 0, 0); __builtin_amdgcn_raw_ptr_buffer_load_lds(rs, (lvp)(bb_ + A2_V + 1024), 16, (int)vV[1], (int)vo_, 0, 0); \
    __builtin_amdgcn_raw_ptr_buffer_load_lds(rs, (lvp)(bb_ + A2_V + 16384), 16, (int)vV[0], (int)(vo_ + 256u), 0, 0); __builtin_amdgcn_raw_ptr_buffer_load_lds(rs, (lvp)(bb_ + A2_V + 16384 + 1024), 16, (int)vV[1], (int)(vo_ + 256u), 0, 0); } while (0)
  const int NT = 4 * (qb + 1), lastvis = 4 * qb + (wid >> 1);
  const int vbase = (int)(uintptr_t)lds + A2_V + v_rd_base(lane);
  A2_ISSUE(0);
  for (int j = 0; j < NT; ++j) {
    asm volatile("s_waitcnt vmcnt(0)" ::: "memory"); __builtin_amdgcn_s_barrier(); asm volatile("" ::: "memory");
    if (j + 1 < NT) A2_ISSUE(j + 1);
    f32x16 p0, p1; float mn, al; bf16x8 pa0, pa1, pa2, pa3;
    qkt(p0, p1, (const bf16*)(lds + (j & 1) * A2_BUF + A2_K), qr, r32, hi);
    if (j > lastvis) {
#pragma unroll
      for (int r = 0; r < 16; ++r) { p0[r] = -1e30f; p1[r] = -1e30f; } }
    partialSM(p0, p1, m_reg, mn, al);
    if (__any(al < 1.f)) { if (hi == 0) al_l[r32] = al; asm volatile("s_waitcnt lgkmcnt(0)" ::: "memory");
#pragma unroll
      for (int d = 0; d < 8; ++d)
#pragma unroll
        for (int r = 0; r < 16; ++r) o[d][r] *= al_l[crow(r, hi)]; }
    finishSM(p0, p1, al, l_reg, pa0, pa1, pa2, pa3); SBAR();
    const int vb = vbase + (j & 1) * A2_BUF;
    pv_d0(o, vb, pa0, pa1, pa2, pa3); pv_d0(o + 4, vb + 16384, pa0, pa1, pa2, pa3);
  }
  if (hi == 0) li_l[r32] = l_reg; asm volatile("s_waitcnt lgkmcnt(0)" ::: "memory");
  float rli[16];
#pragma unroll
  for (int r = 0; r < 16; ++r) rli[r] = __builtin_amdgcn_rcpf(li_l[crow(r, hi)]);
  bf16* Ow = Ob + (long)(wid * QBLK) * LDO;
#pragma unroll
  for (int r = 0; r < 16; ++r) { int orow = crow(r, hi);
#pragma unroll
    for (int d0 = 0; d0 < 8; ++d0) Ow[(long)orow * LDO + d0 * 32 + r32] = (bf16)(cvtpk(o[d0][r] * rli[r], 0.f) & 0xffffu); }
#undef A2_ISSUE
}

__device__ __forceinline__ void attn_sample_unit(const bf16* __restrict__ QB, const bf16* __restrict__ KB, const bf16* __restrict__ VB, const float* __restrict__ ck, const float* __restrict__ cv,
                                                 float* __restrict__ OPS, float* __restrict__ MLS, int b, int h, int split, char* lds, const int tid) {
  const int wid = tid >> 6, lane = tid & 63, r32 = lane & 31, hi = lane >> 5, j = wid >> 2, c = wid & 3;
  bf16* K_lds = (bf16*)(lds + j * 16384);
  char* V_base = lds + 32768;
  float* ws = (float*)(lds + 65536) + wid * 64; float* al_l = ws + 32;
  float m_reg = -1e30f, l_reg = 0; f32x16 o[2] = {}; bf16x8 qr[8];
  const long qrow0 = 32768 + 32 * b;
  const bf16* Qw = QB + (qrow0 + r32) * LDQ + (2 * h + j) * 128 + hi * 8;
#pragma unroll
  for (int d0 = 0; d0 < 8; ++d0) qr[d0] = *reinterpret_cast<const bf16x8*>(Qw + d0 * 16);
  const int vb = (int)(uintptr_t)(V_base + (c >> 1) * 16384) + v_rd_base(lane);
  const int skey = tid >> 3, sg = tid & 7;
  const float* ckb = ck + ((long)(b * 2048 + split * 1024 + skey) * 16 + 2 * h) * 128 + sg * 8;
  const float* cvb = cv + ((long)(b * 2048 + split * 1024 + skey) * 8 + h) * 256 + sg * 8;
  f32x8 kreg[4], vreg[4];
#define S_LOAD(t) do { _Pragma("unroll") for (int i = 0; i < 4; ++i) { kreg[i] = *reinterpret_cast<const f32x8*>(ckb + (long)(t) * 64 * 2048 + i * 64); vreg[i] = *reinterpret_cast<const f32x8*>(cvb + (long)(t) * 64 * 2048 + i * 64); } } while (0)
#define S_WRITE() do { _Pragma("unroll") for (int i = 0; i < 4; ++i) { const int col = (sg + 8 * i) * 8, jj = col >> 7, cc = col & 127; \
    *(bf16x8*)(lds + jj * 16384 + KSWZ(skey, cc * 2)) = tobf(kreg[i]); *(bf16x8*)(V_base + jj * 16384 + v_st(skey, cc)) = tobf(vreg[i]); } } while (0)
#define S_TILE(MASKP1) do { f32x16 p0, p1; float mn, al; bf16x8 pa0, pa1, pa2, pa3; \
    qkt(p0, p1, K_lds, qr, r32, hi); if (MASKP1) { _Pragma("unroll") for (int r = 0; r < 16; ++r) p1[r] = -1e30f; } \
    partialSM(p0, p1, m_reg, mn, al); \
    if (__any(al < 1.f)) { if (hi == 0) al_l[r32] = al; asm volatile("s_waitcnt lgkmcnt(0)" ::: "memory"); \
      _Pragma("unroll") for (int d = 0; d < 2; ++d) _Pragma("unroll") for (int r = 0; r < 16; ++r) o[d][r] *= al_l[crow(r, hi)]; } \
    finishSM(p0, p1, al, l_reg, pa0, pa1, pa2, pa3); SBAR(); \
    if (c & 1) { pv_one<2>(o[0], vb, pa0, pa1, pa2, pa3); pv_one<3>(o[1], vb, pa0, pa1, pa2, pa3); } \
    else { pv_one<0>(o[0], vb, pa0, pa1, pa2, pa3); pv_one<1>(o[1], vb, pa0, pa1, pa2, pa3); } } while (0)
  S_LOAD(0);
  for (int t = 0; t < 16; ++t) {
    asm volatile("s_waitcnt vmcnt(0)" ::: "memory"); __syncthreads(); S_WRITE(); __syncthreads();
    if (t + 1 < 16) S_LOAD(t + 1);
    S_TILE(false);
  }
  if (split == 1) {
    __syncthreads();
    { const int key = tid >> 4, g16 = tid & 15;
#pragma unroll
      for (int i = 0; i < 2; ++i) { const int col = g16 * 16 + i * 8, jj = col >> 7, cc = col & 127;
        const bf16x8 kv = *reinterpret_cast<const bf16x8*>(KB + (qrow0 + key) * LDK + h * 256 + col);
        const bf16x8 vv = *reinterpret_cast<const bf16x8*>(VB + (qrow0 + key) * LDK + h * 256 + col);
        *(bf16x8*)(lds + jj * 16384 + KSWZ(key, cc * 2)) = kv; *(bf16x8*)(V_base + jj * 16384 + v_st(key, cc)) = vv;
        *(bf16x8*)(lds + jj * 16384 + KSWZ(32 + key, cc * 2)) = bf16x8{}; *(bf16x8*)(V_base + jj * 16384 + v_st(32 + key, cc)) = bf16x8{}; } }
    __syncthreads();
    S_TILE(true);
  }
  const long pbase = ((((long)b * 8 + h) * 2 + split) * 2 + j) * 32;
#pragma unroll
  for (int r = 0; r < 16; ++r) { const int orow = crow(r, hi);
#pragma unroll
    for (int d = 0; d < 2; ++d) OPS[(pbase + orow) * 256 + c * 64 + d * 32 + r32] = o[d][r]; }
  if (c == 0 && hi == 0) { MLS[(pbase + r32) * 2] = m_reg; MLS[(pbase + r32) * 2 + 1] = l_reg; }
  __syncthreads();
#undef S_LOAD
#undef S_WRITE
#undef S_TILE
}
#undef RESC
#undef KSWZ
}

constexpr int NWAVES = 8;
constexpr int DM = 2048, MP = 32768, MS = 512, M = MP + MS, SEQ = 4096, TS = 32, NSTREAM = 24, DFF = 5632, NGRP = 128, SP = 64;
constexpr float LN_EPS = 1e-5f;
constexpr float LAM_INIT = 0.35550906759f;
constexpr size_t OUT_Y = 0, OUT_KP = (size_t)M * DM, OUT_VP = OUT_KP + (size_t)MP * DM, OUT_SRP = OUT_VP + (size_t)MP * DM, OUT_SIP = OUT_SRP + 8 * 128 * 64, OUT_CVP = OUT_SIP + 8 * 128 * 64,
                 OUT_KS = OUT_CVP + 2 * 8 * 2 * DFF, OUT_VS = OUT_KS + (size_t)MS * DM, OUT_SRS = OUT_VS + (size_t)MS * DM, OUT_SIS = OUT_SRS + 16 * 128 * 64, OUT_CVS = OUT_SIS + 16 * 128 * 64,
                 OUT_END = OUT_CVS + 2 * 16 * 2 * DFF;
static_assert(OUT_END == 205406208 && OUT_VP - OUT_KP == (size_t)MP * DM && OUT_VS - OUT_KS == (size_t)MS * DM, "output size");
constexpr size_t MiB = 1u << 20;
constexpr size_t WS_CTL = 0, WS_STAT = 1 * MiB  , CTL_ZERO_BYTES = 2 * MiB + 256 * 1024;
constexpr size_t WS_MOD = 2 * MiB + 256 * 1024;
constexpr size_t WS_ABAR = 4 * MiB + 512 * 1024;
constexpr size_t WS_BBT = 5 * MiB;
constexpr size_t WS_CMT = 6 * MiB;
constexpr size_t WS_WIN = 8 * MiB, WS_WGLU = 16 * MiB, WS_WUP8 = 32 * MiB  , WS_WDOWN8 = 76 * MiB  , WS_WQKV = 98 * MiB, WS_WO = 122 * MiB;
constexpr size_t WS_HB = 136 * MiB;
constexpr size_t WS_CVP = 130 * MiB;
constexpr size_t WS_BIG = 266 * MiB;
constexpr size_t WS_U = WS_BIG, WS_Z = WS_BIG + 130 * MiB;
constexpr size_t WS_G = WS_BIG, WS_V = WS_BIG + 358 * MiB;
constexpr size_t WS_GT = WS_BIG + 400 * MiB  , WS_FR = WS_BIG + 408 * MiB  ;
constexpr size_t WS_ACT8 = WS_BIG + 716 * MiB;
constexpr size_t WS_Q = WS_BIG, WS_K = WS_BIG + 130 * MiB, WS_VA = WS_BIG + 260 * MiB, WS_OP = WS_BIG + 390 * MiB  , WS_OPS = WS_BIG + 650 * MiB  , WS_MLS = WS_BIG + 666 * MiB;
constexpr size_t WS_PART = WS_ACT8 + 180 * MiB;
constexpr size_t WS_END = WS_PART + 8 * MiB;
static_assert(WS_STAT + (size_t)4 * M * 2 * 4 <= CTL_ZERO_BYTES && WS_MOD + (size_t)2 * NSTREAM * 12288 * 4 <= WS_ABAR && WS_VA - WS_K == WS_K - WS_Q && (size_t)M * DFF * 2 <= 358 * MiB && (size_t)M * DM * 2 <= 130 * MiB && (size_t)M * 4096 * 2 <= 260 * MiB && (size_t)M * DFF <= 179 * MiB && (size_t)4 * 48 * DFF * 4 <= 6 * MiB, "ws map");
constexpr unsigned SC_H1 = 0x7b7b7b7bu, SC_WUP = 0x73737373u, SC_ACT = 0x7a7a7a7au, SC_WDN = 0x72727272u;
constexpr float F8_Z = 64.f, F8_WGLU = 4096.f; constexpr float F8_H1 = 16.f, F8_WUP = 4096.f, F8_ACT = 32.f, F8_WDN = 8192.f;
constexpr int CW_BAR = 4096;
constexpr int RING_BYTES = 131072, LDSCTL_OFF = RING_BYTES, MISC_OFF = LDSCTL_OFF + 320, XCH_OFF = LDSCTL_OFF + 512  , LDS_BYTES = 147456;

#define GAS __attribute__((address_space(1)))
#define LAS __attribute__((address_space(3)))
typedef unsigned short bf16;
typedef unsigned v4u __attribute__((ext_vector_type(4)));
typedef float f32x4 __attribute__((ext_vector_type(4)));
typedef short bf16x8 __attribute__((ext_vector_type(8)));
typedef GAS unsigned gu32;
typedef GAS unsigned long long gu64;
#define RLX_AGENT __ATOMIC_RELAXED, __HIP_MEMORY_SCOPE_AGENT
#define LDS_WAIT() asm volatile("s_waitcnt lgkmcnt(0)" ::: "memory")
#define VM_WAIT() asm volatile("s_waitcnt vmcnt(0)" ::: "memory")
__device__ __forceinline__ unsigned long long rt() { return __builtin_amdgcn_s_memrealtime(); }
__device__ __forceinline__ unsigned f2bf(float f) { unsigned u = __builtin_bit_cast(unsigned, f); return (u + 0x7fffu + ((u >> 16) & 1u)) >> 16; }
__device__ __forceinline__ unsigned pk2(float lo, float hi) { return f2bf(lo) | (f2bf(hi) << 16); }

#define XB_TMO      128
#define XB_XCNT(j)  (256  + 64 * (j))
#define XB_XSUB(j)  (1280 + 64 * (j))
#define XB_XGEN(j)  (2304 + 64 * (j))
#define XB_TOP      3328
#define XB_TOPGEN   3392
#define XCD_BAR_WORDS 3456
#define XB_SPIN_CAP (1u << 18)

__device__ __forceinline__ unsigned xb_ld(unsigned* p)              { return __hip_atomic_load(p, __ATOMIC_RELAXED, __HIP_MEMORY_SCOPE_AGENT); }
__device__ __forceinline__ unsigned xb_add(unsigned* p, unsigned v) { return __hip_atomic_fetch_add(p, v, __ATOMIC_RELAXED, __HIP_MEMORY_SCOPE_AGENT); }
__device__ __forceinline__ unsigned xb_xcc_id() { return (unsigned)__builtin_amdgcn_s_getreg((3 << 11) | 20) & 0xFu; }
#define XB_SPIN(cond, bar) do { unsigned _sp = 0; while (cond) { __builtin_amdgcn_s_sleep(1); \
    if ((++_sp & 255u) == 0u) { if (xb_ld(&(bar)[XB_TMO])) break; if (_sp > XB_SPIN_CAP) { atomicAdd(&(bar)[XB_TMO], 1u); break; } } } } while (0)

struct XcdBarrier {
    unsigned* bar; unsigned x;
    volatile LAS unsigned* st;
};

__device__ __forceinline__ XcdBarrier xcd_barrier_post(unsigned* bar, volatile LAS unsigned* st) {
    XcdBarrier b; b.bar = bar; b.x = xb_xcc_id(); b.st = st;
    if (threadIdx.x == 0) (void)xb_add(&bar[XB_XCNT(b.x)], 1u);
    return b;
}
__device__ __forceinline__ void xcd_barrier_complete(unsigned* bar, unsigned x, unsigned& nloc, unsigned& nx) {
    const unsigned G = gridDim.x * gridDim.y * gridDim.z;
    unsigned sum, cnt, mine, sp = 0u;
    for (;;) {
        sum = 0u; cnt = 0u; mine = 0u;
#pragma unroll
        for (unsigned j = 0; j < 16; ++j) { const unsigned c = xb_ld(&bar[XB_XCNT(j)]); sum += c; cnt += (c > 0u) ? 1u : 0u; mine = (j == x) ? c : mine; }
        if (sum == G) break;
        __builtin_amdgcn_s_sleep(1);
        if ((++sp & 255u) == 0u) { if (xb_ld(&bar[XB_TMO])) break; if (sp > XB_SPIN_CAP) { atomicAdd(&bar[XB_TMO], 1u); break; } }
    }
    nloc = mine > 0u ? mine : 1u; nx = cnt > 0u ? cnt : 1u;
}

__device__ __forceinline__ void xcd_barrier(const XcdBarrier& b, const bool thread0) {
    asm volatile("s_waitcnt vmcnt(0)" ::: "memory");
    __syncthreads();
    if (thread0) {
        unsigned* bar = b.bar;
        __builtin_amdgcn_s_waitcnt(0);
        unsigned nloc = b.st[0], nx = b.st[1];
        if (nloc == 0u) { xcd_barrier_complete(bar, b.x, nloc, nx); b.st[0] = nloc; b.st[1] = nx; }
        const unsigned old = xb_add(&bar[XB_XSUB(b.x)], 1u);
        const unsigned gen = old / nloc;
        if (old + 1u == (gen + 1u) * nloc) {
            __builtin_amdgcn_fence(__ATOMIC_RELEASE, "agent");
            asm volatile("s_waitcnt vmcnt(0)" ::: "memory");
            const unsigned og = xb_add(&bar[XB_TOP], 1u);
            const unsigned tg = og / nx;
            if (og + 1u == (tg + 1u) * nx) xb_add(&bar[XB_TOPGEN], 1u);
            else XB_SPIN(xb_ld(&bar[XB_TOPGEN]) == tg, bar);
            __builtin_amdgcn_fence(__ATOMIC_ACQUIRE, "agent");
            xb_add(&bar[XB_XGEN(b.x)], 1u);
            asm volatile("s_waitcnt vmcnt(0)" ::: "memory");
        } else {
            XB_SPIN(xb_ld(&bar[XB_XGEN(b.x)]) == gen, bar);
            __builtin_amdgcn_fence(__ATOMIC_ACQUIRE, "agent");
            asm volatile("s_waitcnt vmcnt(0)" ::: "memory");
        }
    }
    __syncthreads();
}

struct Args { const float* in[34]; float* out; unsigned char* ws; int ph_lo, ph_hi, grid, pad; };
enum { I_XP = 0, I_XS, I_CP, I_CS, I_CK, I_CV, I_SRE, I_SIM, I_SCONV, I_WADA, I_BADA, I_LNG, I_LNB, I_WUP, I_WDC, I_BDC, I_WDOWN, I_WIN, I_LRE, I_LIM, I_LSTEP, I_BRE, I_BIM, I_CRE, I_CIM, I_SSMD, I_WGLU, I_WQKV, I_LQ1, I_LK1, I_LQ2, I_LK2, I_SUBG, I_WO };


typedef __attribute__((address_space(4))) const Args* CArgsP;
__device__ __forceinline__ CArgsP launder_args(CArgsP p) { asm volatile("" : "+s"(p)); return p; }
__device__ __forceinline__ int mk_lane() { int r; asm volatile("v_mbcnt_lo_u32_b32 %0, -1, 0\n\tv_mbcnt_hi_u32_b32 %0, -1, %0" : "=v"(r)); return r; }
#define REPEAT(k)
#define PHASE_ARGS const int lane = mk_lane(), tid = wave * 64 + lane; (void)tid; const Args& A = *(const Args*)launder_args((CArgsP)__builtin_amdgcn_kernarg_segment_ptr()); const int G = A.grid, bx = blockIdx.x, gw = bx * NWAVES + wave, NGW = G * NWAVES, vcu = (G % 8 == 0) ? (bx % 8) * (G / 8) + bx / 8 : bx; (void)gw; (void)NGW; (void)vcu
namespace pg8 {
__device__ __forceinline__ float dpp_ror1(float x) { return __builtin_bit_cast(float, __builtin_amdgcn_update_dpp(0, __builtin_bit_cast(int, x), 0x121, 0xf, 0xf, false)); }
__device__ __forceinline__ float dpp_ror2(float x) { return __builtin_bit_cast(float, __builtin_amdgcn_update_dpp(0, __builtin_bit_cast(int, x), 0x122, 0xf, 0xf, false)); }
template <int layer> struct EpiUpConv {
    static constexpr bool PERM = true, AFTER_DRAIN = false;
    __device__ static __forceinline__ unsigned pk4(float a, float b, float c, float d) {
        a = __builtin_amdgcn_fmed3f(a * 32.f, -448.f, 448.f); b = __builtin_amdgcn_fmed3f(b * 32.f, -448.f, 448.f); c = __builtin_amdgcn_fmed3f(c * 32.f, -448.f, 448.f); d = __builtin_amdgcn_fmed3f(d * 32.f, -448.f, 448.f);
        unsigned w = 0u; w = (unsigned)__builtin_amdgcn_cvt_pk_fp8_f32(a, b, (int)w, false); w = (unsigned)__builtin_amdgcn_cvt_pk_fp8_f32(c, d, (int)w, true); return w; }
    __device__ __forceinline__ void operator()(const f32x4 (&acc)[2][2][4][2], const Unit& u, int wr, int wc, int fr, int fq) const {
        typedef unsigned u32x2 __attribute__((ext_vector_type(2)));
        const Args& Aq = *(const Args*)launder_args((CArgsP)__builtin_amdgcn_kernarg_segment_ptr());
        unsigned char* const ws = Aq.ws; unsigned char* const ACT = ws + WS_ACT8; float* const GT = (float*)(ws + WS_GT); float* const FR = (float*)(ws + WS_FR);
        const float* const wdc = Aq.in[I_WDC] + (size_t)layer * 3 * DFF; const float* const bdc = Aq.in[I_BDC] + (size_t)layer * DFF; const float* const stc = Aq.in[I_SCONV] + (size_t)layer * 16 * 2 * DFF;
        PG8_LAS unsigned char* const xch = (PG8_LAS unsigned char*)0 + XCH_OFF;
        const int col = u.pn * HALF + wc * 32 + 8 * fq;
        float w0[8], w1[8], w2[8], bb[8];
        { const f32x4 a0 = *(const f32x4*)(wdc + col), a1 = *(const f32x4*)(wdc + col + 4), b0 = *(const f32x4*)(wdc + 5632 + col), b1 = *(const f32x4*)(wdc + 5632 + col + 4),
                      c0 = *(const f32x4*)(wdc + 2 * 5632 + col), c1 = *(const f32x4*)(wdc + 2 * 5632 + col + 4), d0 = *(const f32x4*)(bdc + col), d1 = *(const f32x4*)(bdc + col + 4);
#pragma unroll
          for (int e = 0; e < 4; ++e) { w0[e] = a0[e]; w0[4 + e] = a1[e]; w1[e] = b0[e]; w1[4 + e] = b1[e]; w2[e] = c0[e]; w2[4 + e] = c1[e]; bb[e] = d0[e]; bb[4 + e] = d1[e]; } }
        if (fr >= 14) {
#pragma unroll
            for (int ai = 0; ai < 2; ++ai) { PG8_LAS unsigned char* p = xch + (size_t)(((((ai * 2 + wr) * 4 + wc) * 2 + (fr - 14)) * 4 + fq) * 32);
                *(PG8_LAS f32x4*)p = acc[ai][0][3][0]; *(PG8_LAS f32x4*)(p + 16) = acc[ai][0][3][1]; } }
        asm volatile("s_waitcnt lgkmcnt(0)" ::: "memory"); __builtin_amdgcn_s_barrier(); asm volatile("" ::: "memory");
        const bool samp = u.pm >= (EP_MP / BM);
        int rb = u.pm * BM + wr * 64 + fr; asm volatile("" : "+v"(rb));
#pragma unroll
        for (int ai = 0; ai < 2; ++ai) {
            float xb1[8], xb2[8]; bool defer = false;
            if (ai == 0 && wr == 0) {
#pragma unroll
                for (int e = 0; e < 8; ++e) { xb1[e] = 0.f; xb2[e] = 0.f; }
                defer = !samp && (u.pm & 15) != 0;
            } else { const int ps = (wr == 1) ? ai * 2 : (ai - 1) * 2 + 1;
                const PG8_LAS unsigned char* p = xch + (size_t)((((ps * 4 + wc) * 2 + 0) * 4 + fq) * 32);
                const f32x4 q0 = *(const PG8_LAS f32x4*)p, q1 = *(const PG8_LAS f32x4*)(p + 16), r0 = *(const PG8_LAS f32x4*)(p + 128), r1 = *(const PG8_LAS f32x4*)(p + 144);
#pragma unroll
                for (int e = 0; e < 4; ++e) { xb2[e] = q0[e]; xb2[4 + e] = q1[e]; xb1[e] = r0[e]; xb1[4 + e] = r1[e]; } }
#pragma unroll
            for (int m = 0; m < 4; ++m) {
                const int r = rb + ai * HALF + m * 16;
                float g[8], v[8], p1[8], p2[8];
#pragma unroll
                for (int e = 0; e < 4; ++e) { g[e] = acc[ai][0][m][0][e]; g[4 + e] = acc[ai][0][m][1][e]; v[e] = acc[ai][1][m][0][e]; v[4 + e] = acc[ai][1][m][1][e]; }
#pragma unroll
                for (int e = 0; e < 8; ++e) {
                    const float s1 = dpp_ror1(g[e]), s2 = dpp_ror2(g[e]);
                    float c1, c2;
                    if (m > 0) { const float gp = e < 4 ? acc[ai][0][m - 1][0][e] : acc[ai][0][m - 1][1][e - 4]; c1 = dpp_ror1(gp); c2 = dpp_ror2(gp); }
                    else { c1 = xb1[e]; c2 = (fr == 0) ? xb2[e] : xb1[e]; }
                    p1[e] = (fr >= 1) ? s1 : c1; p2[e] = (fr >= 2) ? s2 : c2; }
                if (samp && (r & 31) < 2) { const float* st = stc + (size_t)(((r - EP_MP) >> 5) * 2) * 5632 + col;
                    const f32x4 a0 = *(const f32x4*)st, a1 = *(const f32x4*)(st + 4), b0 = *(const f32x4*)(st + 5632), b1 = *(const f32x4*)(st + 5632 + 4);
                    if ((r & 31) == 0) {
#pragma unroll
                        for (int e = 0; e < 4; ++e) { p2[e] = a0[e]; p2[4 + e] = a1[e]; p1[e] = b0[e]; p1[4 + e] = b1[e]; } }
                    else {
#pragma unroll
                        for (int e = 0; e < 4; ++e) { p2[e] = b0[e]; p2[4 + e] = b1[e]; } } }
                float o[8];
#pragma unroll
                for (int e = 0; e < 8; e += 2) { const float c0 = bb[e] + w0[e] * p2[e] + w1[e] * p1[e] + w2[e] * g[e], c1 = bb[e + 1] + w0[e + 1] * p2[e + 1] + w1[e + 1] * p1[e + 1] + w2[e + 1] * g[e + 1];
                    const f32x2 a = gelu_pk((f32x2){c0, c1}); o[e] = a.x * v[e]; o[e + 1] = a.y * v[e + 1]; }
                if (defer && m == 0 && fr < 2) {
                    float* fp = FR + (size_t)((u.pm * 2 + fr) * 2) * 5632 + col;
                    *(f32x4*)fp = (f32x4){g[0], g[1], g[2], g[3]}; *(f32x4*)(fp + 4) = (f32x4){g[4], g[5], g[6], g[7]};
                    *(f32x4*)(fp + 5632) = (f32x4){v[0], v[1], v[2], v[3]}; *(f32x4*)(fp + 5632 + 4) = (f32x4){v[4], v[5], v[6], v[7]};
                } else { u32x2 w; w.x = pk4(o[0], o[1], o[2], o[3]); w.y = pk4(o[4], o[5], o[6], o[7]); *(u32x2*)(ACT + (size_t)r * 5632 + col) = w; }
                if (ai == 1 && wr == 1 && m == 3 && fr >= 14) { float* gp = GT + (size_t)(u.pm * 2 + (fr - 14)) * 5632 + col;
                    *(f32x4*)gp = (f32x4){g[0], g[1], g[2], g[3]}; *(f32x4*)(gp + 4) = (f32x4){g[4], g[5], g[6], g[7]}; }
            }
        }
        asm volatile("s_waitcnt lgkmcnt(0)" ::: "memory"); __builtin_amdgcn_s_barrier(); asm volatile("" ::: "memory");
    }
};
}

__device__ __forceinline__ float wave_sum(float v) {
#pragma unroll
    for (int o = 1; o < 64; o <<= 1) v += __shfl_xor(v, o);
    return v;
}
__device__ __forceinline__ unsigned cvtpk2(float lo, float hi) { unsigned r; asm volatile("v_cvt_pk_bf16_f32 %0, %1, %2" : "=v"(r) : "v"(lo), "v"(hi)); return r; }
__device__ __forceinline__ int row_stream(int r) { return r < MP ? (r >> 12) : 8 + ((r - MP) >> 5); }

__device__ __forceinline__ void p0_transpose_item(const float* W, int K, int N, bf16* WT, int kind, LAS float* scr, int item, int lane) {
    const int nblk = N / 32, kb = item / nblk, nb = item % nblk, k0 = 64 * kb, n0 = 32 * nb;
    int d0 = n0;
    if (kind == 1) { const int hn = N / 2, half = n0 / hn, rem = n0 % hn; d0 = 256 * (rem >> 7) + 128 * half + (rem & 127); }
    { float tv[32]; const float* wp = W + (size_t)(k0 + (lane >> 5)) * N + n0 + (lane & 31);
#pragma unroll
      for (int i = 0; i < 32; ++i) tv[i] = wp[(size_t)(2 * i) * N];
#pragma unroll
      for (int i = 0; i < 32; ++i) scr[(2 * i + (lane >> 5)) * 33 + (lane & 31)] = tv[i]; }
    LDS_WAIT(); asm volatile("" ::: "memory");
    const int c = lane & 7;
#pragma unroll
    for (int j = 0; j < 4; ++j) { const int n = (lane >> 3) + 8 * j; const LAS float* s = scr + (8 * c) * 33 + n;
        v4u o; o.x = pk2(s[0 * 33], s[1 * 33]); o.y = pk2(s[2 * 33], s[3 * 33]); o.z = pk2(s[4 * 33], s[5 * 33]); o.w = pk2(s[6 * 33], s[7 * 33]);
        *(GAS v4u*)(WT + (size_t)(d0 + n) * K + k0 + 8 * c) = o; }
    LDS_WAIT(); asm volatile("" ::: "memory");
}

__device__ __forceinline__ unsigned pk4_fp8(float a, float b, float c, float d) {
    a = __builtin_amdgcn_fmed3f(a, -448.f, 448.f); b = __builtin_amdgcn_fmed3f(b, -448.f, 448.f); c = __builtin_amdgcn_fmed3f(c, -448.f, 448.f); d = __builtin_amdgcn_fmed3f(d, -448.f, 448.f);
    unsigned w = 0u; w = (unsigned)__builtin_amdgcn_cvt_pk_fp8_f32(a, b, (int)w, false); w = (unsigned)__builtin_amdgcn_cvt_pk_fp8_f32(c, d, (int)w, true); return w;
}
__device__ __forceinline__ void p0_transpose_item_fp8(const float* W, int K, int N, unsigned char* WT, int kind, float scale, LAS float* scr, int item, int lane) {
    const int nblk = N / 32, kb = item / nblk, nb = item % nblk, k0 = 64 * kb, n0 = 32 * nb;
    int d0 = n0;
    if (kind == 1) { const int hn = N / 2, half = n0 / hn, rem = n0 % hn; d0 = 256 * (rem >> 7) + 128 * half + (rem & 127); }
    { float tv[32]; const float* wp = W + (size_t)(k0 + (lane >> 5)) * N + n0 + (lane & 31);
#pragma unroll
      for (int i = 0; i < 32; ++i) tv[i] = wp[(size_t)(2 * i) * N];
#pragma unroll
      for (int i = 0; i < 32; ++i) scr[(2 * i + (lane >> 5)) * 33 + (lane & 31)] = tv[i]; }
    LDS_WAIT(); asm volatile("" ::: "memory");
    const int n = lane >> 1, kh = (lane & 1) * 32; const LAS float* sp = scr + kh * 33 + n;
    v4u o0, o1;
    o0.x = pk4_fp8(sp[0 * 33] * scale, sp[1 * 33] * scale, sp[2 * 33] * scale, sp[3 * 33] * scale);     o0.y = pk4_fp8(sp[4 * 33] * scale, sp[5 * 33] * scale, sp[6 * 33] * scale, sp[7 * 33] * scale);
    o0.z = pk4_fp8(sp[8 * 33] * scale, sp[9 * 33] * scale, sp[10 * 33] * scale, sp[11 * 33] * scale);   o0.w = pk4_fp8(sp[12 * 33] * scale, sp[13 * 33] * scale, sp[14 * 33] * scale, sp[15 * 33] * scale);
    o1.x = pk4_fp8(sp[16 * 33] * scale, sp[17 * 33] * scale, sp[18 * 33] * scale, sp[19 * 33] * scale); o1.y = pk4_fp8(sp[20 * 33] * scale, sp[21 * 33] * scale, sp[22 * 33] * scale, sp[23 * 33] * scale);
    o1.z = pk4_fp8(sp[24 * 33] * scale, sp[25 * 33] * scale, sp[26 * 33] * scale, sp[27 * 33] * scale); o1.w = pk4_fp8(sp[28 * 33] * scale, sp[29 * 33] * scale, sp[30 * 33] * scale, sp[31 * 33] * scale);
    GAS v4u* dst = (GAS v4u*)(WT + (size_t)(d0 + n) * K + k0 + kh); dst[0] = o0; dst[1] = o1;
    LDS_WAIT(); asm volatile("" ::: "memory");
}
__device__ __forceinline__ void sincos_cw(float x, float& s, float& c) {
    const float k = rintf(x * 0.63661977236758134f);
    float r = fmaf(k, -1.5703125f, x); r = fmaf(k, -4.837512969970703125e-4f, r); r = fmaf(k, -7.54978995489188216e-8f, r);
    const float r2 = r * r;
    const float sp = r + r * r2 * (-1.6666654611e-1f + r2 * (8.3321608736e-3f + r2 * -1.9515295891e-4f));
    const float cp = 1.0f - 0.5f * r2 + r2 * r2 * (4.166664568298827e-2f + r2 * (-1.388731625493765e-3f + r2 * 2.443315711809948e-5f));
    const int q = (int)k & 3;
    const float ss = (q & 1) ? cp : sp, cc = (q & 1) ? sp : cp;
    s = (q & 2) ? -ss : ss; c = ((q + 1) & 2) ? -cc : cc;
}
__device__ __forceinline__ void p0_ssm_tables(const Args& A, int g, int lane) {
    const int p = lane;
    const float lr = fminf(A.in[I_LRE][g * 64 + p], -1e-4f), li = A.in[I_LIM][g * 64 + p], dt = expf(A.in[I_LSTEP][g]);
    const float mag = expf(lr * dt); float sn, cs; sincos_cw(li * dt, sn, cs);
    const float ar = mag * cs, ai = mag * sn, nr = ar - 1.0f, ni = ai, den = lr * lr + li * li;
    const float kr = (nr * lr + ni * li) / den, ki = (ni * lr - nr * li) / den;
    float2* ab = (float2*)(A.ws + WS_ABAR); ab[g * 64 + p] = make_float2(ar, ai);
    bf16* bbt = (bf16*)(A.ws + WS_BBT) + (size_t)g * 128 * 16;
    const float* bre = A.in[I_BRE] + ((size_t)g * 64 + p) * 16; const float* bim = A.in[I_BIM] + ((size_t)g * 64 + p) * 16;
#pragma unroll
    for (int c = 0; c < 16; ++c) { const float br = bre[c], bi = bim[c];
        bbt[p * 16 + c] = (bf16)f2bf(kr * br - ki * bi); bbt[(64 + p) * 16 + c] = (bf16)f2bf(kr * bi + ki * br); }
    bf16* cmt = (bf16*)(A.ws + WS_CMT) + (size_t)g * 16 * 128;
#pragma unroll
    for (int c = 0; c < 16; ++c) { const float cr = A.in[I_CRE][((size_t)g * 16 + c) * 64 + p], ci = A.in[I_CIM][((size_t)g * 16 + c) * 64 + p];
        *(unsigned*)(cmt + c * 128 + 2 * p) = f2bf(cr) | (f2bf(-ci) << 16); }
}
__device__ __forceinline__ void p0_ada_item(const Args& A, LAS unsigned char* lds, int item, int tid, int wave, int lane) {
    const int l = item / 96, cb = item % 96;
    LAS float* SC = (LAS float*)lds;
    LAS float* RED = (LAS float*)(lds + 98304);
    float acx[24], acy[24];
#pragma unroll
    for (int s = 0; s < 24; ++s) { acx[s] = 0.f; acy[s] = 0.f; }
    const float* W = A.in[I_WADA] + (size_t)l * DM * 12288 + cb * 128 + lane * 2;
    for (int half = 0; half < 2; ++half) {
        for (int i = tid; i < 24 * 1024; i += 512) { const int s = i >> 10, k = (i & 1023) + half * 1024;
            const float c = s < 8 ? A.in[I_CP][s * DM + k] : A.in[I_CS][(s - 8) * DM + k]; SC[i] = c / (1.0f + __expf(-c)); }
        __syncthreads();
        const int k0 = wave * 128; const float* Wk = W + (size_t)(half * 1024 + k0) * 12288;
#pragma unroll 1
        for (int kb = 0; kb < 128; kb += 16) { pg8::f32x2 wv[16];
#pragma unroll
            for (int j = 0; j < 16; ++j) wv[j] = *(const pg8::f32x2*)(Wk + (size_t)(kb + j) * 12288);
#pragma unroll
            for (int j = 0; j < 16; ++j) {
#pragma unroll
                for (int s = 0; s < 24; ++s) { const float c = SC[s * 1024 + k0 + kb + j]; acx[s] = fmaf(c, wv[j].x, acx[s]); acy[s] = fmaf(c, wv[j].y, acy[s]); } } }
        __syncthreads();
    }
    for (int w8 = 0; w8 < 8; ++w8) {
        if (wave == w8) {
#pragma unroll
            for (int s = 0; s < 24; ++s) { pg8::f32x2 v; v.x = acx[s]; v.y = acy[s]; LAS pg8::f32x2* rp = (LAS pg8::f32x2*)(RED + s * 128 + lane * 2); if (w8) v += *rp; *rp = v; } }
        __syncthreads();
    }
    float* mod = (float*)(A.ws + WS_MOD);
    for (int i = tid; i < 24 * 128; i += 512) { const int s = i >> 7, c = i & 127; mod[((size_t)l * 24 + s) * 12288 + cb * 128 + c] = RED[i] + A.in[I_BADA][l * 12288 + cb * 128 + c]; }
    __syncthreads();
}
__device__ __forceinline__ void mod_row(const float* __restrict__ xr, const float* __restrict__ sc, const float* __restrict__ sh, bf16* __restrict__ hr, int lane) {
    f32x4 xa[4], xb[4];
#pragma unroll
    for (int j = 0; j < 4; ++j) { const int col = j * 512 + lane * 8; xa[j] = *(const f32x4*)(xr + col); xb[j] = *(const f32x4*)(xr + col + 4); }
#pragma unroll
    for (int j = 0; j < 4; ++j) { const int col = j * 512 + lane * 8;
        const f32x4 a0 = xa[j], a1 = xb[j], s0 = *(const f32x4*)(sc + col), s1 = *(const f32x4*)(sc + col + 4), h0 = *(const f32x4*)(sh + col), h1 = *(const f32x4*)(sh + col + 4);
        v4u w; w.x = cvtpk2(a0[0] * (1.f + s0[0]) + h0[0], a0[1] * (1.f + s0[1]) + h0[1]); w.y = cvtpk2(a0[2] * (1.f + s0[2]) + h0[2], a0[3] * (1.f + s0[3]) + h0[3]);
        w.z = cvtpk2(a1[0] * (1.f + s1[0]) + h1[0], a1[1] * (1.f + s1[1]) + h1[1]); w.w = cvtpk2(a1[2] * (1.f + s1[2]) + h1[2], a1[3] * (1.f + s1[3]) + h1[3]);
        *(v4u*)(hr + col) = w; }
}
#ifndef MK_DIAG_Y
#define MK_DIAG_Y 1.0f
#endif
__device__ __forceinline__ void ln_row(float* xr, const float* lg, const float* lb, const float* sc, const float* sh, bf16* hr, int lane, float dscale = 1.0f, unsigned char* h8 = nullptr) {
    f32x4 v[8]; float s = 0.f;
#pragma unroll
    for (int j = 0; j < 8; ++j) { v[j] = *(const f32x4*)(xr + j * 256 + lane * 4); s += (v[j][0] + v[j][1]) + (v[j][2] + v[j][3]); }
    const float mean = wave_sum(s) * (1.f / DM); float s2 = 0.f;
#pragma unroll
    for (int j = 0; j < 8; ++j) { v[j] = v[j] - mean; s2 += (v[j][0] * v[j][0] + v[j][1] * v[j][1]) + (v[j][2] * v[j][2] + v[j][3] * v[j][3]); }
    const float rstd = 1.f / sqrtf(wave_sum(s2) * (1.f / DM) + LN_EPS);
#pragma unroll
    for (int j = 0; j < 8; ++j) { const int col = j * 256 + lane * 4; const f32x4 g = *(const f32x4*)(lg + col), b = *(const f32x4*)(lb + col);
        f32x4 y;
#pragma unroll
        for (int e = 0; e < 4; ++e) y[e] = (v[j][e] * rstd * g[e] + b[e]) * dscale;
        *(f32x4*)(xr + col) = y;
        if (hr) { const f32x4 a = *(const f32x4*)(sc + col), h = *(const f32x4*)(sh + col);
            uint2 w; w.x = cvtpk2(y[0] * (1.f + a[0]) + h[0], y[1] * (1.f + a[1]) + h[1]); w.y = cvtpk2(y[2] * (1.f + a[2]) + h[2], y[3] * (1.f + a[3]) + h[3]);
            *(uint2*)(hr + col) = w; }
        if (h8) { const f32x4 a = *(const f32x4*)(sc + col), h = *(const f32x4*)(sh + col);
            *(unsigned*)(h8 + col) = pk4_fp8((y[0] * (1.f + a[0]) + h[0]) * F8_H1, (y[1] * (1.f + a[1]) + h[1]) * F8_H1, (y[2] * (1.f + a[2]) + h[2]) * F8_H1, (y[3] * (1.f + a[3]) + h[3]) * F8_H1); } }
}

template <int MODE> __device__ __forceinline__ void ln_rows_span(float* Xs, const float* stt, const float* lg, const float* lb, const float* modb, int sc_off, int sh_off, unsigned char* H8, bf16* HBp, int r0, int r1, int lane) {
    if (r0 >= r1) return;
    f32x4 Gv[8], Bv[8], v[8]; int cur = -1;
    { const float* xr = Xs + (size_t)r0 * DM + lane * 4;
#pragma unroll
      for (int j = 0; j < 8; ++j) v[j] = *(const f32x4*)(xr + j * 256); }
    float s0 = stt[2 * (size_t)r0], s1 = stt[2 * (size_t)r0 + 1];
    for (int r = r0; r < r1; ++r) {
        if ((r >> 12) != cur) { cur = r >> 12; const float* md = modb + (size_t)cur * 12288;
#pragma unroll
            for (int j = 0; j < 8; ++j) { const int col = j * 256 + lane * 4; const f32x4 g = *(const f32x4*)(lg + col), b = *(const f32x4*)(lb + col);
                if (MODE == 0) { Gv[j] = g; Bv[j] = b; }
                else { const f32x4 a = *(const f32x4*)(md + sc_off + col) + 1.0f, h = *(const f32x4*)(md + sh_off + col); const float F = MODE == 1 ? F8_H1 : 1.0f; Gv[j] = g * a * F; Bv[j] = (b * a + h) * F; } } }
        f32x4 vn[8]; float n0 = 0.f, n1 = 0.f;
        if (r + 1 < r1) { const float* xr = Xs + (size_t)(r + 1) * DM + lane * 4;
#pragma unroll
            for (int j = 0; j < 8; ++j) vn[j] = *(const f32x4*)(xr + j * 256);
            n0 = stt[2 * (size_t)(r + 1)]; n1 = stt[2 * (size_t)(r + 1) + 1]; }
        const float mu = s0 * (1.f / DM), rstd = 1.f / sqrtf(fmaxf(s1 * (1.f / DM) - mu * mu, 0.f) + LN_EPS);
#pragma unroll
        for (int j = 0; j < 8; ++j) { const int col = j * 256 + lane * 4; f32x4 z;
#pragma unroll
            for (int e = 0; e < 4; ++e) z[e] = ((v[j][e] - mu) * rstd) * Gv[j][e] + Bv[j][e];
            if (MODE == 0) *(f32x4*)(Xs + (size_t)r * DM + col) = z;
            else if (MODE == 1) *(unsigned*)(H8 + (size_t)r * DM + col) = pk4_fp8(z[0], z[1], z[2], z[3]);
            else { uint2 w; w.x = cvtpk2(z[0], z[1]); w.y = cvtpk2(z[2], z[3]); *(uint2*)(HBp + (size_t)r * DM + col) = w; } }
        if (r + 1 < r1) {
#pragma unroll
            for (int j = 0; j < 8; ++j) v[j] = vn[j];
            s0 = n0; s1 = n1; }
    }
}
#define SPAN_ROWS(NS, HW, NR, R0, R1) const int vw_ = bx < (NS) ? ((wave < (HW)) ? bx * (HW) + wave : -1) : (NS) * (HW) + (bx - (NS)) * NWAVES + wave, nv_ = (NS) * (HW) + (G - (NS)) * NWAVES; \
        const int R0 = vw_ < 0 ? 0 : (int)((long)vw_ * (NR) / nv_), R1 = vw_ < 0 ? 0 : (int)((long)(vw_ + 1) * (NR) / nv_)
__device__ __forceinline__ void ln_row_st(float* __restrict__ xr, const float* __restrict__ st, const float* __restrict__ lg, const float* __restrict__ lb, const float* __restrict__ sc, const float* __restrict__ sh, unsigned char* __restrict__ h8, bf16* __restrict__ hb, bool yout, int lane) {
    const float mu = st[0] * (1.f / DM), rstd = 1.f / sqrtf(fmaxf(st[1] * (1.f / DM) - mu * mu, 0.f) + LN_EPS);
    f32x4 v[8];
#pragma unroll
    for (int j = 0; j < 8; ++j) v[j] = *(const f32x4*)(xr + j * 256 + lane * 4);
#pragma unroll
    for (int j = 0; j < 8; ++j) { const int col = j * 256 + lane * 4; const f32x4 g = *(const f32x4*)(lg + col), b = *(const f32x4*)(lb + col);
        f32x4 y;
#pragma unroll
        for (int e = 0; e < 4; ++e) y[e] = (v[j][e] - mu) * rstd * g[e] + b[e];
        if (yout) *(f32x4*)(xr + col) = y;
        if (h8 || hb) { const f32x4 a = *(const f32x4*)(sc + col), h = *(const f32x4*)(sh + col);
            const float z0 = y[0] * (1.f + a[0]) + h[0], z1 = y[1] * (1.f + a[1]) + h[1], z2 = y[2] * (1.f + a[2]) + h[2], z3 = y[3] * (1.f + a[3]) + h[3];
            if (h8) *(unsigned*)(h8 + col) = pk4_fp8(z0 * F8_H1, z1 * F8_H1, z2 * F8_H1, z3 * F8_H1);
            if (hb) { uint2 w; w.x = cvtpk2(z0, z1); w.y = cvtpk2(z2, z3); *(uint2*)(hb + col) = w; } } }
}
__device__ __forceinline__ void down_sample_row(const Args& A, int layer, int r, int lane) {
    float* xr = A.out + OUT_Y + (size_t)r * DM; const float* p0 = (const float*)(A.ws + WS_PART) + (size_t)(r - MP) * DM; const float* p1 = p0 + (size_t)512 * DM;
    float* STAT = (float*)(A.ws + WS_STAT); const float* sti = STAT + ((size_t)(layer ? 2 : 0) * M + r) * 2; float* sto = STAT + ((size_t)(layer ? 3 : 1) * M + r) * 2;
    const float* lga = A.in[I_LNG] + (size_t)(layer * 2) * DM; const float* lba = A.in[I_LNB] + (size_t)(layer * 2) * DM;
    const float* lgb = A.in[I_LNG] + (size_t)(layer * 2 + 1) * DM; const float* lbb = A.in[I_LNB] + (size_t)(layer * 2 + 1) * DM;
    const float* MOD = (const float*)(A.ws + WS_MOD); const int st = row_stream(r);
    const float* gt = MOD + ((size_t)layer * NSTREAM + st) * 12288 + 5 * DM; const float* mdn = MOD + ((size_t)NSTREAM + st) * 12288;
    const float mu = sti[0] * (1.f / DM), rs = 1.f / sqrtf(fmaxf(sti[1] * (1.f / DM) - mu * mu, 0.f) + LN_EPS);
    f32x4 v[8]; float s1 = 0.f, s2 = 0.f;
#pragma unroll
    for (int j = 0; j < 8; ++j) { const int col = j * 256 + lane * 4; const f32x4 a = *(const f32x4*)(p0 + col), b = *(const f32x4*)(p1 + col), xp = *(const f32x4*)(xr + col), g = *(const f32x4*)(lga + col), bb = *(const f32x4*)(lba + col), ga = *(const f32x4*)(gt + col);
#pragma unroll
        for (int e = 0; e < 4; ++e) { const float x = (xp[e] - mu) * rs * g[e] + bb[e]; const float rn = 1.4142135623730951f * x + (1.f + ga[e]) * (a[e] + b[e]); v[j][e] = rn; s1 += rn; s2 += rn * rn; } }
    s1 = wave_sum(s1); s2 = wave_sum(s2);
    if (lane == 0) { sto[0] = s1; sto[1] = s2; }
    const float mu2 = s1 * (1.f / DM), rs2 = 1.f / sqrtf(fmaxf(s2 * (1.f / DM) - mu2 * mu2, 0.f) + LN_EPS);
#pragma unroll
    for (int j = 0; j < 8; ++j) { const int col = j * 256 + lane * 4; const f32x4 g = *(const f32x4*)(lgb + col), bb = *(const f32x4*)(lbb + col); f32x4 y;
#pragma unroll
        for (int e = 0; e < 4; ++e) y[e] = (v[j][e] - mu2) * rs2 * g[e] + bb[e];
        if (layer == 0) { *(f32x4*)(xr + col) = v[j]; const f32x4 a = *(const f32x4*)(mdn + 1 * DM + col), h = *(const f32x4*)(mdn + col);
            uint2 w; w.x = cvtpk2(y[0] * (1.f + a[0]) + h[0], y[1] * (1.f + a[1]) + h[1]); w.y = cvtpk2(y[2] * (1.f + a[2]) + h[2], y[3] * (1.f + a[3]) + h[3]);
            *(uint2*)((bf16*)(A.ws + WS_HB) + (size_t)r * DM + col) = w; }
        else *(f32x4*)(xr + col) = y; }
}
#ifndef MK_DIAG_SR
#define MK_DIAG_SR 1.0f
#endif
typedef short s16x4v __attribute__((ext_vector_type(4)));
typedef float f32x2v __attribute__((ext_vector_type(2)));
__device__ __forceinline__ void ssm_seq(const Args& A, LAS unsigned char* wl, int stream, int g, int lane) {
    const bool prompt = stream < 8;
    const int nch = prompt ? SEQ / 16 : TS / 16;
    const size_t row0 = prompt ? (size_t)stream * SEQ : (size_t)MP + (size_t)(stream - 8) * TS;
    const bf16* U = (const bf16*)(A.ws + WS_U) + row0 * DM + 16 * g;
    unsigned char* Z = (unsigned char*)(A.ws + WS_Z) + row0 * DM + 16 * g;
    const int n16 = lane & 15, q4 = lane >> 4;
    s16x4v bB[8]; bf16x8 cB[4]; s16x4v dB;
    { const bf16* bbt = (const bf16*)(A.ws + WS_BBT) + (size_t)g * 128 * 16;
#pragma unroll
      for (int nb = 0; nb < 8; ++nb) bB[nb] = *(const s16x4v*)(bbt + (16 * nb + n16) * 16 + 4 * q4);
      const bf16* cmt = (const bf16*)(A.ws + WS_CMT) + (size_t)g * 16 * 128;
#pragma unroll
      for (int ks = 0; ks < 4; ++ks) cB[ks] = *(const bf16x8*)(cmt + n16 * 128 + 32 * ks + 8 * q4);
      const short dv = (short)f2bf(A.in[I_SSMD][16 * g + n16]);
#pragma unroll
      for (int j = 0; j < 4; ++j) dB[j] = (4 * q4 + j == n16) ? dv : (short)0; }
    const float2 ab = ((const float2*)(A.ws + WS_ABAR))[g * 64 + lane];
    const float ar = ab.x, ai = ab.y;
    float hr = 0.f, hi = 0.f;
    if (!prompt) { hr = A.in[I_SRE][((size_t)(stream - 8) * NGRP + g) * SP + lane]; hi = A.in[I_SIM][((size_t)(stream - 8) * NGRP + g) * SP + lane]; }
    LAS unsigned char* hl = wl + 10240;
#define SSM_LD(ch) (*(const s16x4v*)(U + (size_t)((ch) * 16 + n16) * DM + 4 * q4))
#define SSM_STEP(ua, ch) do { \
        f32x4 bu[8]; \
        _Pragma("unroll") for (int nb = 0; nb < 8; ++nb) bu[nb] = __builtin_amdgcn_mfma_f32_16x16x16bf16_1k(ua, bB[nb], (f32x4){0.f, 0.f, 0.f, 0.f}, 0, 0, 0); \
        _Pragma("unroll") for (int nb = 0; nb < 8; ++nb) *(LAS f32x4*)(wl + ((16 * nb + n16) * 20 + 4 * q4) * 4) = bu[nb]; \
        LDS_WAIT(); asm volatile("" ::: "memory"); \
        f32x4 br[4], bi[4]; \
        _Pragma("unroll") for (int j = 0; j < 4; ++j) { br[j] = *(const LAS f32x4*)(wl + (lane * 20 + 4 * j) * 4); bi[j] = *(const LAS f32x4*)(wl + ((64 + lane) * 20 + 4 * j) * 4); } \
        _Pragma("unroll") for (int t = 0; t < 16; ++t) { \
            const float nhr = fmaf(ar, hr, fmaf(-ai, hi, br[t >> 2][t & 3])), nhi = fmaf(ar, hi, fmaf(ai, hr, bi[t >> 2][t & 3])); hr = nhr; hi = nhi; \
            *(LAS unsigned*)(hl + (t * 68 + lane) * 4) = cvtpk2(hr, hi); } \
        LDS_WAIT(); asm volatile("" ::: "memory"); \
        f32x4 y = (f32x4){0.f, 0.f, 0.f, 0.f}; \
        _Pragma("unroll") for (int ks = 0; ks < 4; ++ks) { const bf16x8 hA = *(const LAS bf16x8*)(hl + (n16 * 68 + 16 * ks + 4 * q4) * 4); y = __builtin_amdgcn_mfma_f32_16x16x32_bf16(hA, cB[ks], y, 0, 0, 0); } \
        { const f32x4 ysk = __builtin_amdgcn_mfma_f32_16x16x16bf16_1k(ua, dB, (f32x4){0.f, 0.f, 0.f, 0.f}, 0, 0, 0); y = y + ysk; }     \
        LDS_WAIT(); asm volatile("" ::: "memory"); \
        const pg8::f32x2 z0 = pg8::gelu_pk((pg8::f32x2){y[0], y[1]}), z1 = pg8::gelu_pk((pg8::f32x2){y[2], y[3]}); \
        unsigned char* zp = Z + (size_t)((ch) * 16 + 4 * q4) * DM + n16; \
        const unsigned w8 = pk4_fp8(z0.x * F8_Z, z0.y * F8_Z, z1.x * F8_Z, z1.y * F8_Z); \
        zp[0] = (unsigned char)(w8 & 0xffu); zp[DM] = (unsigned char)((w8 >> 8) & 0xffu); zp[2 * DM] = (unsigned char)((w8 >> 16) & 0xffu); zp[3 * DM] = (unsigned char)(w8 >> 24); \
    } while (0)
    s16x4v c0 = SSM_LD(0), c1 = SSM_LD(1), c2 = s16x4v{}, c3 = s16x4v{};
    if (nch > 2) { c2 = SSM_LD(2); c3 = SSM_LD(3); }
    for (int ch = 0; ch < nch; ch += 4) {
        s16x4v n0 = s16x4v{}, n1 = s16x4v{}, n2 = s16x4v{}, n3 = s16x4v{};
        if (ch + 4 < nch) { n0 = SSM_LD(ch + 4); n1 = SSM_LD(ch + 5); n2 = SSM_LD(ch + 6); n3 = SSM_LD(ch + 7); }
        SSM_STEP(c0, ch); SSM_STEP(c1, ch + 1);
        if (ch + 2 < nch) { SSM_STEP(c2, ch + 2); SSM_STEP(c3, ch + 3); }
        c0 = n0; c1 = n1; c2 = n2; c3 = n3;
    }
#undef SSM_LD
#undef SSM_STEP
    float* ore = A.out + (prompt ? OUT_SRP + ((size_t)stream * NGRP + g) * SP : OUT_SRS + ((size_t)(stream - 8) * NGRP + g) * SP);
    float* oim = A.out + (prompt ? OUT_SIP + ((size_t)stream * NGRP + g) * SP : OUT_SIS + ((size_t)(stream - 8) * NGRP + g) * SP);
    ore[lane] = hr * (prompt ? 1.0f : MK_DIAG_SR); oim[lane] = hi;
}


__device__ __forceinline__ void ssm_seq_sample_simple(const Args& A, int bs, int g, int lane) {
    const int p = lane;
    const size_t row0 = (size_t)MP + (size_t)bs * TS;
    const bf16* U = (const bf16*)(A.ws + WS_U) + row0 * DM + 16 * g;
    unsigned char* Z = (unsigned char*)(A.ws + WS_Z) + row0 * DM + 16 * g;
    const float lr = fminf(A.in[I_LRE][g * 64 + p], -1e-4f), li = A.in[I_LIM][g * 64 + p], dt = expf(A.in[I_LSTEP][g]);
    const float mag = expf(lr * dt); float sn, cs; sincos_cw(li * dt, sn, cs);
    const float ar = mag * cs, ai = mag * sn, nr = ar - 1.0f, ni = ai, den = lr * lr + li * li;
    const float kr = (nr * lr + ni * li) / den, ki = (ni * lr - nr * li) / den;
    float bbr[16], bbi[16], ccr[16], cci[16];
#pragma unroll
    for (int c = 0; c < 16; ++c) { const float br = A.in[I_BRE][((size_t)g * 64 + p) * 16 + c], bi = A.in[I_BIM][((size_t)g * 64 + p) * 16 + c];
        bbr[c] = kr * br - ki * bi; bbi[c] = kr * bi + ki * br;
        ccr[c] = A.in[I_CRE][((size_t)g * 16 + c) * 64 + p]; cci[c] = A.in[I_CIM][((size_t)g * 16 + c) * 64 + p]; }
    float hr = A.in[I_SRE][((size_t)bs * NGRP + g) * SP + p], hi = A.in[I_SIM][((size_t)bs * NGRP + g) * SP + p];
    const float dsk = A.in[I_SSMD][16 * g + (lane & 15)];
    for (int t = 0; t < TS; ++t) {
        float br = 0.f, bi = 0.f, myu = 0.f;
#pragma unroll
        for (int c = 0; c < 16; ++c) { const float uc = __uint_as_float((unsigned)U[(size_t)t * DM + c] << 16); br = fmaf(bbr[c], uc, br); bi = fmaf(bbi[c], uc, bi); if ((lane & 15) == c) myu = uc; }
        const float nhr = fmaf(ar, hr, fmaf(-ai, hi, br)), nhi = fmaf(ar, hi, fmaf(ai, hr, bi)); hr = nhr; hi = nhi;
        float yv = 0.f;
#pragma unroll
        for (int c = 0; c < 16; ++c) { const float s = wave_sum(ccr[c] * hr - cci[c] * hi); if ((lane & 15) == c) yv = s; }
        yv += dsk * myu;
        const pg8::f32x2 zz = pg8::gelu_pk((pg8::f32x2){yv, yv});
        if (lane < 16) Z[(size_t)t * DM + lane] = (unsigned char)(pk4_fp8(zz.x * F8_Z, 0.f, 0.f, 0.f) & 0xffu);
    }
    A.out[OUT_SRS + ((size_t)bs * NGRP + g) * SP + p] = hr; A.out[OUT_SIS + ((size_t)bs * NGRP + g) * SP + p] = hi;
}

__device__ __forceinline__ void fp8x8_to_f32(uint2 w, float (&o)[8]) {
    typedef float f2 __attribute__((ext_vector_type(2)));
    const f2 a = __builtin_amdgcn_cvt_pk_f32_fp8((int)w.x, false), b = __builtin_amdgcn_cvt_pk_f32_fp8((int)w.x, true), c = __builtin_amdgcn_cvt_pk_f32_fp8((int)w.y, false), d = __builtin_amdgcn_cvt_pk_f32_fp8((int)w.y, true);
    o[0] = a.x * (1.f / 64.f); o[1] = a.y * (1.f / 64.f); o[2] = b.x * (1.f / 64.f); o[3] = b.y * (1.f / 64.f); o[4] = c.x * (1.f / 64.f); o[5] = c.y * (1.f / 64.f); o[6] = d.x * (1.f / 64.f); o[7] = d.y * (1.f / 64.f);
}
__device__ __forceinline__ void conv_item(const Args& A, int layer, int item, int lane) {
    const int rb = item / 11, cs = item % 11, r0 = rb * 32, col = cs * 512 + lane * 8;
    const unsigned char* G = (const unsigned char*)(A.ws + WS_G); const unsigned char* V = (const unsigned char*)(A.ws + WS_V);
    const float* wc = A.in[I_WDC] + (size_t)layer * 3 * DFF + col; const float* bc = A.in[I_BDC] + (size_t)layer * DFF + col;
    float w0[8], w1[8], w2[8], bb[8], gm2[8], gm1[8];
#pragma unroll
    for (int e = 0; e < 8; ++e) { w0[e] = wc[e]; w1[e] = wc[DFF + e]; w2[e] = wc[2 * DFF + e]; bb[e] = bc[e]; gm2[e] = 0.f; gm1[e] = 0.f; }
    if (r0 >= MP) { const float* st = A.in[I_SCONV] + ((size_t)(layer * 16 + ((r0 - MP) >> 5)) * 2) * DFF + col;
#pragma unroll
        for (int e = 0; e < 8; ++e) { gm2[e] = st[e]; gm1[e] = st[DFF + e]; } }
    else if ((r0 & 4095) != 0) { fp8x8_to_f32(*(const uint2*)(G + (size_t)(r0 - 2) * DFF + col), gm2); fp8x8_to_f32(*(const uint2*)(G + (size_t)(r0 - 1) * DFF + col), gm1); }
#pragma unroll 4
    for (int t = 0; t < 32; ++t) {
        float gv[8], vv[8], o[8];
        fp8x8_to_f32(*(const uint2*)(G + (size_t)(r0 + t) * DFF + col), gv); fp8x8_to_f32(*(const uint2*)(V + (size_t)(r0 + t) * DFF + col), vv);
#pragma unroll
        for (int e = 0; e < 8; e += 2) { const float g0 = gv[e], g1 = gv[e + 1];
            const float c0 = bb[e] + w0[e] * gm2[e] + w1[e] * gm1[e] + w2[e] * g0, c1 = bb[e + 1] + w0[e + 1] * gm2[e + 1] + w1[e + 1] * gm1[e + 1] + w2[e + 1] * g1;
            const pg8::f32x2 a = pg8::gelu_pk((pg8::f32x2){c0, c1});
            o[e] = a.x * vv[e]; o[e + 1] = a.y * vv[e + 1];
            gm2[e] = gm1[e]; gm1[e] = g0; gm2[e + 1] = gm1[e + 1]; gm1[e + 1] = g1; }
        uint2 w; w.x = pk4_fp8(o[0] * F8_ACT, o[1] * F8_ACT, o[2] * F8_ACT, o[3] * F8_ACT); w.y = pk4_fp8(o[4] * F8_ACT, o[5] * F8_ACT, o[6] * F8_ACT, o[7] * F8_ACT);
        *(uint2*)((unsigned char*)(A.ws + WS_ACT8) + (size_t)(r0 + t) * DFF + col) = w;
    }
}


__device__ __forceinline__ void convfix_items(const Args& A, int layer, int gtid, int ngt) {
    const float* GT = (const float*)(A.ws + WS_GT); const float* FR = (const float*)(A.ws + WS_FR); unsigned char* ACT = (unsigned char*)(A.ws + WS_ACT8);
    const float* wc = A.in[I_WDC] + (size_t)layer * 3 * DFF; const float* bc = A.in[I_BDC] + (size_t)layer * DFF;
    for (int i = gtid; i < 120 * DFF; i += ngt) { const int j = i / DFF, col = i - j * DFF, pm = (j / 15) * 16 + (j % 15) + 1;
        const float gm2 = GT[(size_t)((pm - 1) * 2 + 0) * DFF + col], gm1 = GT[(size_t)((pm - 1) * 2 + 1) * DFF + col];
        const float g0 = FR[(size_t)((pm * 2 + 0) * 2 + 0) * DFF + col], v0 = FR[(size_t)((pm * 2 + 0) * 2 + 1) * DFF + col], g1 = FR[(size_t)((pm * 2 + 1) * 2 + 0) * DFF + col], v1 = FR[(size_t)((pm * 2 + 1) * 2 + 1) * DFF + col];
        const float w0 = wc[col], w1 = wc[DFF + col], w2 = wc[2 * DFF + col], bb = bc[col];
        const pg8::f32x2 a = pg8::gelu_pk((pg8::f32x2){bb + w0 * gm2 + w1 * gm1 + w2 * g0, bb + w0 * gm1 + w1 * g0 + w2 * g1});
        const unsigned w8 = pk4_fp8(a.x * v0 * F8_ACT, a.y * v1 * F8_ACT, 0.f, 0.f);
        ACT[(size_t)(pm * 256) * DFF + col] = (unsigned char)(w8 & 0xffu); ACT[(size_t)(pm * 256 + 1) * DFF + col] = (unsigned char)((w8 >> 8) & 0xffu); }
}
__device__ __forceinline__ void cvstate_item(const Args& A, int layer, LAS unsigned char* lds, int item, int tid) {
    const int cb = item % 88, q = item / 88;
    LAS float* H = (LAS float*)lds;
    const float* Xs = A.out + OUT_Y; const float* modl = (const float*)(A.ws + WS_MOD) + (size_t)layer * NSTREAM * 12288;
    for (int i = tid; i < 48 * 512; i += 512) { const int rr = i >> 9, k = (i & 511) + q * 512, st = rr >> 1, j = rr & 1;
        const size_t row = st < 8 ? (size_t)st * SEQ + (SEQ - 2) + j : (size_t)MP + (size_t)(st - 8) * TS + (TS - 2) + j; const float* md = modl + (size_t)st * 12288;
        const float* stt = (const float*)(A.ws + WS_STAT) + ((size_t)(layer ? 2 : 0) * M + row) * 2; const float mu = stt[0] * (1.f / DM), rstd = 1.f / sqrtf(fmaxf(stt[1] * (1.f / DM) - mu * mu, 0.f) + LN_EPS);
        const float x1 = (Xs[row * DM + k] - mu) * rstd * A.in[I_LNG][(size_t)(layer * 2) * DM + k] + A.in[I_LNB][(size_t)(layer * 2) * DM + k];
        H[i] = x1 * (1.0f + md[4 * DM + k]) + md[3 * DM + k]; }
    __syncthreads();
    const int c = tid & 63, rg = tid >> 6;
    const float* W = A.in[I_WUP] + (size_t)layer * DM * 2 * DFF + (size_t)(q * 512) * (2 * DFF) + cb * 64 + c;
    float acc[6];
#pragma unroll
    for (int i = 0; i < 6; ++i) acc[i] = 0.f;
    float wa[16], wb[16];
#pragma unroll
    for (int j = 0; j < 16; ++j) wa[j] = W[(size_t)j * (2 * DFF)];
    for (int k0 = 0; k0 < 512; k0 += 32) {
#pragma unroll
        for (int j = 0; j < 16; ++j) wb[j] = W[(size_t)(k0 + 16 + j) * (2 * DFF)];
#pragma unroll
        for (int j = 0; j < 16; ++j)
#pragma unroll
            for (int i = 0; i < 6; ++i) acc[i] = fmaf(H[(rg * 6 + i) * 512 + k0 + j], wa[j], acc[i]);
        if (k0 + 32 < 512) {
#pragma unroll
            for (int j = 0; j < 16; ++j) wa[j] = W[(size_t)(k0 + 32 + j) * (2 * DFF)]; }
#pragma unroll
        for (int j = 0; j < 16; ++j)
#pragma unroll
            for (int i = 0; i < 6; ++i) acc[i] = fmaf(H[(rg * 6 + i) * 512 + k0 + 16 + j], wb[j], acc[i]);
    }
    float* cvp = (float*)(A.ws + WS_CVP) + (size_t)q * 48 * DFF;
#pragma unroll
    for (int i = 0; i < 6; ++i) cvp[(size_t)(rg * 6 + i) * DFF + cb * 64 + c] = acc[i];
    __syncthreads();
}
__device__ __forceinline__ void cvstate_reduce(const Args& A, int layer, int gtid, int ngt) {
    const float* cvp = (const float*)(A.ws + WS_CVP);
    for (int i = gtid; i < 48 * DFF; i += ngt) { const int rr = i / DFF, col = i - rr * DFF, st = rr >> 1, j = rr & 1;
        const float v = (cvp[i] + cvp[(size_t)48 * DFF + i]) + (cvp[(size_t)2 * 48 * DFF + i] + cvp[(size_t)3 * 48 * DFF + i]);
        float* o = st < 8 ? A.out + OUT_CVP + ((size_t)(layer * 8 + st) * 2 + j) * DFF : A.out + OUT_CVS + ((size_t)(layer * 16 + (st - 8)) * 2 + j) * DFF;
        o[col] = v; }
}
__device__ __forceinline__ void comb_row_head(const Args& A, int r, int h, float lam, const f32x4 sg, int lane) {
    const bf16* op = (const bf16*)(A.ws + WS_OP) + (size_t)r * 4096 + h * 512 + lane * 4;
    const uint2 a = *(const uint2*)op, b = *(const uint2*)(op + 256);
    float o1[4], o2[4];
    o1[0] = __uint_as_float(a.x << 16); o1[1] = __uint_as_float(a.x & 0xffff0000u); o1[2] = __uint_as_float(a.y << 16); o1[3] = __uint_as_float(a.y & 0xffff0000u);
    o2[0] = __uint_as_float(b.x << 16); o2[1] = __uint_as_float(b.x & 0xffff0000u); o2[2] = __uint_as_float(b.y << 16); o2[3] = __uint_as_float(b.y & 0xffff0000u);
    float d[4], ss = 0.f;
#pragma unroll
    for (int e = 0; e < 4; ++e) { d[e] = o1[e] - lam * o2[e]; ss += d[e] * d[e]; }
    const float rs_ = 1.0f / sqrtf(wave_sum(ss) * (1.0f / 256.0f) + LN_EPS) * (1.0f - LAM_INIT);
    uint2 w; w.x = cvtpk2(d[0] * rs_ * sg[0], d[1] * rs_ * sg[1]); w.y = cvtpk2(d[2] * rs_ * sg[2], d[3] * rs_ * sg[3]);
    *(uint2*)((bf16*)(A.ws + WS_HB) + (size_t)r * DM + h * 256 + lane * 4) = w;
}
__device__ __forceinline__ void comb_rows8_head(const Args& A, int r0, int h, float lam, const f32x4 sg, int lane) {
    const bf16* op = (const bf16*)(A.ws + WS_OP) + (size_t)r0 * 4096 + h * 512 + lane * 4;
    uint2 a[8], b[8];
#pragma unroll
    for (int i = 0; i < 8; ++i) { a[i] = *(const uint2*)(op + (size_t)i * 4096); b[i] = *(const uint2*)(op + (size_t)i * 4096 + 256); }
#pragma unroll
    for (int i = 0; i < 8; ++i) {
        float d[4], ss = 0.f;
        d[0] = __uint_as_float(a[i].x << 16) - lam * __uint_as_float(b[i].x << 16); d[1] = __uint_as_float(a[i].x & 0xffff0000u) - lam * __uint_as_float(b[i].x & 0xffff0000u);
        d[2] = __uint_as_float(a[i].y << 16) - lam * __uint_as_float(b[i].y << 16); d[3] = __uint_as_float(a[i].y & 0xffff0000u) - lam * __uint_as_float(b[i].y & 0xffff0000u);
#pragma unroll
        for (int e = 0; e < 4; ++e) ss += d[e] * d[e];
        const float rs_ = 1.0f / sqrtf(wave_sum(ss) * (1.0f / 256.0f) + LN_EPS) * (1.0f - LAM_INIT);
        uint2 w; w.x = cvtpk2(d[0] * rs_ * sg[0], d[1] * rs_ * sg[1]); w.y = cvtpk2(d[2] * rs_ * sg[2], d[3] * rs_ * sg[3]);
        *(uint2*)((bf16*)(A.ws + WS_HB) + (size_t)(r0 + i) * DM + h * 256 + lane * 4) = w; }
}
__device__ __forceinline__ void comb_row(const Args& A, int r, float lam, int lane) {
    bf16* ob = (bf16*)(A.ws + WS_HB) + (size_t)r * DM;
    const f32x4 sg = *(const f32x4*)(A.in[I_SUBG] + lane * 4);
    constexpr float C = att::SCALE * 1.4426950408889634f;
    for (int h = 0; h < 8; ++h) {
        float o1[4], o2[4];
        if (r < MP) {
            const bf16* op = (const bf16*)(A.ws + WS_OP) + (size_t)r * 4096 + h * 512 + lane * 4;
            const uint2 a = *(const uint2*)op, b = *(const uint2*)(op + 256);
            o1[0] = __uint_as_float(a.x << 16); o1[1] = __uint_as_float(a.x & 0xffff0000u); o1[2] = __uint_as_float(a.y << 16); o1[3] = __uint_as_float(a.y & 0xffff0000u);
            o2[0] = __uint_as_float(b.x << 16); o2[1] = __uint_as_float(b.x & 0xffff0000u); o2[2] = __uint_as_float(b.y << 16); o2[3] = __uint_as_float(b.y & 0xffff0000u);
        } else {
            const int rs = r - MP, b = rs >> 5, row = rs & 31;
            const float* ops = (const float*)(A.ws + WS_OPS); const float* mls = (const float*)(A.ws + WS_MLS);
#pragma unroll
            for (int j = 0; j < 2; ++j) {
                const size_t p0 = ((((size_t)b * 8 + h) * 2 + 0) * 2 + j) * 32 + row, p1 = ((((size_t)b * 8 + h) * 2 + 1) * 2 + j) * 32 + row;
                const float m0 = mls[p0 * 2], l0 = mls[p0 * 2 + 1], m1 = mls[p1 * 2], l1 = mls[p1 * 2 + 1], mm = fmaxf(m0, m1);
                const float e0 = __builtin_amdgcn_exp2f((m0 - mm) * C), e1 = __builtin_amdgcn_exp2f((m1 - mm) * C), inv = 1.0f / (l0 * e0 + l1 * e1);
                const f32x4 a = *(const f32x4*)(ops + p0 * 256 + lane * 4), bq = *(const f32x4*)(ops + p1 * 256 + lane * 4);
#pragma unroll
                for (int e = 0; e < 4; ++e) { const float v = (a[e] * e0 + bq[e] * e1) * inv; if (j == 0) o1[e] = v; else o2[e] = v; }
            }
        }
        float d[4], ss = 0.f;
#pragma unroll
        for (int e = 0; e < 4; ++e) { d[e] = o1[e] - lam * o2[e]; ss += d[e] * d[e]; }
        const float rs_ = 1.0f / sqrtf(wave_sum(ss) * (1.0f / 256.0f) + LN_EPS) * (1.0f - LAM_INIT);
        uint2 w; w.x = cvtpk2(d[0] * rs_ * sg[0], d[1] * rs_ * sg[1]); w.y = cvtpk2(d[2] * rs_ * sg[2], d[3] * rs_ * sg[3]);
        *(uint2*)(ob + h * 256 + lane * 4) = w;
    }
}


__device__ __forceinline__ void ssm_pair(const Args& A, LAS unsigned char* pl, int stream, int g, int role, int lane) {
    const bool prompt = stream < 8; const int b = prompt ? stream : stream - 8;
    const int nch = prompt ? SEQ / 16 : TS / 16;
    const size_t row0 = prompt ? (size_t)stream * SEQ : (size_t)MP + (size_t)(stream - 8) * TS;
    const bf16* U = (const bf16*)(A.ws + WS_U) + row0 * DM + 16 * g;
    unsigned char* Z = (unsigned char*)(A.ws + WS_Z) + row0 * DM + 16 * g;
    const int n16 = lane & 15, q4 = lane >> 4;
#define PB_BUT(i) (pl + ((i) & 1) * 10240)
#define PB_H(i) (pl + 20480 + ((i) & 1) * 4352)
#define PB_BAR() do { asm volatile("s_waitcnt lgkmcnt(0)" ::: "memory"); __builtin_amdgcn_s_barrier(); asm volatile("" ::: "memory"); } while (0)
    if (role == 0) {
        const float2 ab = ((const float2*)(A.ws + WS_ABAR))[g * 64 + lane];
        const float ar = ab.x, ai = ab.y; float hr = 0.f, hi = 0.f;
        if (!prompt) { hr = A.in[I_SRE][((size_t)b * NGRP + g) * SP + lane]; hi = A.in[I_SIM][((size_t)b * NGRP + g) * SP + lane]; }
        PB_BAR();
        for (int i = 0; i < nch; ++i) {
            LAS unsigned char* wl = PB_BUT(i); LAS unsigned char* hl = PB_H(i);
            f32x4 br[4], bi[4];
#pragma unroll
            for (int j = 0; j < 4; ++j) { br[j] = *(const LAS f32x4*)(wl + (lane * 20 + 4 * j) * 4); bi[j] = *(const LAS f32x4*)(wl + ((64 + lane) * 20 + 4 * j) * 4); }
#pragma unroll
            for (int t = 0; t < 16; ++t) {
                const float nhr = fmaf(ar, hr, fmaf(-ai, hi, br[t >> 2][t & 3])), nhi = fmaf(ar, hi, fmaf(ai, hr, bi[t >> 2][t & 3])); hr = nhr; hi = nhi;
                *(LAS unsigned*)(hl + (t * 68 + lane) * 4) = cvtpk2(hr, hi); }
            PB_BAR();
        }
        A.out[(prompt ? OUT_SRP : OUT_SRS) + ((size_t)b * NGRP + g) * SP + lane] = hr; A.out[(prompt ? OUT_SIP : OUT_SIS) + ((size_t)b * NGRP + g) * SP + lane] = hi;
    } else {
        s16x4v bB[8]; bf16x8 cB[4]; s16x4v dB;
        { const bf16* bbt = (const bf16*)(A.ws + WS_BBT) + (size_t)g * 128 * 16;
#pragma unroll
          for (int nb = 0; nb < 8; ++nb) bB[nb] = *(const s16x4v*)(bbt + (16 * nb + n16) * 16 + 4 * q4);
          const bf16* cmt = (const bf16*)(A.ws + WS_CMT) + (size_t)g * 16 * 128;
#pragma unroll
          for (int ks = 0; ks < 4; ++ks) cB[ks] = *(const bf16x8*)(cmt + n16 * 128 + 32 * ks + 8 * q4);
          const short dv = (short)f2bf(A.in[I_SSMD][16 * g + n16]);
#pragma unroll
          for (int j = 0; j < 4; ++j) dB[j] = (4 * q4 + j == n16) ? dv : (short)0; }
#define PB_LD(ch) (*(const s16x4v*)(U + (size_t)((ch) * 16 + n16) * DM + 4 * q4))
#define PB_BU(ua, ch) do { LAS unsigned char* wl = PB_BUT(ch); \
            _Pragma("unroll") for (int nb = 0; nb < 8; ++nb) { const f32x4 bu = __builtin_amdgcn_mfma_f32_16x16x16bf16_1k(ua, bB[nb], (f32x4){0.f, 0.f, 0.f, 0.f}, 0, 0, 0); \
                *(LAS f32x4*)(wl + ((16 * nb + n16) * 20 + 4 * q4) * 4) = bu; } } while (0)
#define PB_CP(ua, ch) do { LAS unsigned char* hl = PB_H(ch); f32x4 y = (f32x4){0.f, 0.f, 0.f, 0.f}; \
            _Pragma("unroll") for (int ks = 0; ks < 4; ++ks) { const bf16x8 hA = *(const LAS bf16x8*)(hl + (n16 * 68 + 16 * ks + 4 * q4) * 4); y = __builtin_amdgcn_mfma_f32_16x16x32_bf16(hA, cB[ks], y, 0, 0, 0); } \
            { const f32x4 ysk = __builtin_amdgcn_mfma_f32_16x16x16bf16_1k(ua, dB, (f32x4){0.f, 0.f, 0.f, 0.f}, 0, 0, 0); y = y + ysk; } \
            const pg8::f32x2 z0 = pg8::gelu_pk((pg8::f32x2){y[0], y[1]}), z1 = pg8::gelu_pk((pg8::f32x2){y[2], y[3]}); \
            unsigned char* zp = Z + (size_t)((ch) * 16 + 4 * q4) * DM + n16; \
            const unsigned w8 = pk4_fp8(z0.x * F8_Z, z0.y * F8_Z, z1.x * F8_Z, z1.y * F8_Z); \
            zp[0] = (unsigned char)(w8 & 0xffu); zp[DM] = (unsigned char)((w8 >> 8) & 0xffu); zp[2 * DM] = (unsigned char)((w8 >> 16) & 0xffu); zp[3 * DM] = (unsigned char)(w8 >> 24); } while (0)
        s16x4v r0 = PB_LD(0), r1 = PB_LD(1), r2 = s16x4v{}, r3 = s16x4v{}, r4 = s16x4v{};
        if (nch > 2) { r2 = PB_LD(2); r3 = PB_LD(3); r4 = PB_LD(4); }
        PB_BU(r0, 0);
        s16x4v uprev = r0, ucur = r0;
        PB_BAR();
        for (int i = 0; i < nch; ++i) {
            const s16x4v rn = (i + 5 < nch) ? PB_LD(i + 5) : s16x4v{};
            if (i + 1 < nch) PB_BU(r1, i + 1);
            if (i >= 1) PB_CP(uprev, i - 1);
            uprev = ucur; ucur = r1; r1 = r2; r2 = r3; r3 = r4; r4 = rn;
            PB_BAR();
        }
        PB_CP(uprev, nch - 1);
    }
#undef PB_BUT
#undef PB_H
#undef PB_BAR
#undef PB_LD
#undef PB_BU
#undef PB_CP
}


struct TDesc { const float* W; unsigned char* WT; int K, N, kind, fp8, item; float scale; };
__device__ __forceinline__ void p0_decode(const Args& A, int r, TDesc& d) {
    constexpr int I_IN = 2048, I_GLU = 4096, I_UP = 11264, I_DN = 5632, I_QKV = 6144, I_O = 2048;
    if (r < I_IN) { d = TDesc{A.in[I_WIN], A.ws + WS_WIN, DM, DM, 0, 0, r, 1.f}; return; } r -= I_IN;
    if (r < I_GLU) { d = TDesc{A.in[I_WGLU], A.ws + WS_WGLU, DM, 2 * DM, 1, 1, r, F8_WGLU}; return; } r -= I_GLU;
    if (r < I_UP) { d = TDesc{A.in[I_WUP], A.ws + WS_WUP8, DM, 2 * DFF, 1, 1, r, F8_WUP}; return; } r -= I_UP;
    if (r < I_DN) { d = TDesc{A.in[I_WDOWN], A.ws + WS_WDOWN8, DFF, DM, 0, 1, r, F8_WDN}; return; } r -= I_DN;
    if (r < I_QKV) { d = TDesc{A.in[I_WQKV], A.ws + WS_WQKV, DM, 3 * DM, 0, 0, r, 1.f}; return; } r -= I_QKV;
    if (r < I_O) { d = TDesc{A.in[I_WO], A.ws + WS_WO, DM, DM, 0, 0, r, 1.f}; return; } r -= I_O;
    if (r < I_UP) { d = TDesc{A.in[I_WUP] + (size_t)DM * 2 * DFF, A.ws + WS_WUP8 + (size_t)22 * MiB, DM, 2 * DFF, 1, 1, r, F8_WUP}; return; } r -= I_UP;
    d = TDesc{A.in[I_WDOWN] + (size_t)DFF * DM, A.ws + WS_WDOWN8 + (size_t)11 * MiB, DFF, DM, 0, 1, r, F8_WDN};
}
constexpr int TI_P0 = 0, TI_WINB = 6144  , TI_UPB = 23040  , TI_QKVB = 31232  , TI_END = 48128;
__device__ __forceinline__ void p0_tload(const TDesc& d, float (&tv)[32], int lane) {
    const int nblk = d.N / 32, kb = d.item / nblk, nb = d.item % nblk;
    const float* wp = d.W + (size_t)(64 * kb + (lane >> 5)) * d.N + 32 * nb + (lane & 31);
#pragma unroll
    for (int i = 0; i < 32; ++i) tv[i] = wp[(size_t)(2 * i) * d.N];
}
__device__ __forceinline__ void p0_tstore(const TDesc& d, const float (&tv)[32], LAS float* scr, int lane) {
    const int nblk = d.N / 32, kb = d.item / nblk, nb = d.item % nblk, k0 = 64 * kb, n0 = 32 * nb, K = d.K;
    int d0 = n0;
    if (d.kind == 1) { const int hn = d.N / 2, half = n0 / hn, rem = n0 % hn; d0 = 256 * (rem >> 7) + 128 * half + (rem & 127); }
#pragma unroll
    for (int i = 0; i < 32; ++i) scr[(2 * i + (lane >> 5)) * 33 + (lane & 31)] = tv[i];
    LDS_WAIT(); asm volatile("" ::: "memory");
    if (d.fp8) {
        const float scale = d.scale; const int n = lane >> 1, kh = (lane & 1) * 32; const LAS float* sp = scr + kh * 33 + n;
        v4u o0, o1;
        o0.x = pk4_fp8(sp[0 * 33] * scale, sp[1 * 33] * scale, sp[2 * 33] * scale, sp[3 * 33] * scale);     o0.y = pk4_fp8(sp[4 * 33] * scale, sp[5 * 33] * scale, sp[6 * 33] * scale, sp[7 * 33] * scale);
        o0.z = pk4_fp8(sp[8 * 33] * scale, sp[9 * 33] * scale, sp[10 * 33] * scale, sp[11 * 33] * scale);   o0.w = pk4_fp8(sp[12 * 33] * scale, sp[13 * 33] * scale, sp[14 * 33] * scale, sp[15 * 33] * scale);
        o1.x = pk4_fp8(sp[16 * 33] * scale, sp[17 * 33] * scale, sp[18 * 33] * scale, sp[19 * 33] * scale); o1.y = pk4_fp8(sp[20 * 33] * scale, sp[21 * 33] * scale, sp[22 * 33] * scale, sp[23 * 33] * scale);
        o1.z = pk4_fp8(sp[24 * 33] * scale, sp[25 * 33] * scale, sp[26 * 33] * scale, sp[27 * 33] * scale); o1.w = pk4_fp8(sp[28 * 33] * scale, sp[29 * 33] * scale, sp[30 * 33] * scale, sp[31 * 33] * scale);
        GAS v4u* dst = (GAS v4u*)(d.WT + (size_t)(d0 + n) * K + k0 + kh); dst[0] = o0; dst[1] = o1;
    } else {
        const int c = lane & 7;
#pragma unroll
        for (int j = 0; j < 4; ++j) { const int n = (lane >> 3) + 8 * j; const LAS float* sp = scr + (8 * c) * 33 + n;
            v4u o; o.x = pk2(sp[0 * 33], sp[1 * 33]); o.y = pk2(sp[2 * 33], sp[3 * 33]); o.z = pk2(sp[4 * 33], sp[5 * 33]); o.w = pk2(sp[6 * 33], sp[7 * 33]);
            *(GAS v4u*)((bf16*)d.WT + (size_t)(d0 + n) * K + k0 + 8 * c) = o; }
    }
    LDS_WAIT(); asm volatile("" ::: "memory");
}

__device__ __forceinline__ void p0_wimages(const Args& A, LAS float* scr, int first, int last, int w, int NW, int lane) {
        int it = first + w;
        if (it < last) { TDesc cur; p0_decode(A, it, cur); float tv[32]; p0_tload(cur, tv, lane);
            for (;;) { const int nx = it + NW; TDesc nxt; float tn[32];
                if (nx < last) { p0_decode(A, nx, nxt); p0_tload(nxt, tn, lane); }
                p0_tstore(cur, tv, scr, lane);
                if (nx >= last) break;
                cur = nxt; it = nx;
#pragma unroll
                for (int i = 0; i < 32; ++i) tv[i] = tn[i]; } }
}
#define BUBBLE_IMAGES(NUNITS, FIRST, LAST) do { const int rem_ = (NUNITS) % G; const int lane_ = mk_lane(); if (bx >= rem_) p0_wimages(A, (LAS float*)(L + wave * 16384), (FIRST), (LAST), (bx - rem_) * NWAVES + wave, (G - rem_) * NWAVES, lane_); } while (0)
__device__ __forceinline__ void phase_p0a(const Args& A, LAS unsigned char* L, int bx, int G, int gw, int NGW, int wave, int lane, int tid) {
        for (int it = bx; it < 192; it += G) p0_ada_item(A, L, it, tid, wave, lane);
        __syncthreads();
        LAS float* scr = (LAS float*)(L + wave * 16384);
        const int na = G > 192 ? 192 : 0;
        if (bx >= na) { const int w = (bx - na) * NWAVES + wave, NW = (G - na) * NWAVES;
            for (int t = w; t < 128; t += NW) p0_ssm_tables(A, t, lane);
            p0_wimages(A, scr, TI_P0, TI_WINB, w, NW, lane); }
}
__device__ __forceinline__ void phase_scan(const Args& A, LAS unsigned char* L, int bx, int G, int wave, int lane) {
#if MK_PROBE_PAIR_SAMPLE
    { const int pr = wave & 3, role = wave >> 2; LAS unsigned char* pl = L + pr * 29184;
      for (int u = bx * 4 + pr; u < 16 * NGRP; u += G * 4) ssm_pair(A, pl, 8 + (u >> 7), u & 127, role, lane); }
#else
    { LAS unsigned char* wl = L + wave * 14592;
      for (int u = bx * NWAVES + wave; u < 16 * NGRP; u += G * NWAVES) ssm_seq(A, wl, 8 + (u >> 7), u & 127, lane); }
    __syncthreads();
#endif
    { const int pr = wave & 3, role = wave >> 2; LAS unsigned char* pl = L + pr * 29184;
      for (int u = bx * 4 + pr; u < 8 * NGRP; u += G * 4) ssm_pair(A, pl, u >> 7, u & 127, role, lane); }
}
__device__ __forceinline__ void phase_attn(const Args& A, unsigned char* lds, int vcu, int G, int tid_) {
                const att::bf16* QB = (const att::bf16*)(A.ws + WS_Q); const att::bf16* KB = (const att::bf16*)(A.ws + WS_K); const att::bf16* VB = (const att::bf16*)(A.ws + WS_VA);
                att::bf16* OP = (att::bf16*)(A.ws + WS_OP);
                const int samp_pass = (vcu & 1) ? 0 : 2;
#pragma unroll 1
                for (int pass = 0; pass < 3; ++pass) { int tidp = tid_; asm volatile("" : "+v"(tidp)); const int tid = tidp;
#ifndef MK_NO_ATTP
                if (pass == 1) {
                  for (int gi_ = vcu; gi_ < (MK_REP == 110 ? 1024 : 512); gi_ += G) { const int gi = gi_ & 511;
                    const int qp = gi & 7, h = (gi >> 3) & 7, b = gi >> 6;
                    const size_t seq0 = (size_t)b * SEQ;
#pragma unroll 1
                    for (int u4 = 0; u4 < 4; ++u4) { const int s = 2 * h + (u4 >> 1), qb = (u4 & 1) ? qp : 15 - qp;
                        att::attn_prompt_unit2(A.ws, QB + (seq0 + qb * 256) * DM + s * 128, KB + seq0 * DM + s * 128, VB + seq0 * DM + h * 256, OP + (seq0 + qb * 256) * 4096 + s * 256, qb, (char*)lds, tid); }
                    asm volatile("s_waitcnt vmcnt(0)" ::: "memory"); __syncthreads();
                    const int lane = tid & 63, wid = tid >> 6;
                    float d1 = A.in[I_LQ1][lane] * A.in[I_LK1][lane] + A.in[I_LQ1][64 + lane] * A.in[I_LK1][64 + lane];
                    float d2 = A.in[I_LQ2][lane] * A.in[I_LK2][lane] + A.in[I_LQ2][64 + lane] * A.in[I_LK2][64 + lane];
                    const float lam = expf(wave_sum(d1)) - expf(wave_sum(d2)) + LAM_INIT;
                    const f32x4 sg = *(const f32x4*)(A.in[I_SUBG] + lane * 4);
#pragma unroll 1
                    for (int i = 0; i < 64; i += 8) { const int rr = wid * 64 + i, qb = (rr >> 8) ? qp : 15 - qp; comb_rows8_head(A, (int)seq0 + qb * 256 + (rr & 255), h, lam, sg, lane); }
                  } }
#endif
                __syncthreads();
#ifndef MK_NO_ATTS
                if (pass == samp_pass) {
                for (int si_ = vcu; si_ < (MK_REP == 111 ? 512 : 256); si_ += G) { const int si = si_ & 255;
                    att::attn_sample_unit(QB, KB, VB, A.in[I_CK], A.in[I_CV], (float*)(A.ws + WS_OPS), (float*)(A.ws + WS_MLS), si >> 4, (si >> 1) & 7, si & 1, (char*)lds, tid); }
                __syncthreads(); }
#endif
                }
}

#ifndef MK_PHMASK
#define MK_PHMASK 0x7ffff
#endif
__device__ __forceinline__ bool mk_in(int k) { const Args& Aq = *(const Args*)launder_args((CArgsP)__builtin_amdgcn_kernarg_segment_ptr()); return Aq.ph_lo <= k && k < Aq.ph_hi; }
#define IN(k) (((MK_PHMASK >> (k)) & 1) && mk_in(k))
#define SEAM(k) do { if (IN(k) && IN((k) + 1)) { XcdBarrier b_; b_.bar = (unsigned*)(A.ws + WS_CTL) + CW_BAR; b_.x = xb_xcc_id(); b_.st = (volatile LAS unsigned*)(L + MISC_OFF) + 8; xcd_barrier(b_, wave == 0 && mk_lane() == 0); if (MK_REP == 99) xcd_barrier(b_, wave == 0 && mk_lane() == 0); } } while (0)
#define GRIDBAR() do { XcdBarrier b_; b_.bar = (unsigned*)(A.ws + WS_CTL) + CW_BAR; b_.x = xb_xcc_id(); b_.st = (volatile LAS unsigned*)(L + MISC_OFF) + 8; xcd_barrier(b_, wave == 0 && mk_lane() == 0); if (MK_REP == 99) xcd_barrier(b_, wave == 0 && mk_lane() == 0); } while (0)
#define SHARE_ROWS(NS, HW, NR, BODY) do { const int vw_ = bx < (NS) ? ((wave < (HW)) ? bx * (HW) + wave : -1) : (NS) * (HW) + (bx - (NS)) * NWAVES + wave, nv_ = (NS) * (HW) + (G - (NS)) * NWAVES; \
        if (vw_ >= 0) for (int r__ = vw_; r__ < (NR); r__ += nv_) { BODY; } } while (0)
constexpr int CW_Q = 8192;
template <int layer> __device__ __forceinline__ void ffn_phases(LAS unsigned char* L, const int wave) {
        const int fb = layer ? 14 : 5;
        if (IN(fb)) {
            PHASE_ARGS; float* const Xs = A.out + OUT_Y; float* const MOD = (float*)(A.ws + WS_MOD); const float* modl = MOD + (size_t)layer * NSTREAM * 12288; (void)Xs; (void)modl;
            const float* lg = A.in[I_LNG] + (size_t)(layer * 2 + 0) * DM; const float* lb = A.in[I_LNB] + (size_t)(layer * 2 + 0) * DM;
            if (layer == 0) { pg8::Gemm g{(const bf16*)(A.ws + WS_Z), (const bf16*)(A.ws + WS_WGLU), M, 2 * DM, DM / 2, 1.0f / (F8_Z * F8_WGLU), A.ws}; pg8::StaticOrder S; S.init(MS, 2 * DM, G, bx, 1, MP / 256);
                pg8::EpiRes<true, false> E{A.in[I_XP], A.in[I_XS], Xs, MOD + 2 * DM, (float*)(A.ws + WS_STAT), nullptr, nullptr, nullptr};
                pg8::gemm_phase<pg8::EpiRes<true, false>, pg8::StaticOrder, true, true, true>(L, g, S, E, tid); }
            else { pg8::Gemm g{(const bf16*)(A.ws + WS_HB), (const bf16*)(A.ws + WS_WO), M, DM, DM, 0.f, A.ws}; pg8::StaticOrder S; S.init(MS, DM, G, bx, 1, MP / 256);
                float* const STAT = (float*)(A.ws + WS_STAT);
                pg8::EpiRes<false, true> E{Xs, Xs + (size_t)MP * DM, Xs, MOD + (size_t)NSTREAM * 12288 + 2 * DM, STAT + (size_t)2 * M * 2, STAT + (size_t)1 * M * 2, A.in[I_LNG] + (size_t)1 * DM, A.in[I_LNB] + (size_t)1 * DM};
                pg8::gemm_phase<pg8::EpiRes<false, true>, pg8::StaticOrder, true, true>(L, g, S, E, tid); }
            const float* stt = (const float*)(A.ws + WS_STAT) + (size_t)(layer ? 2 : 0) * M * 2;
            { const int lane_ = mk_lane(); SPAN_ROWS((layer ? 16 : 32), (layer ? 0 : 4), MP, r0_, r1_); ln_rows_span<1>(Xs, stt, lg, lb, modl, 4 * DM, 3 * DM, (unsigned char*)(A.ws + WS_HB), (bf16*)nullptr, r0_, r1_, lane_); }
            GRIDBAR();
            { const int lane = mk_lane(); for (int r = MP + gw; r < M; r += NGW) { const float* md = modl + (size_t)row_stream(r) * 12288; ln_row_st(Xs + (size_t)r * DM, stt + 2 * (size_t)r, lg, lb, md + 4 * DM, md + 3 * DM, (unsigned char*)(A.ws + WS_HB) + (size_t)r * DM, (bf16*)nullptr, false, lane); } }
            SEAM(fb);
        }
        if (IN(fb + 1)) {
            PHASE_ARGS;
            pg8::Gemm g{(const bf16*)(A.ws + WS_HB), (const bf16*)(A.ws + WS_WUP8 + (size_t)layer * 22 * MiB), M, 2 * DFF, DM / 2, 1.0f / (F8_H1 * F8_WUP), A.ws}; pg8::StaticOrder S; S.init(M, 2 * DFF, G, bx, (MK_REP == 6 && layer == 0) ? 2 : 1);
            pg8::EpiUpConv<layer> E{};
            pg8::gemm_phase<pg8::EpiUpConv<layer>, pg8::StaticOrder, true, true, true>(L, g, S, E, tid);
            if (layer == 0) BUBBLE_IMAGES((M / 256) * (2 * DFF / 256), TI_UPB, TI_QKVB);
            SEAM(fb + 1);
        }
        if (IN(fb + 2)) {
            PHASE_ARGS;
            convfix_items(A, layer, gw * 64 + lane, NGW * 64);
            for (int it_ = bx; it_ < ((MK_REP == 70 && layer == 0) ? 704 : 352); it_ += G) { const int it = it_ % 352; cvstate_item(A, layer, L, it, tid); }
            SEAM(fb + 2);
        }
        if (IN(fb + 3)) {
            PHASE_ARGS; float* const Xs = A.out + OUT_Y; float* const MOD = (float*)(A.ws + WS_MOD); const float* modl = MOD + (size_t)layer * NSTREAM * 12288; (void)Xs; (void)modl;
            pg8::Gemm g{(const bf16*)(A.ws + WS_ACT8), (const bf16*)(A.ws + WS_WDOWN8 + (size_t)layer * 11 * MiB), M, DM, DFF / 2, 1.0f / (F8_ACT * F8_WDN), A.ws}; pg8::StaticOrder S; S.init(MP, DM, G, bx);
            float* const STAT = (float*)(A.ws + WS_STAT);
            pg8::EpiRes<false, true, true> E{Xs, Xs + (size_t)MP * DM, Xs, modl + 5 * DM, STAT + (size_t)(layer ? 3 : 1) * M * 2, STAT + (size_t)(layer ? 2 : 0) * M * 2, A.in[I_LNG] + (size_t)(layer * 2) * DM, A.in[I_LNB] + (size_t)(layer * 2) * DM};
            pg8::gemm_phase<pg8::EpiRes<false, true, true>, pg8::StaticOrder, true, true, true>(L, g, S, E, tid);
            SEAM(fb + 3);
        }
        if (IN(fb + 4)) {
            PHASE_ARGS; float* const Xs = A.out + OUT_Y; float* const MOD = (float*)(A.ws + WS_MOD); const float* modl = MOD + (size_t)layer * NSTREAM * 12288; (void)Xs; (void)modl;
            const float* lg = A.in[I_LNG] + (size_t)(layer * 2 + 1) * DM; const float* lb = A.in[I_LNB] + (size_t)(layer * 2 + 1) * DM;
            const float* modn = MOD + (size_t)NSTREAM * 12288;
            { pg8::Gemm g{(const bf16*)(A.ws + WS_ACT8), (const bf16*)(A.ws + WS_WDOWN8 + (size_t)layer * 11 * MiB), M, DM, DFF / 2, 1.0f / (F8_ACT * F8_WDN), A.ws}; pg8::StaticOrder S; S.init(MS, DM, G, bx, 1, MP / 256, 2);
              pg8::EpiRaw E{(float*)(A.ws + WS_PART)};
              pg8::gemm_phase<pg8::EpiRaw, pg8::StaticOrder, true, true, true>(L, g, S, E, tid); }
            { const int lane = mk_lane();
            cvstate_reduce(A, layer, gw * 64 + lane, NGW * 64);
            const float* stt = (const float*)(A.ws + WS_STAT) + (size_t)(layer ? 3 : 1) * M * 2;
            { SPAN_ROWS(32, 0, MP, r0_, r1_); if (layer == 0) ln_rows_span<2>(Xs, stt, lg, lb, modn, 1 * DM, 0 * DM, (unsigned char*)nullptr, (bf16*)(A.ws + WS_HB), r0_, r1_, lane); else ln_rows_span<0>(Xs, stt, lg, lb, modn, 0, 0, (unsigned char*)nullptr, (bf16*)nullptr, r0_, r1_, lane); }
            GRIDBAR();
            for (int r = MP + gw; r < M; r += NGW) down_sample_row(A, layer, r, lane);
            }
            if (layer == 0) SEAM(9);
        }
    }

constexpr int NPHASE = 19;
__global__ void __launch_bounds__(NWAVES * 64, 2) mk_fwd(Args A0) {
    extern __shared__ __attribute__((aligned(16))) unsigned char lds[];
    LAS unsigned char* L = (LAS unsigned char*)lds;
    const int wave = __builtin_amdgcn_readfirstlane((int)threadIdx.x >> 6);
    for (int u = threadIdx.x; u < (LDS_BYTES - LDSCTL_OFF) / 4; u += NWAVES * 64) ((LAS unsigned*)(L + LDSCTL_OFF))[u] = 0u;
    __syncthreads();
    if (A0.ph_hi - A0.ph_lo > 1) (void)xcd_barrier_post((unsigned*)(A0.ws + WS_CTL) + CW_BAR, (volatile LAS unsigned*)(L + MISC_OFF) + 8);

    if (IN(0)) { PHASE_ARGS; float* const Xs = A.out + OUT_Y; float* const MOD = (float*)(A.ws + WS_MOD); bf16* const HB = (bf16*)(A.ws + WS_HB); (void)Xs; (void)MOD; (void)HB;
            REPEAT(0) {
        phase_p0a(A, L, bx, G, gw, NGW, wave, lane, tid);
#if MK_REP == 0
        __syncthreads(); phase_p0a(A, L, bx, G, gw, NGW, wave, lane, tid);
#endif
        }
            SEAM(0);
    }
    if (IN(1)) { PHASE_ARGS; float* const Xs = A.out + OUT_Y; float* const MOD = (float*)(A.ws + WS_MOD); bf16* const HB = (bf16*)(A.ws + WS_HB); (void)Xs; (void)MOD; (void)HB;
            REPEAT(1) {
        for (int r_ = gw; r_ < (MK_REP == 1 ? 2 * M : M); r_ += NGW) { const int r = r_ >= M ? r_ - M : r_; const float* xr = r < MP ? A.in[I_XP] + (size_t)r * DM : A.in[I_XS] + (size_t)(r - MP) * DM; const float* md = MOD + (size_t)row_stream(r) * 12288;
            mod_row(xr, md + 1 * DM, md + 0 * DM, HB + (size_t)r * DM, lane); }
        }
            SEAM(1);
    }
    {
        {
            if (IN(2)) { PHASE_ARGS; float* const Xs = A.out + OUT_Y; float* const MOD = (float*)(A.ws + WS_MOD); bf16* const HB = (bf16*)(A.ws + WS_HB); (void)Xs; (void)MOD; (void)HB;
                pg8::Gemm g{HB, (const bf16*)(A.ws + WS_WIN), M, DM, DM, 0.f, A.ws}; pg8::StaticOrder S; S.init(M, DM, G, bx, MK_REP == 2 ? 2 : 1);
                pg8::EpiBf16<0> E{(bf16*)(A.ws + WS_U), DM, nullptr, 0, 0, 1.f};
                pg8::gemm_phase<pg8::EpiBf16<0>, pg8::StaticOrder, true, true>(L, g, S, E, tid);
                BUBBLE_IMAGES((M / 256) * (DM / 256), TI_WINB, TI_UPB);
                SEAM(2);
            }
            if (IN(3)) { PHASE_ARGS; float* const Xs = A.out + OUT_Y; float* const MOD = (float*)(A.ws + WS_MOD); bf16* const HB = (bf16*)(A.ws + WS_HB); (void)Xs; (void)MOD; (void)HB;
            REPEAT(3) {
                phase_scan(A, L, bx, G, wave, lane);
#if MK_REP == 3
                phase_scan(A, L, bx, G, wave, lane);
#endif
                }
            SEAM(3);
            }
            if (IN(4)) { PHASE_ARGS; float* const Xs = A.out + OUT_Y; float* const MOD = (float*)(A.ws + WS_MOD); bf16* const HB = (bf16*)(A.ws + WS_HB); (void)Xs; (void)MOD; (void)HB;
                pg8::Gemm g{(const bf16*)(A.ws + WS_Z), (const bf16*)(A.ws + WS_WGLU), M, 2 * DM, DM / 2, 1.0f / (F8_Z * F8_WGLU), A.ws}; pg8::StaticOrder S; S.init(MP, 2 * DM, G, bx);
                pg8::EpiRes<true, false, true> E{A.in[I_XP], A.in[I_XS], Xs, MOD + 2 * DM, (float*)(A.ws + WS_STAT), nullptr, nullptr, nullptr};
                pg8::gemm_phase<pg8::EpiRes<true, false, true>, pg8::StaticOrder, true, true, true>(L, g, S, E, tid);
                SEAM(4);
            }
        }
        ffn_phases<0>(L, wave);
    }
    {
        {
            if (IN(10)) { PHASE_ARGS; float* const Xs = A.out + OUT_Y; float* const MOD = (float*)(A.ws + WS_MOD); bf16* const HB = (bf16*)(A.ws + WS_HB); (void)Xs; (void)MOD; (void)HB;
                pg8::Gemm g{HB, (const bf16*)(A.ws + WS_WQKV), M, 3 * DM, DM, 0.f, A.ws}; pg8::StaticOrder S; S.init(M, 3 * DM, G, bx, MK_REP == 10 ? 2 : 1);
                pg8::EpiQkv E{(bf16*)(A.ws + WS_Q), (size_t)(WS_K - WS_Q) / 2, A.out + OUT_KP, A.out + OUT_KS};
                pg8::gemm_phase<pg8::EpiQkv, pg8::StaticOrder, true, true>(L, g, S, E, tid);
                BUBBLE_IMAGES((M / 256) * (3 * DM / 256), TI_QKVB, TI_END);
                SEAM(10);
            }
            if (IN(11)) { PHASE_ARGS; float* const Xs = A.out + OUT_Y; float* const MOD = (float*)(A.ws + WS_MOD); bf16* const HB = (bf16*)(A.ws + WS_HB); (void)Xs; (void)MOD; (void)HB;
            REPEAT(11) {
                phase_attn(A, lds, vcu, G, tid);
#if MK_REP == 11
                phase_attn(A, lds, vcu, G, tid);
#endif
                }
            SEAM(11);
            }
            if (IN(12)) { PHASE_ARGS; float* const Xs = A.out + OUT_Y; float* const MOD = (float*)(A.ws + WS_MOD); bf16* const HB = (bf16*)(A.ws + WS_HB); (void)Xs; (void)MOD; (void)HB;
            REPEAT(12) {
                float d1 = A.in[I_LQ1][lane] * A.in[I_LK1][lane] + A.in[I_LQ1][64 + lane] * A.in[I_LK1][64 + lane];
                float d2 = A.in[I_LQ2][lane] * A.in[I_LK2][lane] + A.in[I_LQ2][64 + lane] * A.in[I_LK2][64 + lane];
                const float lam = expf(wave_sum(d1)) - expf(wave_sum(d2)) + LAM_INIT;
                for (int r = MP + gw; r < M; r += NGW) comb_row(A, r, lam, lane);
                }
            SEAM(12);
            }
            if (IN(13)) { PHASE_ARGS; float* const Xs = A.out + OUT_Y; float* const MOD = (float*)(A.ws + WS_MOD); bf16* const HB = (bf16*)(A.ws + WS_HB); (void)Xs; (void)MOD; (void)HB;
                pg8::Gemm g{HB, (const bf16*)(A.ws + WS_WO), M, DM, DM, 0.f, A.ws}; pg8::StaticOrder S; S.init(MP, DM, G, bx);
                float* const STAT = (float*)(A.ws + WS_STAT);
                pg8::EpiRes<false, true, true> E{Xs, Xs + (size_t)MP * DM, Xs, MOD + (size_t)NSTREAM * 12288 + 2 * DM, STAT + (size_t)2 * M * 2, STAT + (size_t)1 * M * 2, A.in[I_LNG] + (size_t)1 * DM, A.in[I_LNB] + (size_t)1 * DM};
                pg8::gemm_phase<pg8::EpiRes<false, true, true>, pg8::StaticOrder, true, true>(L, g, S, E, tid);
                SEAM(13);
            }
        }
        ffn_phases<1>(L, wave);
    }
#undef IN
#undef SEAM
}

extern "C" void kernel_launch(void* const* d_in, const int* in_sizes, int n_in, void* d_out, int out_size, void* d_ws, size_t ws_size, hipStream_t stream) {
    static int grid = 0;
    if (grid == 0) {
        if (n_in != 34 || out_size != (int)OUT_END || ws_size < WS_END) { fprintf(stderr, "kernel_launch: expected 34 inputs, %zu outputs, >= %zu ws bytes; got %d, %d, %zu\n", (size_t)OUT_END, (size_t)WS_END, n_in, out_size, ws_size); grid = -1; return; }
        int dev = 0, cus = 0, per_cu = 0;
        if (hipGetDevice(&dev) != hipSuccess || hipDeviceGetAttribute(&cus, hipDeviceAttributeMultiprocessorCount, dev) != hipSuccess) { grid = -1; return; }
        if (hipFuncSetAttribute((const void*)mk_fwd, hipFuncAttributeMaxDynamicSharedMemorySize, LDS_BYTES) != hipSuccess) { fprintf(stderr, "kernel_launch: hipFuncSetAttribute failed\n"); grid = -1; return; }
        if (hipOccupancyMaxActiveBlocksPerMultiprocessor(&per_cu, (const void*)mk_fwd, NWAVES * 64, LDS_BYTES) != hipSuccess || per_cu < 1) fprintf(stderr, "kernel_launch: occupancy query says %d\n", per_cu);
        (void)hipGetLastError();
        grid = cus;
    }
    if (grid < 0) return;
    if (hipMemsetAsync((char*)d_ws + WS_CTL, 0, CTL_ZERO_BYTES, stream) != hipSuccess) return;
    Args a{};
    for (int i = 0; i < 34; ++i) a.in[i] = (const float*)d_in[i];
    a.out = (float*)d_out; a.ws = (unsigned char*)d_ws; a.grid = grid;
#if MK_ONE_LAUNCH
    a.ph_lo = 0; a.ph_hi = NPHASE;
    hipLaunchKernelGGL(mk_fwd, dim3(grid), dim3(NWAVES * 64), LDS_BYTES, stream, a);
#else
    for (int k = 0; k < NPHASE; ++k) { a.ph_lo = k; a.ph_hi = k + 1; hipLaunchKernelGGL(mk_fwd, dim3(grid), dim3(NWAVES * 64), LDS_BYTES, stream, a); }
#endif
    const hipError_t le = hipPeekAtLastError();
    if (le != hipSuccess) fprintf(stderr, "kernel_launch: launch failed: %s\n", hipGetErrorName(le));
}
```
